# Optimizing an MI355X kernel written in HIP

```python
import jax
import jax.numpy as jnp
from jax import lax
import numpy as np

D_MODEL = 1024
BATCH = 2
SEQ = 16384
DEPTH = 2

GRID_W = 64
CTX_LEN = 256
RMS_EPS = 1e-6

MLA_HEADS = 4
MLA_Q_LORA = 256
MLA_KV_LORA = 128
MLA_NOPE = 128
MLA_ROPE = 64
MLA_V = 128
MLA_SCALE = (MLA_NOPE + MLA_ROPE) ** -0.5
ROPE_THETA = 10000.0
Q_BLOCK = 128

ML_HEADS = 4
ML_QK = 64
ML_V = 128
ML_CONV = 3
ML_CHUNK = 128

AB_SPLITS = (MLA_Q_LORA, MLA_KV_LORA, MLA_ROPE, ML_HEADS * ML_QK, ML_HEADS * ML_QK,
             ML_HEADS * ML_V, ML_HEADS * ML_V, 4 * ML_HEADS)
AB_IN = sum(AB_SPLITS)
AB_OUT = MLA_HEADS * MLA_V + ML_HEADS * ML_V

HG_EXPAND = 128
HG_HEADS = D_MODEL // HG_EXPAND
HG_V = D_MODEL // HG_HEADS
HG_F = HG_HEADS * HG_EXPAND
HG_CHUNK = 64
C_SPLITS = (HG_F, HG_F, HG_F, HG_HEADS * HG_V, HG_HEADS * HG_V)
C_IN = sum(C_SPLITS)

D_FF = 2816
N_EXPERTS = 8
TOP_K = 2
D_FF_EXPERT = 2816
MOE_BLOCK = 512

N_EVEN = (DEPTH + 1) // 2
N_ODD = DEPTH // 2

kernel_name = 'hybrid_mla_mlstm_hgrn2_moe_dit_block'


def rms_norm(x, gain):
    xf = x.astype(jnp.float32)
    y = xf * lax.rsqrt(jnp.mean(xf * xf, axis=-1, keepdims=True) + RMS_EPS)
    return (y * gain.astype(jnp.float32)).astype(x.dtype)


def modulate(x, shift, scale):
    return x * (1 + scale) + shift


def split_cols(a, sizes):
    return jnp.split(a, [int(s) for s in np.cumsum(sizes)[:-1]], axis=-1)


def to_heads(a, n_heads):
    b, t, _ = a.shape
    return a.reshape(b, t, n_heads, -1).transpose(0, 2, 1, 3)


def to_chunks(a, size):
    b, h, t = a.shape[:3]
    return jnp.moveaxis(a.reshape((b, h, t // size, size) + a.shape[3:]), 2, 0)


def from_chunks(a):
    a = jnp.moveaxis(a, 0, 2)
    return a.reshape(a.shape[:2] + (-1,) + a.shape[4:])


def axial_rope_tables(n_lat):
    rows = n_lat // GRID_W
    t = jnp.arange(rows * GRID_W)
    row = (t // GRID_W).astype(jnp.float32)
    col = (t % GRID_W).astype(jnp.float32)
    n_freq = MLA_ROPE // 4
    inv_freq = ROPE_THETA ** (-jnp.arange(n_freq, dtype=jnp.float32) / n_freq)
    ang = jnp.concatenate([row[:, None] * inv_freq, col[:, None] * inv_freq], axis=-1)
    ang = jnp.concatenate([ang, ang], axis=-1)
    return jnp.cos(ang), jnp.sin(ang)


def apply_rope(x, cos, sin):
    xf = x.astype(jnp.float32)
    half = xf.shape[-1] // 2
    rot = jnp.concatenate([-xf[..., half:], xf[..., :half]], axis=-1)
    return (xf * cos + rot * sin).astype(x.dtype)


def dwconv_centred(x, w, b):
    k, ch = w.shape
    y = lax.conv_general_dilated(x, w[:, None, :].astype(x.dtype), window_strides=(1,),
                                 padding=[(k // 2, k // 2)], dimension_numbers=('NWC', 'WIO', 'NWC'),
                                 feature_group_count=ch)
    return y + b.astype(x.dtype)


def attend(q, k, v):
    s = jnp.einsum('bqhd,bkhd->bhqk', q, k).astype(jnp.float32) * MLA_SCALE
    p = jax.nn.softmax(s, axis=-1).astype(v.dtype)
    return jnp.einsum('bhqk,bkhd->bqhd', p, v)


def blocked_attend(q, k, v):
    b, s, h, d = q.shape
    nb = s // Q_BLOCK
    qb = jnp.moveaxis(q.reshape(b, nb, Q_BLOCK, h, d), 1, 0)
    o = lax.map(lambda qq: attend(qq, k, v), qb)
    return jnp.moveaxis(o, 0, 1).reshape(b, s, -1)


def mla_qkv(cq, ckv, k_rope, q_gain, w_uq, kv_gain, w_ukv, rope):
    b, t, _ = cq.shape
    q = (rms_norm(cq, q_gain) @ w_uq).reshape(b, t, MLA_HEADS, MLA_NOPE + MLA_ROPE)
    kv = (rms_norm(ckv, kv_gain) @ w_ukv).reshape(b, t, MLA_HEADS, MLA_NOPE + MLA_V)
    q_nope, q_rope = q[..., :MLA_NOPE], q[..., MLA_NOPE:]
    k_nope, v = kv[..., :MLA_NOPE], kv[..., MLA_NOPE:]
    if rope is not None:
        cos, sin = rope
        q_rope = apply_rope(q_rope, cos[:, None, :], sin[:, None, :])
        k_rope = apply_rope(k_rope, cos, sin)
    q = jnp.concatenate([q_nope, q_rope], axis=-1)
    k = jnp.concatenate([k_nope, jnp.broadcast_to(k_rope[:, :, None, :], (b, t, MLA_HEADS, MLA_ROPE))], axis=-1)
    return q, k, v


def mlstm_chunk_scan(q, k, v, log_i, log_f, state):
    tril = jnp.tril(jnp.ones((ML_CHUNK, ML_CHUNK), bool))

    def step(carry, inp):
        c_st, n_st, m_st = carry
        qc, kc, vc, ic, fc = inp
        g = jnp.cumsum(fc, axis=-1)
        d = jnp.where(tril, g[..., :, None] - g[..., None, :] + ic[..., None, :], -jnp.inf)
        inter = g + m_st[..., None]
        m_t = jnp.maximum(jnp.max(d, axis=-1), inter)
        s = jnp.einsum('bhtd,bhsd->bhts', qc, kc) * jnp.exp(d - m_t[..., None])
        w_inter = jnp.exp(inter - m_t)
        num = jnp.einsum('bhts,bhse->bhte', s, vc) + w_inter[..., None] * jnp.einsum('bhtd,bhde->bhte', qc, c_st)
        den = jnp.sum(s, axis=-1) + w_inter * jnp.einsum('bhtd,bhd->bht', qc, n_st)
        h = num / jnp.maximum(jnp.abs(den), jnp.exp(-m_t))[..., None]
        g_end = g[..., -1]
        w_log = g_end[..., None] - g + ic
        m_new = jnp.maximum(g_end + m_st, jnp.max(w_log, axis=-1))
        decay = jnp.exp(g_end + m_st - m_new)
        w_in = jnp.exp(w_log - m_new[..., None])
        c_st = decay[..., None, None] * c_st + jnp.einsum('bhsd,bhse->bhde', kc * w_in[..., None], vc)
        n_st = decay[..., None] * n_st + jnp.einsum('bhs,bhsd->bhd', w_in, kc)
        return (c_st, n_st, m_new), h

    xs = tuple(to_chunks(a, ML_CHUNK) for a in (q, k, v, log_i, log_f))
    state, h = lax.scan(step, state, xs)
    return from_chunks(h), state


def hgrn2_chunk_scan(q, k, v, log_f, state):
    tril = jnp.tril(jnp.ones((HG_CHUNK, HG_CHUNK), bool))[:, :, None]

    def step(s_st, inp):
        qc, kc, vc, fc = inp
        g = jnp.cumsum(fc, axis=2)
        decay = jnp.exp(jnp.where(tril, g[:, :, :, None, :] - g[:, :, None, :, :], -jnp.inf))
        a = jnp.sum(qc[:, :, :, None, :] * kc[:, :, None, :, :] * decay, axis=-1)
        o = jnp.einsum('bhts,bhse->bhte', a, vc) + jnp.einsum('bhtd,bhde->bhte', qc * jnp.exp(g), s_st)
        g_end = g[:, :, -1]
        s_st = jnp.exp(g_end)[..., None] * s_st + jnp.einsum(
            'bhsd,bhse->bhde', kc * jnp.exp(g_end[:, :, None, :] - g), vc)
        return s_st, o

    xs = tuple(to_chunks(a, HG_CHUNK) for a in (q, k, v, log_f))
    state, o = lax.scan(step, state, xs)
    return from_chunks(o), state


def bidirectional_scan(scan_fn, init, ctx_fwd, lat_fwd, ctx_bwd, lat_bwd):
    flip = lambda arrs: tuple(jnp.flip(a, axis=2) for a in arrs)
    h_cf, s_f = scan_fn(*ctx_fwd, init)
    h_lf, _ = scan_fn(*lat_fwd, s_f)
    h_cb, s_b = scan_fn(*flip(ctx_bwd), init)
    h_lb, _ = scan_fn(*flip(lat_bwd), s_b)
    return h_cf + jnp.flip(h_cb, axis=2), h_lf + jnp.flip(h_lb, axis=2)


def swiglu(h, w_gu, w_dn):
    g, u = jnp.split(h @ w_gu, 2, axis=-1)
    return (jax.nn.silu(g) * u) @ w_dn


def moe_swiglu(h, w_router, w_gu, w_dn):
    b, t, d = h.shape
    n_tok = b * t
    xf = h.reshape(n_tok, d)
    logits = (xf @ w_router).astype(jnp.float32)
    top_val, top_idx = lax.top_k(logits, TOP_K)
    gates = jax.nn.softmax(top_val, axis=-1)
    flat_e = top_idx.reshape(-1)
    order = jnp.argsort(flat_e)
    e_sorted = flat_e[order]
    tok_sorted = (order // TOP_K).astype(jnp.int32)
    g_sorted = gates.reshape(-1)[order]
    counts = jnp.bincount(flat_e, length=N_EXPERTS)
    padded = (counts + MOE_BLOCK - 1) // MOE_BLOCK * MOE_BLOCK
    start = jnp.cumsum(counts) - counts
    ends = jnp.cumsum(padded)
    dest = (ends - padded)[e_sorted] + jnp.arange(n_tok * TOP_K) - start[e_sorted]
    n_blocks = -(-(n_tok * TOP_K) // MOE_BLOCK) + N_EXPERTS
    n_slots = n_blocks * MOE_BLOCK
    slot_tok = jnp.full((n_slots,), n_tok, jnp.int32).at[dest].set(tok_sorted)
    slot_gate = jnp.zeros((n_slots,), jnp.float32).at[dest].set(g_sorted)
    block_expert = jnp.minimum(jnp.searchsorted(ends, jnp.arange(n_blocks) * MOE_BLOCK, side='right'), N_EXPERTS - 1)
    x_pad = jnp.concatenate([xf, jnp.zeros((1, d), xf.dtype)], axis=0)
    xs = x_pad[slot_tok].reshape(n_blocks, MOE_BLOCK, d)

    def expert_block(args):
        xb, e = args
        return swiglu(xb, w_gu[e], w_dn[e])

    ys = lax.map(expert_block, (xs, block_expert)).reshape(n_slots, d)
    out = jnp.zeros((n_tok + 1, d), jnp.float32).at[slot_tok].add(ys.astype(jnp.float32) * slot_gate[:, None])
    return out[:n_tok].astype(h.dtype).reshape(b, t, d)


def mla_mlstm_mixer(h_lat, h_ctx, rope, w_in, q_gain, w_uq, kv_gain, w_ukv, conv_w, conv_b, gate_b,
                    head_gain, w_out, need_ctx):
    b = h_lat.shape[0]
    p_lat = split_cols(h_lat @ w_in, AB_SPLITS)
    p_ctx = split_cols(h_ctx @ w_in, AB_SPLITS)
    q_l, k_l, v_l = mla_qkv(*p_lat[:3], q_gain, w_uq, kv_gain, w_ukv, rope)
    q_c, k_c, v_c = mla_qkv(*p_ctx[:3], q_gain, w_uq, kv_gain, w_ukv, None)
    a_lat = blocked_attend(q_l, jnp.concatenate([k_c, k_l], axis=1), jnp.concatenate([v_c, v_l], axis=1))

    def prepare(mq, mk, mv, mg):
        bb, t, _ = mq.shape
        qk = jax.nn.silu(dwconv_centred(jnp.concatenate([mq, mk], axis=-1), conv_w, conv_b))
        q = to_heads(qk[..., :ML_HEADS * ML_QK], ML_HEADS).astype(jnp.float32)
        k = to_heads(qk[..., ML_HEADS * ML_QK:], ML_HEADS).astype(jnp.float32) * ML_QK ** -0.5
        v = to_heads(mv, ML_HEADS).astype(jnp.float32)
        g = (mg + gate_b).astype(jnp.float32).reshape(bb, t, 4, ML_HEADS).transpose(2, 0, 3, 1)
        fwd = (q, k, v, g[0], jax.nn.log_sigmoid(g[1]))
        bwd = (q, k, v, g[2], jax.nn.log_sigmoid(g[3]))
        return fwd, bwd

    c_f, c_b = prepare(p_ctx[3], p_ctx[4], p_ctx[5], p_ctx[7])
    l_f, l_b = prepare(p_lat[3], p_lat[4], p_lat[5], p_lat[7])
    init = (jnp.zeros((b, ML_HEADS, ML_QK, ML_V), jnp.float32),
            jnp.zeros((b, ML_HEADS, ML_QK), jnp.float32),
            jnp.zeros((b, ML_HEADS), jnp.float32))
    m_ctx, m_lat = bidirectional_scan(mlstm_chunk_scan, init, c_f, l_f, c_b, l_b)

    def readout(h, o_pre):
        bb, _, t, _ = h.shape
        h = rms_norm(h.transpose(0, 2, 1, 3), head_gain.reshape(ML_HEADS, ML_V)).reshape(bb, t, -1)
        return (h * jax.nn.sigmoid(o_pre.astype(jnp.float32))).astype(h_lat.dtype)

    y_lat = jnp.concatenate([a_lat, readout(m_lat, p_lat[6])], axis=-1) @ w_out
    y_ctx = None
    if need_ctx:
        a_ctx = attend(q_c, k_c, v_c).reshape(b, q_c.shape[1], -1)
        y_ctx = jnp.concatenate([a_ctx, readout(m_ctx, p_ctx[6])], axis=-1) @ w_out
    return y_lat, y_ctx


def hgrn2_mixer(h_lat, h_ctx, lower_bound, w_in, head_gain, w_out, need_ctx):
    b = h_lat.shape[0]
    lb = lower_bound.reshape(HG_HEADS, 1, HG_EXPAND)

    def prepare(h):
        hq, zf, zb, hi, hg = split_cols(h @ w_in, C_SPLITS)
        q = to_heads(jax.nn.silu(hq), HG_HEADS).astype(jnp.float32)
        v = to_heads(hi, HG_HEADS).astype(jnp.float32)

        def direction(z):
            z = to_heads(z, HG_HEADS).astype(jnp.float32)
            log_f = jnp.log(lb + (1.0 - lb) * jax.nn.sigmoid(z))
            k = (1.0 - lb) * jax.nn.sigmoid(-z)
            return (q, k, v, log_f)

        return direction(zf), direction(zb), hg

    c_f, c_b, g_ctx = prepare(h_ctx)
    l_f, l_b, g_lat = prepare(h_lat)
    init = jnp.zeros((b, HG_HEADS, HG_EXPAND, HG_V), jnp.float32)
    o_ctx, o_lat = bidirectional_scan(hgrn2_chunk_scan, init, c_f, l_f, c_b, l_b)

    def readout(o, g):
        bb, _, t, _ = o.shape
        o = rms_norm(o.transpose(0, 2, 1, 3), head_gain.reshape(HG_HEADS, HG_V))
        gate = jax.nn.silu(g.astype(jnp.float32)).reshape(bb, t, HG_HEADS, HG_V)
        return (o * gate).reshape(bb, t, -1).astype(h_lat.dtype) @ w_out

    y_ctx = readout(o_ctx, g_ctx) if need_ctx else None
    return readout(o_lat, g_lat), y_ctx


def setup_inputs(seed: int = 0) -> dict:
    key = jax.random.key(seed)
    keys = iter(jax.random.split(key, 40))
    d = D_MODEL

    def dense(shape, fan_in):
        return jax.random.normal(next(keys), shape, jnp.float32) * fan_in ** -0.5

    def gain(shape, s=0.05):
        return 1.0 + s * jax.random.normal(next(keys), shape, jnp.float32)

    def small(shape, s=0.02):
        return s * jax.random.normal(next(keys), shape, jnp.float32)

    f_bias = jnp.linspace(3.0, 6.0, ML_HEADS)
    gate_base = jnp.concatenate([jnp.zeros((ML_HEADS,)), f_bias, jnp.zeros((ML_HEADS,)), f_bias])
    return {
        'x': jax.random.normal(next(keys), (BATCH, SEQ, d), jnp.float32),
        'c': jax.random.normal(next(keys), (BATCH, d), jnp.float32),
        'ctx': jax.random.normal(next(keys), (BATCH, CTX_LEN, d), jnp.float32),
        'c_ctx': jax.random.normal(next(keys), (d,), jnp.float32),
        'w_mod': dense((DEPTH, d, 6 * d), d),
        'b_mod': small((DEPTH, 6 * d)),
        'norm_gains': gain((DEPTH, 4, d)),
        'w_in_ab': dense((N_EVEN, d, AB_IN), d),
        'mla_q_gain': gain((N_EVEN, MLA_Q_LORA)),
        'mla_w_uq': dense((N_EVEN, MLA_Q_LORA, MLA_HEADS * (MLA_NOPE + MLA_ROPE)), MLA_Q_LORA),
        'mla_kv_gain': gain((N_EVEN, MLA_KV_LORA)),
        'mla_w_ukv': dense((N_EVEN, MLA_KV_LORA, MLA_HEADS * (MLA_NOPE + MLA_V)), MLA_KV_LORA),
        'ml_conv_w': dense((N_EVEN, ML_CONV, 2 * ML_HEADS * ML_QK), ML_CONV),
        'ml_conv_b': small((N_EVEN, 2 * ML_HEADS * ML_QK)),
        'ml_gate_b': gate_base + small((N_EVEN, 4 * ML_HEADS), 0.1),
        'ml_head_gain': gain((N_EVEN, ML_HEADS * ML_V)),
        'w_out_ab': dense((N_EVEN, AB_OUT, d), AB_OUT),
        'ffn_w_gu': dense((N_EVEN, d, 2 * D_FF), d),
        'ffn_w_dn': dense((N_EVEN, D_FF, d), D_FF),
        'w_in_c': dense((N_ODD, d, C_IN), d),
        'hg_lb_logits': gain((DEPTH, HG_F), 0.3),
        'hg_head_gain': gain((N_ODD, HG_HEADS * HG_V)),
        'w_out_c': dense((N_ODD, HG_HEADS * HG_V, d), HG_HEADS * HG_V),
        'moe_router': dense((N_ODD, d, N_EXPERTS), d),
        'moe_w_gu': dense((N_ODD, N_EXPERTS, d, 2 * D_FF_EXPERT), d),
        'moe_w_dn': dense((N_ODD, N_EXPERTS, D_FF_EXPERT, d), D_FF_EXPERT),
    }


def reference(x, c, ctx, c_ctx, w_mod, b_mod, norm_gains, w_in_ab, mla_q_gain, mla_w_uq, mla_kv_gain,
              mla_w_ukv, ml_conv_w, ml_conv_b, ml_gate_b, ml_head_gain, w_out_ab, ffn_w_gu, ffn_w_dn,
              w_in_c, hg_lb_logits, hg_head_gain, w_out_c, moe_router, moe_w_gu, moe_w_dn):
    rope = axial_rope_tables(x.shape[1])
    lbs = jnp.cumsum(jax.nn.softmax(hg_lb_logits.astype(jnp.float32), axis=0), axis=0)
    lbs = lbs - lbs[0]
    for layer in range(DEPTH):
        j = layer // 2
        need_ctx = layer < DEPTH - 1
        gains = norm_gains[layer]
        mod = jax.nn.silu(c) @ w_mod[layer] + b_mod[layer]
        mod_c = jax.nn.silu(c_ctx) @ w_mod[layer] + b_mod[layer]
        sh1, sc1, g1, sh2, sc2, g2 = jnp.split(mod[:, None, :], 6, axis=-1)
        csh1, csc1, cg1, csh2, csc2, cg2 = jnp.split(mod_c, 6, axis=-1)

        h = modulate(rms_norm(x, gains[0]), sh1, sc1)
        hc = modulate(rms_norm(ctx, gains[0]), csh1, csc1)
        if layer % 2 == 0:
            y, yc = mla_mlstm_mixer(h, hc, rope, w_in_ab[j], mla_q_gain[j], mla_w_uq[j], mla_kv_gain[j],
                                    mla_w_ukv[j], ml_conv_w[j], ml_conv_b[j], ml_gate_b[j], ml_head_gain[j],
                                    w_out_ab[j], need_ctx)
        else:
            y, yc = hgrn2_mixer(h, hc, lbs[layer], w_in_c[j], hg_head_gain[j], w_out_c[j], need_ctx)
        x = x + g1 * rms_norm(y, gains[1])

        h = modulate(rms_norm(x, gains[2]), sh2, sc2)
        if layer % 2 == 0:
            y = swiglu(h, ffn_w_gu[j], ffn_w_dn[j])
        else:
            y = moe_swiglu(h, moe_router[j], moe_w_gu[j], moe_w_dn[j])
        x = x + g2 * rms_norm(y, gains[3])

        if need_ctx:
            ctx = ctx + cg1 * rms_norm(yc, gains[1])
            hc = modulate(rms_norm(ctx, gains[2]), csh2, csc2)
            if layer % 2 == 0:
                yc = swiglu(hc, ffn_w_gu[j], ffn_w_dn[j])
            else:
                yc = moe_swiglu(hc, moe_router[j], moe_w_gu[j], moe_w_dn[j])
            ctx = ctx + cg2 * rms_norm(yc, gains[3])
    return x
```

```cpp
#define MLSTM_STUB 0
#define N_LAUNCHES 1
#define BAR_PROBE 0
#include <hip/hip_runtime.h>
#include <cstdio>
#include <cstdint>

#define GAS __attribute__((address_space(1)))
#define LAS __attribute__((address_space(3)))
typedef unsigned short bf16;
typedef short bf16x8 __attribute__((ext_vector_type(8)));
typedef short s16x4 __attribute__((ext_vector_type(4)));
typedef float f32x4 __attribute__((ext_vector_type(4)));
typedef float f32x16 __attribute__((ext_vector_type(16)));
typedef unsigned u32x4 __attribute__((ext_vector_type(4)));
typedef unsigned u32x2 __attribute__((ext_vector_type(2)));

constexpr int DM = 1024, NB = 2, SEQ = 16384, CTXL = 256, NT = SEQ + CTXL  , NR = NB * NT  ;
constexpr int NGRP = NT / 256;
constexpr int NH = 4;
constexpr int P_LD = 2048;
constexpr int DFF = 2816, NEXP = 8;
constexpr float RMS_EPS = 1e-6f;
constexpr int NWAVES = 8, NTHREADS = 512;

enum { I_X = 0, I_C, I_CTX, I_CCTX, I_WMOD, I_BMOD, I_GAINS, I_WINAB, I_QGAIN, I_WUQ, I_KVGAIN, I_WUKV, I_CONVW, I_CONVB, I_GATEB, I_MLGAIN, I_WOUTAB,
       I_FFNGU, I_FFNDN, I_WINC, I_LBLOG, I_HGGAIN, I_WOUTC, I_ROUTER, I_MOEGU, I_MOEDN, N_IN };

constexpr size_t MiB = 1u << 20;
constexpr size_t WS_CTL = 0, CTL_ZERO_BYTES = 1 * MiB;
constexpr size_t WS_MOD = 1 * MiB;
constexpr size_t WS_LB = WS_MOD + 160 * 1024;
constexpr size_t WS_ROPE = WS_MOD + 192 * 1024;
constexpr size_t WS_WGBASE = WS_MOD + 256 * 1024;
constexpr size_t WS_TOKREC = 2 * MiB;
constexpr size_t WS_SA = 5 * MiB;
constexpr size_t WS_W_INAB = 8 * MiB, WS_W_UP = 12 * MiB, WS_W_OUTAB = 14 * MiB, WS_W_GU = 16 * MiB, WS_W_DN = 27 * MiB, WS_W_INC = 33 * MiB, WS_W_OUTC = 43 * MiB;
constexpr size_t WS_D = 46 * MiB;
constexpr size_t WS_H = WS_D + 0 * MiB;
constexpr size_t WS_P = WS_D + 65 * MiB;
constexpr size_t WS_A2 = WS_D + 195 * MiB;
constexpr size_t WS_QKP = WS_D + 220 * MiB;
constexpr size_t WS_GATES = WS_D + 253 * MiB;
constexpr size_t WS_GL = WS_D + 255 * MiB + 512 * 1024;
constexpr size_t WS_Q = WS_D + 258 * MiB;
constexpr size_t WS_KN = WS_D + 307 * MiB;
constexpr size_t WS_KR = WS_D + 340 * MiB;
constexpr size_t WS_V = WS_D + 345 * MiB;
constexpr size_t WS_CAT = WS_D + 378 * MiB;
constexpr size_t WS_Y = WS_D + 443 * MiB;
constexpr size_t WS_VT8 = WS_D + 443 * MiB;
constexpr size_t WS_KV8 = WS_D + 443 * MiB;
constexpr size_t WS_K8 = WS_KV8;
constexpr size_t WS_MLU = WS_D + 508 * MiB;
constexpr size_t WS_MLS = WS_D + 542 * MiB;
constexpr size_t WS_HID = WS_D + 65 * MiB;
constexpr size_t WS1_Y = WS_D + 0 * MiB, WS1_H1 = WS_D + 0 * MiB, WS1_CAT = WS_D + 65 * MiB, WS1_H2 = WS_D + 65 * MiB, WS1_PC = WS_D + 130 * MiB, WS1_S = WS_D + 455 * MiB, WS1_U = WS_D + 0 * MiB  ;
constexpr size_t WS1_MHID = WS_D + 0 * MiB  , WS_RES = WS_D + 560 * MiB  , WS1_XS = WS_D + 430 * MiB  , WS1_YS = WS_D + 183 * MiB  ;
constexpr size_t WS_END = WS_D + 651 * MiB;
static_assert(WS_HID + (size_t)NR * DFF * 2 <= WS_Q, "HID overlay");
static_assert(WS1_YS + (size_t)67584 * 2048 <= WS1_XS && WS1_U + (size_t)32 * 65 * 65536 <= WS1_PC && WS1_XS + (size_t)67584 * 1024 <= WS_RES && WS_RES + 66 * MiB <= WS_END && WS1_MHID + (size_t)67584 * 2816 <= WS1_YS && WS_MLS + 18 * MiB <= WS_RES, "ws map");

constexpr int CW_BAR = 4096;
constexpr int CW_MOECNT = 8192;
constexpr size_t WS_CMAXP = 6 * MiB;
constexpr int CW_COLSC = 32768;

constexpr int RING_BYTES = 131072;
constexpr int MISC_OFF = 147456 - 256;
constexpr int LDS_BYTES = 147456;

#define LDS_WAIT() asm volatile("s_waitcnt lgkmcnt(0)" ::: "memory")
#define VM_WAIT() asm volatile("s_waitcnt vmcnt(0)" ::: "memory")
__device__ __forceinline__ float bf2f(unsigned h) { return __uint_as_float(h << 16); }
typedef __bf16 bf16x2_n __attribute__((ext_vector_type(2)));
typedef float f32x2_n __attribute__((ext_vector_type(2)));
__device__ __forceinline__ unsigned pk2(float lo, float hi) { const f32x2_n v = {lo, hi}; const bf16x2_n b = __builtin_convertvector(v, bf16x2_n); return __builtin_bit_cast(unsigned, b); }
__device__ __forceinline__ unsigned f2bf(float f) { return pk2(f, f) & 0xffffu; }
__device__ __forceinline__ float wave_sum(float v) {
#pragma unroll
    for (int o = 1; o < 64; o <<= 1) v += __shfl_xor(v, o);
    return v;
}
__device__ __forceinline__ float sigm(float x) { return __builtin_amdgcn_rcpf(1.f + __expf(-x)); }
__device__ __forceinline__ float siluf(float x) { return x * __builtin_amdgcn_rcpf(1.f + __expf(-x)); }
__device__ __forceinline__ float logsig(float x) { return fminf(x, 0.f) - log1pf(__expf(-fabsf(x))); }

#define XB_TMO      128
#define XB_XCNT(j)  (256  + 64 * (j))
#define XB_XSUB(j)  (1280 + 64 * (j))
#define XB_XGEN(j)  (2304 + 64 * (j))
#define XB_TOP      3328
#define XB_TOPGEN   3392
#define XCD_BAR_WORDS 3456
#define XB_SPIN_CAP (1u << 18)
__device__ __forceinline__ unsigned xb_ld(unsigned* p)              { return __hip_atomic_load(p, __ATOMIC_RELAXED, __HIP_MEMORY_SCOPE_AGENT); }
__device__ __forceinline__ unsigned xb_add(unsigned* p, unsigned v) { return __hip_atomic_fetch_add(p, v, __ATOMIC_RELAXED, __HIP_MEMORY_SCOPE_AGENT); }
__device__ __forceinline__ unsigned xb_xcc_id() { return (unsigned)__builtin_amdgcn_s_getreg((3 << 11) | 20) & 0xFu; }
#define XB_SPIN(cond, bar) do { unsigned _sp = 0; while (cond) { __builtin_amdgcn_s_sleep(1); \
    if ((++_sp & 255u) == 0u) { if (xb_ld(&(bar)[XB_TMO])) break; if (_sp > XB_SPIN_CAP) { atomicAdd(&(bar)[XB_TMO], 1u); break; } } } } while (0)
struct XcdBarrier { unsigned* bar; unsigned x; volatile LAS unsigned* st; };
__device__ __forceinline__ XcdBarrier xcd_barrier_post(unsigned* bar, volatile LAS unsigned* st, const int tid) {
    XcdBarrier b; b.bar = bar; b.x = xb_xcc_id(); b.st = st;
    if (tid == 0) (void)xb_add(&bar[XB_XCNT(b.x)], 1u);
    return b;
}
__device__ __forceinline__ void xcd_barrier_complete(unsigned* bar, unsigned x, unsigned& nloc, unsigned& nx) {
    const unsigned G = gridDim.x * gridDim.y * gridDim.z;
    unsigned sum, cnt, mine, sp = 0u;
    for (;;) {
        sum = 0u; cnt = 0u; mine = 0u;
#pragma unroll
        for (unsigned j = 0; j < 16; ++j) { const unsigned c = xb_ld(&bar[XB_XCNT(j)]); sum += c; cnt += (c > 0u) ? 1u : 0u; mine = (j == x) ? c : mine; }
        if (sum == G) break;
        __builtin_amdgcn_s_sleep(1);
        if ((++sp & 255u) == 0u) { if (xb_ld(&bar[XB_TMO])) break; if (sp > XB_SPIN_CAP) { atomicAdd(&bar[XB_TMO], 1u); break; } }
    }
    nloc = mine > 0u ? mine : 1u; nx = cnt > 0u ? cnt : 1u;
}
__device__ __forceinline__ void xcd_barrier(const XcdBarrier& b, const int tid) {
    asm volatile("s_waitcnt vmcnt(0)" ::: "memory");
    __syncthreads();
    if (tid == 0) {
        unsigned* bar = b.bar;
        __builtin_amdgcn_s_waitcnt(0);
        unsigned nloc = b.st[0], nx = b.st[1];
        if (nloc == 0u) { xcd_barrier_complete(bar, b.x, nloc, nx); b.st[0] = nloc; b.st[1] = nx; }
        const unsigned old = xb_add(&bar[XB_XSUB(b.x)], 1u);
        const unsigned gen = old / nloc;
        if (old + 1u == (gen + 1u) * nloc) {
            __builtin_amdgcn_fence(__ATOMIC_RELEASE, "agent");
            asm volatile("s_waitcnt vmcnt(0)" ::: "memory");
            const unsigned og = xb_add(&bar[XB_TOP], 1u);
            const unsigned tg = og / nx;
            if (og + 1u == (tg + 1u) * nx) xb_add(&bar[XB_TOPGEN], 1u);
            else XB_SPIN(xb_ld(&bar[XB_TOPGEN]) == tg, bar);
            __builtin_amdgcn_fence(__ATOMIC_ACQUIRE, "agent");
            xb_add(&bar[XB_XGEN(b.x)], 1u);
            asm volatile("s_waitcnt vmcnt(0)" ::: "memory");
        } else {
            XB_SPIN(xb_ld(&bar[XB_XGEN(b.x)]) == gen, bar);
            __builtin_amdgcn_fence(__ATOMIC_ACQUIRE, "agent");
            asm volatile("s_waitcnt vmcnt(0)" ::: "memory");
        }
    }
    __syncthreads();
}

namespace pg8 {
#define PG8_LAS __attribute__((address_space(3)))
typedef unsigned short bf16_t;
constexpr int BM = 256, BK = 64, HALF = 128, HTB = HALF * BK * 2, STAGE_BYTES = 8 * HTB, NXCD = 8, WGM = 8;
__host__ __device__ __forceinline__ int lds_byte(int r, int c) { const int st = (r >> 4) * 2 + (c >> 5), rr = r & 15, cc = c & 31, ob = rr * 64 + cc * 2; return st * 1024 + (ob ^ (((ob >> 9) & 1) << 5)); }
__host__ __device__ __forceinline__ void stage_rc(int b, int& R, int& C) { const int st = b / 1024, sb = b % 1024, swz = sb ^ (((sb >> 9) & 1) << 5); R = (st >> 1) * 16 + swz / 64; C = (st & 1) * 32 + (swz % 64) / 2; }
__host__ __device__ __forceinline__ int perm32(int rho) { const int n = rho >> 4, i = rho & 15; return 8 * (i >> 2) + 4 * n + (i & 3); }
struct Unit { int pm, pn, eb; };
struct Gemm { const bf16_t* A; const bf16_t* Bt; int K; size_t estride; const float* sa = nullptr; const float* sw = nullptr; };
__device__ __forceinline__ unsigned cvt_pk_bf16(float lo, float hi) { unsigned r; asm volatile("v_cvt_pk_bf16_f32 %0, %1, %2" : "=v"(r) : "v"(lo), "v"(hi)); return r; }

struct StaticOrder {
    int nM, nN, nwg, G, c, lat_only;
    __device__ void init(int nM_, int nN_, int G_, int c_, int lat_only_) { nM = nM_; nN = nN_; nwg = nM * nN; G = G_; c = c_; lat_only = lat_only_; }
    __device__ bool next(int i, Unit& u) const {
        const long L = (long)i * G + c; if (L >= nwg) return false;
        int wgid = (int)L; { const int q = nwg / NXCD, r = nwg % NXCD, xcd = wgid % NXCD, off = wgid / NXCD; wgid = (xcd < r ? xcd * (q + 1) : r * (q + 1) + (xcd - r) * q) + off; }
        const int nig = WGM * nN, gid = wgid / nig, fm = gid * WGM, gsz = (nM - fm) < WGM ? (nM - fm) : WGM;
        int pm = fm + ((wgid % nig) % gsz); u.pn = (wgid % nig) / gsz; u.eb = 0;
        if (lat_only) pm = pm + 1 + (pm >= 64 ? 1 : 0);
        u.pm = pm; return true;
    }
    __device__ __forceinline__ void a_ready(const Unit&) const {}
    __device__ __forceinline__ void done(const Unit&) const {}
};
struct CtxOrder {
    int c;
    __device__ bool next(int i, Unit& u) const { if (i != 0 || c >= 8) return false; u.pm = (c >> 2) ? 65 : 0; u.pn = c & 3; u.eb = 0; return true; }
    __device__ __forceinline__ void a_ready(const Unit&) const {}
    __device__ __forceinline__ void done(const Unit&) const {}
};
struct GroupedOrder {
    int nM, nN, nwg, G, c; const int* tile_e;
    __device__ void init(int nM_, int nN_, int G_, int c_, const int* te) { nM = nM_; nN = nN_; nwg = nM * nN; G = G_; c = c_; tile_e = te; }
    __device__ bool next(int i, Unit& u) const {
        const long L = (long)i * G + c; if (L >= nwg) return false;
        int wgid = (int)L; { const int q = nwg / NXCD, r = nwg % NXCD, xcd = wgid % NXCD, off = wgid / NXCD; wgid = (xcd < r ? xcd * (q + 1) : r * (q + 1) + (xcd - r) * q) + off; }
        const int nig = WGM * nN, gid = wgid / nig, fm = gid * WGM, gsz = (nM - fm) < WGM ? (nM - fm) : WGM;
        u.pm = fm + ((wgid % nig) % gsz); u.pn = (wgid % nig) / gsz; u.eb = tile_e[u.pm]; return true;
    }
    __device__ __forceinline__ void a_ready(const Unit&) const {}
    __device__ __forceinline__ void done(const Unit&) const {}
};
typedef int pg8_v4i __attribute__((ext_vector_type(4))); typedef int pg8_v8i __attribute__((ext_vector_type(8)));
template <bool F8> struct pg8_frag;
template <> struct pg8_frag<false> { ::bf16x8 v[2]; };
template <> struct pg8_frag<true> { pg8_v8i w; };
__device__ __forceinline__ void pg8_put(pg8_v8i& w, ::bf16x8 t, int k) { const pg8_v4i a = __builtin_bit_cast(pg8_v4i, t); if (k == 0) { w[0] = a[0]; w[1] = a[1]; w[2] = a[2]; w[3] = a[3]; } else { w[4] = a[0]; w[5] = a[1]; w[6] = a[2]; w[7] = a[3]; } }
template <class Epi, class Sched, bool ALIGN_EPI = false, bool SP2 = false, int FP8 = 0>
__device__ __forceinline__ void gemm_phase(PG8_LAS unsigned char* lds, const Gemm g, const Sched& S, const Epi& E, const int tid_in) {
    const int tid = tid_in, wid = __builtin_amdgcn_readfirstlane(tid >> 6), lane = tid & 63, wr = wid >> 2, wc = wid & 3, fr = lane & 15, fq = lane >> 4;
    const int K = g.K, nt = K / BK;
    unsigned voffA[2], voffB[2];
#pragma unroll
    for (int i = 0; i < 2; ++i) { int R, C; stage_rc(tid * 16 + i * 8192, R, C); const int Rb = Epi::PERM ? ((R & ~31) + perm32(R & 31)) : R;
        voffA[i] = (unsigned)(R * K + C) * 2u; voffB[i] = (unsigned)(Rb * K + C) * 2u; }
    const size_t kstep = (size_t)(BK * 2);
    const size_t hstep = (size_t)HALF * K * 2;
    const size_t tstep = 2 * hstep;
    const unsigned ldsw = (unsigned)wid * 1024u;
    const int aoff = lds_byte(wr * 64 + fr, fq * 8), boff = lds_byte(wc * 32 + fr, fq * 8);
#define PG8_SA(b, h) (((b) * 2 + (h)) * HTB)
#define PG8_SB(b, h) ((4 + (b) * 2 + (h)) * HTB)
#define PG8_STAGE(bufoff, gbase, voff) do { _Pragma("unroll") for (int _i = 0; _i < 2; ++_i) \
        __builtin_amdgcn_global_load_lds((const unsigned*)((const char*)(gbase) + (voff)[_i]), (PG8_LAS unsigned*)(lds + (bufoff) + ldsw + _i * 8192), 16, 0, 0); } while (0)
#define PG8_LDA(dst, b, h) do { _Pragma("unroll") for (int m = 0; m < 4; ++m) _Pragma("unroll") for (int k = 0; k < 2; ++k) { const ::bf16x8 t_ = *(const PG8_LAS ::bf16x8*)(lds + PG8_SA(b, h) + aoff + m * 2048 + k * 1024); if constexpr (FP8 == 1) pg8_put(dst[m].w, t_, k); else dst[m].v[k] = t_; } } while (0)
#define PG8_LDB(dst, b, h) do { _Pragma("unroll") for (int n = 0; n < 2; ++n) _Pragma("unroll") for (int k = 0; k < 2; ++k) { const ::bf16x8 t_ = *(const PG8_LAS ::bf16x8*)(lds + PG8_SB(b, h) + boff + n * 2048 + k * 1024); if constexpr (FP8 == 1) pg8_put(dst[n].w, t_, k); else dst[n].v[k] = t_; } } while (0)
#define PG8_MMA(ai, bj, At, Bt) do { __builtin_amdgcn_s_setprio(1); _Pragma("unroll") for (int m = 0; m < 4; ++m) _Pragma("unroll") for (int n = 0; n < 2; ++n) _Pragma("unroll") for (int k = 0; k < 2; ++k) \
        { if constexpr (FP8 == 1) { if (k == 0) asm volatile("v_mfma_f32_16x16x128_f8f6f4 %0, %1, %2, %0" : "+v"(acc[ai][bj][m][n]) : "v"(Bt[n].w), "v"(At[m].w)); }     \
          else if constexpr (FP8 == 2) asm volatile("v_mfma_i32_16x16x64_i8 %0, %1, %2, %0" : "+v"(acc[ai][bj][m][n]) : "v"(Bt[n].v[k]), "v"(At[m].v[k])); \
          else acc[ai][bj][m][n] = __builtin_amdgcn_mfma_f32_16x16x32_bf16(Bt[n].v[k], At[m].v[k], acc[ai][bj][m][n], 0, 0, 0); } __builtin_amdgcn_s_setprio(0); } while (0)
#define PG8_WAIT_V(n) asm volatile("s_waitcnt vmcnt(" #n ")" ::: "memory")
#define PG8_WAIT_L(n) asm volatile("s_waitcnt lgkmcnt(" #n ")" ::: "memory")
#define PG8_BAR __builtin_amdgcn_s_barrier()
#define PG8_SCHED __builtin_amdgcn_sched_barrier(0)
    Unit cur, nxt; int ui = 0;
    if (!S.next(0, cur)) return;
    ::f32x4 acc[2][2][4][2];
#pragma unroll
    for (int a = 0; a < 2; ++a)
#pragma unroll
        for (int b = 0; b < 2; ++b)
#pragma unroll
            for (int m = 0; m < 4; ++m)
#pragma unroll
                for (int n = 0; n < 2; ++n) acc[a][b][m][n] = (::f32x4){0.f, 0.f, 0.f, 0.f};
    pg8_frag<FP8 == 1> At[4], B0[2], B1[2];
    const char* cA = (const char*)g.A + (size_t)cur.pm * tstep; const char* cB = (const char*)g.Bt + (size_t)cur.eb * g.estride + (size_t)cur.pn * tstep;
    S.a_ready(cur);
    if constexpr (SP2) {
        PG8_STAGE(PG8_SB(0, 0), cB, voffB); PG8_STAGE(PG8_SB(0, 1), cB + hstep, voffB); PG8_STAGE(PG8_SA(0, 0), cA, voffA); PG8_STAGE(PG8_SA(0, 1), cA + hstep, voffA);
        if (wr == 1) PG8_BAR;
        PG8_WAIT_V(2); PG8_BAR;
        PG8_STAGE(PG8_SB(1, 0), cB + kstep, voffB); PG8_STAGE(PG8_SA(1, 0), cA + kstep, voffA); PG8_STAGE(PG8_SB(1, 1), cB + hstep + kstep, voffB);
        PG8_WAIT_V(6); PG8_BAR;
    } else {
        PG8_STAGE(PG8_SB(0, 0), cB, voffB); PG8_STAGE(PG8_SA(0, 0), cA, voffA); PG8_STAGE(PG8_SB(0, 1), cB + hstep, voffB); PG8_STAGE(PG8_SA(0, 1), cA + hstep, voffA);
        if (wr == 1) PG8_BAR;
        PG8_WAIT_V(4); PG8_BAR;
        PG8_STAGE(PG8_SB(1, 0), cB + kstep, voffB); PG8_STAGE(PG8_SA(1, 0), cA + kstep, voffA); PG8_STAGE(PG8_SB(1, 1), cB + hstep + kstep, voffB);
        PG8_WAIT_V(6); PG8_BAR;
    }
    for (;;) {
        const bool has_next = S.next(ui + 1, nxt);
        const char* nA = has_next ? (const char*)g.A + (size_t)nxt.pm * tstep : cA; const char* nB = has_next ? (const char*)g.Bt + (size_t)nxt.eb * g.estride + (size_t)nxt.pn * tstep : cB;
        for (int t = 0; t < nt; t += 2) {
            const bool last = (t == nt - 2);
            const char* a1 = cA + (size_t)(t + 1) * kstep;
            const char* a2 = last ? nA : cA + (size_t)(t + 2) * kstep; const char* b2 = last ? nB : cB + (size_t)(t + 2) * kstep;
            const char* a3 = a2 + kstep; const char* b3 = b2 + kstep;
            if (last && has_next) S.a_ready(nxt);
            if constexpr (SP2) {
            PG8_LDB(B0, 0, 0); PG8_LDB(B1, 0, 1); PG8_SCHED; PG8_LDA(At, 0, 0); PG8_STAGE(PG8_SA(1, 1), a1 + hstep, voffA);
            PG8_WAIT_V(8); PG8_WAIT_L(0); PG8_BAR; PG8_MMA(0, 0, At, B0); PG8_MMA(0, 1, At, B1); PG8_BAR; PG8_SCHED;
            PG8_LDA(At, 0, 1); PG8_STAGE(PG8_SB(0, 0), b2, voffB); PG8_STAGE(PG8_SB(0, 1), b2 + hstep, voffB); PG8_STAGE(PG8_SA(0, 0), a2, voffA);
            PG8_WAIT_V(8); PG8_WAIT_L(0); PG8_BAR; PG8_MMA(1, 0, At, B0); PG8_MMA(1, 1, At, B1); PG8_BAR; PG8_SCHED;
            PG8_LDB(B0, 1, 0); PG8_LDB(B1, 1, 1); PG8_SCHED; PG8_LDA(At, 1, 0); PG8_STAGE(PG8_SA(0, 1), a2 + hstep, voffA);
            PG8_WAIT_V(8); PG8_WAIT_L(0); PG8_BAR; PG8_MMA(0, 0, At, B0); PG8_MMA(0, 1, At, B1); PG8_BAR; PG8_SCHED;
            PG8_LDA(At, 1, 1); PG8_STAGE(PG8_SB(1, 0), b3, voffB); PG8_STAGE(PG8_SB(1, 1), b3 + hstep, voffB); PG8_STAGE(PG8_SA(1, 0), a3, voffA);
            PG8_WAIT_V(8); PG8_WAIT_L(0); PG8_BAR; PG8_MMA(1, 0, At, B0); PG8_MMA(1, 1, At, B1); PG8_BAR; PG8_SCHED;
            } else {
            PG8_LDB(B0, 0, 0); PG8_SCHED; PG8_LDA(At, 0, 0); PG8_STAGE(PG8_SA(1, 1), a1 + hstep, voffA);
            PG8_WAIT_L(8); PG8_BAR; PG8_WAIT_L(0); PG8_MMA(0, 0, At, B0); PG8_BAR; PG8_SCHED;
            PG8_LDB(B1, 0, 1); PG8_STAGE(PG8_SB(0, 0), b2, voffB);
            PG8_BAR; PG8_WAIT_L(0); PG8_MMA(0, 1, At, B1); PG8_BAR;
            PG8_LDA(At, 0, 1); PG8_STAGE(PG8_SA(0, 0), a2, voffA);
            PG8_BAR; PG8_WAIT_L(0); PG8_MMA(1, 0, At, B0); PG8_BAR; PG8_SCHED;
            PG8_STAGE(PG8_SB(0, 1), b2 + hstep, voffB);
            PG8_WAIT_V(6); PG8_BAR; PG8_MMA(1, 1, At, B1); PG8_BAR;
            PG8_LDB(B0, 1, 0); PG8_SCHED; PG8_LDA(At, 1, 0); PG8_STAGE(PG8_SA(0, 1), a2 + hstep, voffA);
            PG8_WAIT_L(8); PG8_BAR; PG8_WAIT_L(0); PG8_MMA(0, 0, At, B0); PG8_BAR; PG8_SCHED;
            PG8_LDB(B1, 1, 1); PG8_STAGE(PG8_SB(1, 0), b3, voffB);
            PG8_BAR; PG8_WAIT_L(0); PG8_MMA(0, 1, At, B1); PG8_BAR;
            PG8_LDA(At, 1, 1); PG8_STAGE(PG8_SA(1, 0), a3, voffA);
            PG8_BAR; PG8_WAIT_L(0); PG8_MMA(1, 0, At, B0); PG8_BAR; PG8_SCHED;
            PG8_STAGE(PG8_SB(1, 1), b3 + hstep, voffB);
            PG8_WAIT_V(6); PG8_BAR; PG8_MMA(1, 1, At, B1); PG8_BAR;
            }
        }
        if constexpr (ALIGN_EPI) { if (wr == 0) PG8_BAR; }
        asm volatile("s_nop 15\n\ts_nop 15" : "+v"(acc[1][1][0][0]), "+v"(acc[1][1][0][1]), "+v"(acc[1][1][1][0]), "+v"(acc[1][1][1][1]), "+v"(acc[1][1][2][0]), "+v"(acc[1][1][2][1]), "+v"(acc[1][1][3][0]), "+v"(acc[1][1][3][1]));
        if constexpr (FP8 == 2) {
            const int r0_ = cur.pm * BM + wr * 64 + fr; ::f32x4 sw_[2][2];
#pragma unroll
            for (int bj = 0; bj < 2; ++bj)
#pragma unroll
                for (int n = 0; n < 2; ++n) sw_[bj][n] = *(const ::f32x4*)(g.sw + cur.pn * BM + bj * HALF + wc * 32 + 8 * fq + 4 * n);
#pragma unroll
            for (int ai = 0; ai < 2; ++ai)
#pragma unroll
                for (int m = 0; m < 4; ++m) { const float s_ = g.sa[r0_ + ai * HALF + m * 16];
#pragma unroll
                    for (int bj = 0; bj < 2; ++bj)
#pragma unroll
                        for (int n = 0; n < 2; ++n)
#pragma unroll
                            for (int e = 0; e < 4; ++e) acc[ai][bj][m][n][e] = (float)__float_as_int(acc[ai][bj][m][n][e]) * (s_ * sw_[bj][n][e]); } }
        if constexpr (!Epi::AFTER_DRAIN) { E(acc, cur, wr, wc, fr, fq); S.done(cur); }
        if (!has_next) break;
#pragma unroll
        for (int a = 0; a < 2; ++a)
#pragma unroll
            for (int b = 0; b < 2; ++b)
#pragma unroll
                for (int m = 0; m < 4; ++m)
#pragma unroll
                    for (int n = 0; n < 2; ++n) acc[a][b][m][n] = (::f32x4){0.f, 0.f, 0.f, 0.f};
        cur = nxt; cA = nA; cB = nB; ++ui;
        if constexpr (ALIGN_EPI) { if (wr == 1) PG8_BAR; }
    }
    PG8_WAIT_V(0);
    if constexpr (!ALIGN_EPI) { if (wr == 0) PG8_BAR; }
    PG8_BAR;
    if constexpr (Epi::AFTER_DRAIN) { E.fused(acc, cur, wr, wc, fr, fq, lds, wid, lane); S.done(cur); }
#undef PG8_SA
#undef PG8_SB
#undef PG8_STAGE
#undef PG8_LDA
#undef PG8_LDB
#undef PG8_MMA
#undef PG8_WAIT_V
#undef PG8_WAIT_L
#undef PG8_BAR
#undef PG8_SCHED
}
}

namespace epi {
using pg8::Unit; using pg8::cvt_pk_bf16; using pg8::BM; using pg8::HALF;
struct Bf16 {
    static constexpr bool PERM = true, AFTER_DRAIN = false;
    bf16* O; int ldc; float scale = 1.f;
    __device__ __forceinline__ void operator()(const f32x4 (&acc)[2][2][4][2], const Unit& u, int wr, int wc, int fr, int fq) const {
        const int row0 = u.pm * BM + wr * 64 + fr, col0 = u.pn * BM + wc * 32 + 8 * fq;
#pragma unroll
        for (int ai = 0; ai < 2; ++ai)
#pragma unroll
            for (int m = 0; m < 4; ++m) { bf16* rowp = O + (size_t)(row0 + ai * HALF + m * 16) * ldc + col0;
#pragma unroll
                for (int bj = 0; bj < 2; ++bj) { const f32x4 v0 = acc[ai][bj][m][0] * scale, v1 = acc[ai][bj][m][1] * scale;
                    u32x4 w; w.x = cvt_pk_bf16(v0[0], v0[1]); w.y = cvt_pk_bf16(v0[2], v0[3]); w.z = cvt_pk_bf16(v1[0], v1[1]); w.w = cvt_pk_bf16(v1[2], v1[3]);
                    *(u32x4*)(rowp + bj * HALF) = w; } }
    }
};
struct InAB {
    static constexpr bool PERM = true, AFTER_DRAIN = false;
    bf16* O; float* G;
    __device__ __forceinline__ void operator()(const f32x4 (&acc)[2][2][4][2], const Unit& u, int wr, int wc, int fr, int fq) const {
        const int row0 = u.pm * BM + wr * 64 + fr, col0 = u.pn * BM + wc * 32 + 8 * fq;
        const bool gates = (u.pn == 7) && (wc == 2) && (fq < 2);
#pragma unroll
        for (int ai = 0; ai < 2; ++ai)
#pragma unroll
            for (int m = 0; m < 4; ++m) { const int row = row0 + ai * HALF + m * 16; bf16* rowp = O + (size_t)row * P_LD + col0;
#pragma unroll
                for (int bj = 0; bj < 2; ++bj) { const f32x4 v0 = acc[ai][bj][m][0], v1 = acc[ai][bj][m][1];
                    u32x4 w; w.x = cvt_pk_bf16(v0[0], v0[1]); w.y = cvt_pk_bf16(v0[2], v0[3]); w.z = cvt_pk_bf16(v1[0], v1[1]); w.w = cvt_pk_bf16(v1[2], v1[3]);
                    *(u32x4*)(rowp + bj * HALF) = w;
                    if (bj == 1 && gates) { float* gp = G + (size_t)row * 16 + 8 * fq; *(f32x4*)gp = v0; *(f32x4*)(gp + 4) = v1; } } }
    }
};
struct UpProj {
    static constexpr bool PERM = true, AFTER_DRAIN = false;
    unsigned char* ws;
    __device__ __forceinline__ void operator()(const f32x4 (&acc)[2][2][4][2], const Unit& u, int wr, int wc, int fr, int fq) const {
        const int b = u.pm >= NGRP ? 1 : 0, j0 = u.pm * BM - b * NT + wr * 64 + fr;
        unsigned off[2], ldb[2];
#pragma unroll
        for (int bj = 0; bj < 2; ++bj) {
            const int col = u.pn * BM + bj * HALF + wc * 32 + 8 * fq; int hd, w; unsigned base;
            if (col < 768) { hd = col / 192; w = col - hd * 192; base = (unsigned)WS_Q; ldb[bj] = 384u; }
            else { const int c2 = col - 768; hd = c2 >> 8; w = c2 & 255; if (w < 128) base = (unsigned)WS_KN; else { base = (unsigned)WS_V; w -= 128; } ldb[bj] = 256u; }
            off[bj] = base + ((unsigned)(b * NH + hd) * NT + (unsigned)j0) * ldb[bj] + 2u * w;
        }
#pragma unroll
        for (int ai = 0; ai < 2; ++ai)
#pragma unroll
            for (int m = 0; m < 4; ++m) {
#pragma unroll
                for (int bj = 0; bj < 2; ++bj) { const f32x4 v0 = acc[ai][bj][m][0], v1 = acc[ai][bj][m][1];
                    u32x4 wv; wv.x = cvt_pk_bf16(v0[0], v0[1]); wv.y = cvt_pk_bf16(v0[2], v0[3]); wv.z = cvt_pk_bf16(v1[0], v1[1]); wv.w = cvt_pk_bf16(v1[2], v1[3]);
                    *(u32x4*)(ws + (off[bj] + (unsigned)(ai * HALF + m * 16) * ldb[bj])) = wv; }
                asm volatile("" ::: "memory"); }
    }
};
struct SwiGLU {
    static constexpr bool PERM = true, AFTER_DRAIN = false;
    bf16* Hd; int ldh;
    __device__ __forceinline__ void operator()(const f32x4 (&acc)[2][2][4][2], const Unit& u, int wr, int wc, int fr, int fq) const {
        const int row0 = u.pm * BM + wr * 64 + fr, hc0 = u.pn * 128 + wc * 16 + 4 * fq;
#pragma unroll
        for (int ai = 0; ai < 2; ++ai)
#pragma unroll
            for (int m = 0; m < 4; ++m) { bf16* rowp = Hd + (size_t)(row0 + ai * HALF + m * 16) * ldh + hc0;
#pragma unroll
                for (int bj = 0; bj < 2; ++bj) { const f32x4 g = acc[ai][bj][m][0], uu = acc[ai][bj][m][1];
                    u32x2 w; w.x = cvt_pk_bf16(siluf(g[0]) * uu[0], siluf(g[1]) * uu[1]); w.y = cvt_pk_bf16(siluf(g[2]) * uu[2], siluf(g[3]) * uu[3]);
                    *(u32x2*)(rowp + bj * 64) = w; } }
    }
};
struct InC {
    static constexpr bool PERM = true, AFTER_DRAIN = false;
    bf16* O; const float* lb;
    __device__ __forceinline__ void operator()(const f32x4 (&acc)[2][2][4][2], const Unit& u, int wr, int wc, int fr, int fq) const {
        const int row0 = u.pm * BM + wr * 64 + fr, col0 = u.pn * BM + wc * 32 + 8 * fq; const int mode = u.pn < 4 ? 1 : (u.pn < 12 ? 2 : 0);
        f32x4 om[2][2];
#pragma unroll
        for (int bj = 0; bj < 2; ++bj) { const float* lp = lb + ((col0 + bj * HALF) & 1023); const f32x4 l0 = mode == 2 ? *(const f32x4*)lp : (f32x4){0.f, 0.f, 0.f, 0.f}, l1 = mode == 2 ? *(const f32x4*)(lp + 4) : (f32x4){0.f, 0.f, 0.f, 0.f};
            om[bj][0] = 1.f - l0; om[bj][1] = 1.f - l1; }
#pragma unroll
        for (int ai = 0; ai < 2; ++ai)
#pragma unroll
            for (int m = 0; m < 4; ++m) { bf16* rowp = O + (size_t)(row0 + ai * HALF + m * 16) * 5120 + col0;
#pragma unroll
                for (int bj = 0; bj < 2; ++bj) { f32x4 v0 = acc[ai][bj][m][0], v1 = acc[ai][bj][m][1];
                    if (mode == 1) {
#pragma unroll
                        for (int j = 0; j < 4; ++j) { v0[j] = siluf(v0[j]); v1[j] = siluf(v1[j]); } }
                    else if (mode == 2) {
#pragma unroll
                        for (int j = 0; j < 4; ++j) { v0[j] = om[bj][0][j] * __builtin_amdgcn_rcpf(1.f + __expf(v0[j])); v1[j] = om[bj][1][j] * __builtin_amdgcn_rcpf(1.f + __expf(v1[j])); } }
                    u32x4 w; w.x = cvt_pk_bf16(v0[0], v0[1]); w.y = cvt_pk_bf16(v0[2], v0[3]); w.z = cvt_pk_bf16(v1[0], v1[1]); w.w = cvt_pk_bf16(v1[2], v1[3]);
                    *(u32x4*)(rowp + bj * HALF) = w; } }
    }
};
struct SwiGLUf8 {
    static constexpr bool PERM = true, AFTER_DRAIN = false;
    unsigned char* Hd; int ldh; float scale;
    __device__ __forceinline__ void operator()(const f32x4 (&acc)[2][2][4][2], const Unit& u, int wr, int wc, int fr, int fq) const {
        const int row0 = u.pm * BM + wr * 64 + fr, hc0 = u.pn * 128 + wc * 16 + 4 * fq;
#pragma unroll
        for (int ai = 0; ai < 2; ++ai)
#pragma unroll
            for (int m = 0; m < 4; ++m) { unsigned char* rowp = Hd + (size_t)(row0 + ai * HALF + m * 16) * ldh + hc0;
#pragma unroll
                for (int bj = 0; bj < 2; ++bj) { const f32x4 g = acc[ai][bj][m][0] * scale, uu = acc[ai][bj][m][1] * scale;
                    int w = __builtin_amdgcn_cvt_pk_fp8_f32(siluf(g[0]) * uu[0], siluf(g[1]) * uu[1], 0, false); w = __builtin_amdgcn_cvt_pk_fp8_f32(siluf(g[2]) * uu[2], siluf(g[3]) * uu[3], w, true);
                    *(int*)(rowp + bj * 64) = w; } }
    }
};
}

#ifndef ATT_PROBE
#define ATT_PROBE 0
#endif
namespace att {
constexpr int NW = 8, QBLK = 32, KVBLK = 64;
constexpr float SCALE = 0.07216878364870322f;
constexpr float THR = 2.f;
constexpr float PSH = 5.f;
constexpr int KP = 208;
constexpr int VP = 80;
constexpr int SHM_V = 128 * VP, SHM_K = 64 * KP;
constexpr int NBUF = 3;
constexpr int SLOT = SHM_K + SHM_V;
constexpr int OFF_K = 0, OFF_V = SHM_K, OFF_W = NBUF * SLOT, LDS_TOTAL = OFF_W + NW * 64 * 4;
static_assert(LDS_TOTAL <= RING_BYTES, "attention LDS");
#define KSWZ(row, colB) ((row) * 384 + ((colB) ^ (((row) & 7) << 4)))
#define SBAR() __builtin_amdgcn_sched_barrier(0)
__device__ __forceinline__ int crow(int r, int hi) { return (r & 3) + 8 * (r >> 2) + 4 * hi; }
__device__ __forceinline__ unsigned cvtpk(float lo, float hi) { unsigned r; asm volatile("v_cvt_pk_bf16_f32 %0, %1, %2" : "=v"(r) : "v"(lo), "v"(hi)); return r; }

__device__ __forceinline__ void partialSM(f32x16& p0, f32x16& p1, float& m_reg, float& mn, float& alpha) {
  constexpr float C = SCALE * 1.4426950408889634f;
  float pmax = p0[0];
#pragma unroll
  for (int r = 1; r < 16; ++r) pmax = fmaxf(pmax, p0[r]);
#pragma unroll
  for (int r = 0; r < 16; ++r) pmax = fmaxf(pmax, p1[r]);
  { auto rr = __builtin_amdgcn_permlane32_swap(__float_as_uint(pmax), __float_as_uint(pmax), false, false);
    pmax = fmaxf(__uint_as_float(rr[0]), __uint_as_float(rr[1])); }
  if (__builtin_expect(__all(pmax - m_reg <= THR / SCALE), 1)) { mn = m_reg; alpha = 1.f; }
  else { mn = fmaxf(m_reg, pmax); alpha = __builtin_amdgcn_exp2f((m_reg - mn) * C); m_reg = mn; }
  float mnC = PSH - mn * C;
#pragma unroll
  for (int r = 0; r < 16; ++r) p0[r] = fmaf(p0[r], C, mnC);
#pragma unroll
  for (int r = 0; r < 16; ++r) p1[r] = fmaf(p1[r], C, mnC);
#pragma unroll
  for (int r = 0; r < 16; ++r) p0[r] = __builtin_amdgcn_exp2f(p0[r]);
}
#define PK4(P, BASE, OUT) do { unsigned a0 = cvtpk(P[BASE + 0], P[BASE + 1]), a1 = cvtpk(P[BASE + 2], P[BASE + 3]);   \
    unsigned b0 = cvtpk(P[BASE + 4], P[BASE + 5]), b1 = cvtpk(P[BASE + 6], P[BASE + 7]);                              \
    auto r0 = __builtin_amdgcn_permlane32_swap(a0, b0, false, false); auto r1 = __builtin_amdgcn_permlane32_swap(a1, b1, false, false); \
    u32x4 w = {r0[0], r1[0], r0[1], r1[1]}; OUT = *reinterpret_cast<bf16x8*>(&w); } while (0)
typedef int v8i __attribute__((ext_vector_type(8)));
typedef int v4i __attribute__((ext_vector_type(4)));
__device__ __forceinline__ unsigned pk4f8(float a, float b, float c, float d) { int w = __builtin_amdgcn_cvt_pk_fp8_f32(a, b, 0, false); w = __builtin_amdgcn_cvt_pk_fp8_f32(c, d, w, true); return (unsigned)w; }
__device__ __forceinline__ unsigned pk4f8o(float a, float b, float c, float d, int old) { int w = __builtin_amdgcn_cvt_pk_fp8_f32(a, b, old, false); w = __builtin_amdgcn_cvt_pk_fp8_f32(c, d, w, true); return (unsigned)w; }
__device__ __forceinline__ void finishSM(f32x16& p0, f32x16& p1, float alpha, float& l_reg, v8i& p8) {
#pragma unroll
  for (int r = 0; r < 16; ++r) p1[r] = __builtin_amdgcn_exp2f(p1[r]);
#if ATT_PROBE == 2
#pragma unroll
  for (int r = 0; r < 16; ++r) { float t; asm volatile("v_exp_f32 %0, %1" : "=v"(t) : "v"(p0[r])); asm volatile("v_exp_f32 %0, %1" : "=v"(t) : "v"(p1[r])); }
#endif
  float ps = 0;
#pragma unroll
  for (int r = 0; r < 16; ++r) ps += p0[r];
#pragma unroll
  for (int r = 0; r < 16; ++r) ps += p1[r];
  { auto rr = __builtin_amdgcn_permlane32_swap(__float_as_uint(ps), __float_as_uint(ps), false, false);
    ps = __uint_as_float(rr[0]) + __uint_as_float(rr[1]); }
  l_reg = l_reg * alpha + ps;
#pragma unroll
  for (int w = 0; w < 4; ++w) { p8[w] = (int)pk4f8(p0[4 * w], p0[4 * w + 1], p0[4 * w + 2], p0[4 * w + 3]); p8[4 + w] = (int)pk4f8(p1[4 * w], p1[4 * w + 1], p1[4 * w + 2], p1[4 * w + 3]); }
}
__device__ __forceinline__ v8i ld32(const char* p) { const v4i a = *reinterpret_cast<const v4i*>(p), b = *reinterpret_cast<const v4i*>(p + 16); return __builtin_shufflevector(a, b, 0, 1, 2, 3, 4, 5, 6, 7); }
__device__ __forceinline__ void qkt1(f32x16& p0, f32x16& p1, const char* Ks, int kb, const v8i (&qf8)[3]) {
  v8i a0 = ld32(Ks + kb), a1 = ld32(Ks + kb + 32 * KP); const v8i c0 = ld32(Ks + kb + 64), c1 = ld32(Ks + kb + 64 + 32 * KP);
  asm volatile("v_mfma_f32_32x32x64_f8f6f4 %0, %1, %2, 0" : "=&v"(p0) : "v"(a0), "v"(qf8[0]));
  asm volatile("v_mfma_f32_32x32x64_f8f6f4 %0, %1, %2, 0" : "=&v"(p1) : "v"(a1), "v"(qf8[0]));
  a0 = ld32(Ks + kb + 128); a1 = ld32(Ks + kb + 128 + 32 * KP);
  asm volatile("v_mfma_f32_32x32x64_f8f6f4 %0, %1, %2, %0" : "+v"(p0) : "v"(c0), "v"(qf8[1]));
  asm volatile("v_mfma_f32_32x32x64_f8f6f4 %0, %1, %2, %0" : "+v"(p1) : "v"(c1), "v"(qf8[1]));
  asm volatile("v_mfma_f32_32x32x64_f8f6f4 %0, %1, %2, %0" : "+v"(p0) : "v"(a0), "v"(qf8[2]));
  asm volatile("v_mfma_f32_32x32x64_f8f6f4 %0, %1, %2, %0" : "+v"(p1) : "v"(a1), "v"(qf8[2]));
  asm volatile("s_nop 15\n\ts_nop 7" : "+v"(p0), "+v"(p1));
}

__device__ __forceinline__ void qkt(f32x16& p0, f32x16& p1, const char* Ks, int kb, const v8i (&qf8)[3]) {
  qkt1(p0, p1, Ks, kb, qf8);
#if ATT_PROBE == 1
  asm volatile("" : "+v"(kb)); qkt1(p0, p1, Ks, kb, qf8);
#endif
}
__device__ __forceinline__ u32x2 bf8_to_f8(bf16x8 v) { u32x2 o; o.x = pk4f8(bf2f((unsigned short)v[0]), bf2f((unsigned short)v[1]), bf2f((unsigned short)v[2]), bf2f((unsigned short)v[3]));
  o.y = pk4f8(bf2f((unsigned short)v[4]), bf2f((unsigned short)v[5]), bf2f((unsigned short)v[6]), bf2f((unsigned short)v[7])); return o; }
__device__ __forceinline__ int v_st(int k, int c) { const int kk = (k & ~0xC) | ((k & 4) << 1) | ((k & 8) >> 1); return ((kk >> 3) * 4 + (c >> 5)) * 512 + ((kk & 7) * 32 + (c & 31)) * 2; }
__device__ __forceinline__ int v_rd_base(int lane) { return ((lane & 3) << 3) | (((lane >> 2) & 3) << 6) | (((lane >> 4) & 1) << 5) | (((lane >> 5) & 1) << 8); }
constexpr int v_rd_off(int d0, int ks, int half) { return d0 * 512 + ks * 4096 + half * 2048; }
template <int OFF> __device__ __forceinline__ s16x4 tr_read(int vb) {
  s16x4 r; asm volatile("ds_read_b64_tr_b16 %0, %1 offset:%2" : "=&v"(r) : "v"(vb), "i"(OFF) : "memory"); return r;
}
__device__ __forceinline__ void pv_d0(f32x16* o, const char* Vs, int vrd, v8i p8) {
  asm volatile("s_nop 1" : "+v"(p8));
  const v8i v0 = ld32(Vs + vrd), v1 = ld32(Vs + vrd + 32 * VP), v2 = ld32(Vs + vrd + 64 * VP), v3 = ld32(Vs + vrd + 96 * VP);
  asm volatile("v_mfma_f32_32x32x64_f8f6f4 %0, %1, %2, %0" : "+v"(o[0]) : "v"(p8), "v"(v0));
  asm volatile("v_mfma_f32_32x32x64_f8f6f4 %0, %1, %2, %0" : "+v"(o[1]) : "v"(p8), "v"(v1));
  asm volatile("v_mfma_f32_32x32x64_f8f6f4 %0, %1, %2, %0" : "+v"(o[2]) : "v"(p8), "v"(v2));
  asm volatile("v_mfma_f32_32x32x64_f8f6f4 %0, %1, %2, %0" : "+v"(o[3]) : "v"(p8), "v"(v3));
}

#define MF8(ACC, A, B) asm volatile("v_mfma_f32_32x32x64_f8f6f4 %0, %1, %2, %0" : "+v"(ACC) : "v"(A), "v"(B))
#define MF8Z(ACC, A, B) asm volatile("v_mfma_f32_32x32x64_f8f6f4 %0, %1, %2, 0" : "=&v"(ACC) : "v"(A), "v"(B))
__device__ __forceinline__ void qkt_fin(f32x16& n0, f32x16& n1, const char* Ks, int kb, const v8i (&qf8)[3], f32x16& p0, f32x16& p1, float alpha, float& l_reg, v8i& p8) {
  v8i a0 = ld32(Ks + kb), a1 = ld32(Ks + kb + 32 * KP); const v8i c0 = ld32(Ks + kb + 64), c1 = ld32(Ks + kb + 64 + 32 * KP);
  float ps = 0.f, pt = 0.f;
  MF8Z(n0, a0, qf8[0]); SBAR();
#pragma unroll
  for (int r = 0; r < 4; ++r) p1[r] = __builtin_amdgcn_exp2f(p1[r]);
  ps += p0[0]; pt += p0[1]; ps += p0[2]; pt += p0[3]; ps += p0[4]; pt += p0[5]; SBAR();
  MF8Z(n1, a1, qf8[0]); SBAR();
  a0 = ld32(Ks + kb + 128); a1 = ld32(Ks + kb + 128 + 32 * KP);
#pragma unroll
  for (int r = 4; r < 8; ++r) p1[r] = __builtin_amdgcn_exp2f(p1[r]);
  ps += p0[6]; pt += p0[7]; ps += p0[8]; pt += p0[9]; ps += p0[10]; pt += p0[11]; SBAR();
  MF8(n0, c0, qf8[1]); SBAR();
#pragma unroll
  for (int r = 8; r < 12; ++r) p1[r] = __builtin_amdgcn_exp2f(p1[r]);
  ps += p0[12]; pt += p0[13]; ps += p0[14]; pt += p0[15]; ps += p1[0]; pt += p1[1]; SBAR();
  MF8(n1, c1, qf8[1]); SBAR();
#pragma unroll
  for (int r = 12; r < 16; ++r) p1[r] = __builtin_amdgcn_exp2f(p1[r]);
  ps += p1[2]; pt += p1[3]; ps += p1[4]; pt += p1[5]; ps += p1[6]; pt += p1[7]; SBAR();
  MF8(n0, a0, qf8[2]); SBAR();
  ps += p1[8]; pt += p1[9]; ps += p1[10]; pt += p1[11]; ps += p1[12]; pt += p1[13]; ps += p1[14]; pt += p1[15];
  p8[0] = (int)pk4f8(p0[0], p0[1], p0[2], p0[3]); p8[1] = (int)pk4f8(p0[4], p0[5], p0[6], p0[7]); p8[2] = (int)pk4f8(p0[8], p0[9], p0[10], p0[11]); SBAR();
  MF8(n1, a1, qf8[2]); SBAR();
  p8[3] = (int)pk4f8(p0[12], p0[13], p0[14], p0[15]);
#pragma unroll
  for (int w = 0; w < 4; ++w) p8[4 + w] = (int)pk4f8(p1[4 * w], p1[4 * w + 1], p1[4 * w + 2], p1[4 * w + 3]);
  ps += pt;
  { auto rr = __builtin_amdgcn_permlane32_swap(__float_as_uint(ps), __float_as_uint(ps), false, false); ps = __uint_as_float(rr[0]) + __uint_as_float(rr[1]); }
  l_reg = l_reg * alpha + ps;
  asm volatile("s_nop 15\n\ts_nop 7" : "+v"(n0), "+v"(n1));
}
__device__ __forceinline__ void pv_part(f32x16* o, const char* Vs, int vrd, v8i p8, f32x16& p0, f32x16& p1, float& m_reg, float& alpha) {
  constexpr float C = SCALE * 1.4426950408889634f;
  asm volatile("s_nop 1" : "+v"(p8));
  const v8i v0 = ld32(Vs + vrd), v1 = ld32(Vs + vrd + 32 * VP), v2 = ld32(Vs + vrd + 64 * VP), v3 = ld32(Vs + vrd + 96 * VP);
  MF8(o[0], p8, v0); SBAR();
  float pmax = fmaxf(fmaxf(p0[0], p0[1]), p0[2]);
#pragma unroll
  for (int r = 3; r < 15; r += 2) pmax = fmaxf(fmaxf(pmax, p0[r]), p0[r + 1]);
  pmax = fmaxf(fmaxf(pmax, p0[15]), p1[0]);
#pragma unroll
  for (int r = 1; r < 7; r += 2) pmax = fmaxf(fmaxf(pmax, p1[r]), p1[r + 1]);
  SBAR();
  MF8(o[1], p8, v1); SBAR();
#pragma unroll
  for (int r = 7; r < 15; r += 2) pmax = fmaxf(fmaxf(pmax, p1[r]), p1[r + 1]);
  pmax = fmaxf(pmax, p1[15]);
  { auto rr = __builtin_amdgcn_permlane32_swap(__float_as_uint(pmax), __float_as_uint(pmax), false, false); pmax = fmaxf(__uint_as_float(rr[0]), __uint_as_float(rr[1])); }
  const bool keep = __all(pmax - m_reg <= THR / SCALE);
  const float mn = keep ? m_reg : fmaxf(m_reg, pmax);
  alpha = __builtin_amdgcn_exp2f((m_reg - mn) * C); m_reg = mn;
  const float mnC = PSH - mn * C;
  SBAR();
  MF8(o[2], p8, v2); SBAR();
#pragma unroll
  for (int r = 0; r < 14; ++r) p0[r] = fmaf(p0[r], C, mnC);
  SBAR();
  MF8(o[3], p8, v3); SBAR();
  p0[14] = fmaf(p0[14], C, mnC); p0[15] = fmaf(p0[15], C, mnC);
#pragma unroll
  for (int r = 0; r < 16; ++r) p1[r] = fmaf(p1[r], C, mnC);
#pragma unroll
  for (int r = 0; r < 16; ++r) p0[r] = __builtin_amdgcn_exp2f(p0[r]);
}

#define MF8C(ACC, A, B, C_) asm volatile("v_mfma_f32_32x32x64_f8f6f4 %0, %1, %2, %3" : "=&v"(ACC) : "v"(A), "v"(B), "v"(C_))
constexpr float THR2 = THR * 1.4426950408889634f;
__device__ __forceinline__ void qkt_fin_b(f32x16& n0, f32x16& n1, const char* Ks, int kb, const v8i (&qf8)[3], const f32x16& mb, f32x16& p0, f32x16& p1, float alpha, float& l_reg, v8i& p8,
                                          v8i& f0, v8i& f1, v8i& f2, const char* Vs, int vrd) {
#pragma unroll
  for (int r = 8; r < 16; ++r) p0[r] = __builtin_amdgcn_exp2f(p0[r]);
  float ps = 0.f, pt = 0.f;
  MF8C(n0, f0, qf8[0], mb); SBAR();
  f0 = ld32(Ks + kb + 64 + 32 * KP);
#pragma unroll
  for (int r = 0; r < 4; ++r) p1[r] = __builtin_amdgcn_exp2f(p1[r]);
  ps += p0[0]; pt += p0[1]; ps += p0[2]; pt += p0[3]; ps += p0[4]; pt += p0[5]; SBAR();
  MF8C(n1, f1, qf8[0], mb); SBAR();
  f1 = ld32(Ks + kb + 128);
#pragma unroll
  for (int r = 4; r < 8; ++r) p1[r] = __builtin_amdgcn_exp2f(p1[r]);
  ps += p0[6]; pt += p0[7]; ps += p0[8]; pt += p0[9]; ps += p0[10]; pt += p0[11]; SBAR();
  MF8(n0, f2, qf8[1]); SBAR();
  f2 = ld32(Ks + kb + 128 + 32 * KP);
#pragma unroll
  for (int r = 8; r < 12; ++r) p1[r] = __builtin_amdgcn_exp2f(p1[r]);
  ps += p0[12]; pt += p0[13]; ps += p0[14]; pt += p0[15]; ps += p1[0]; pt += p1[1]; SBAR();
  MF8(n1, f0, qf8[1]); SBAR();
#pragma unroll
  for (int r = 12; r < 16; ++r) p1[r] = __builtin_amdgcn_exp2f(p1[r]);
  ps += p1[2]; pt += p1[3]; ps += p1[4]; pt += p1[5]; ps += p1[6]; pt += p1[7]; SBAR();
  MF8(n0, f1, qf8[2]); SBAR();
  ps += p1[8]; pt += p1[9]; ps += p1[10]; pt += p1[11]; ps += p1[12]; pt += p1[13]; ps += p1[14]; pt += p1[15];
  p8[0] = (int)pk4f8o(p0[0], p0[1], p0[2], p0[3], p8[0]); p8[1] = (int)pk4f8o(p0[4], p0[5], p0[6], p0[7], p8[1]); p8[2] = (int)pk4f8o(p0[8], p0[9], p0[10], p0[11], p8[2]); SBAR();
  MF8(n1, f2, qf8[2]); SBAR();
  f0 = ld32(Vs + vrd); f1 = ld32(Vs + vrd + 32 * VP); f2 = ld32(Vs + vrd + 64 * VP);
  p8[3] = (int)pk4f8o(p0[12], p0[13], p0[14], p0[15], p8[3]);
#pragma unroll
  for (int w = 0; w < 4; ++w) p8[4 + w] = (int)pk4f8o(p1[4 * w], p1[4 * w + 1], p1[4 * w + 2], p1[4 * w + 3], p8[4 + w]);
  ps += pt;
  { auto rr = __builtin_amdgcn_permlane32_swap(__float_as_uint(ps), __float_as_uint(ps), false, false); ps = __uint_as_float(rr[0]) + __uint_as_float(rr[1]); }
  l_reg = l_reg * alpha + ps;
  asm volatile("s_nop 15\n\ts_nop 7" : "+v"(n0), "+v"(n1));
}
__device__ __forceinline__ void pv_part_b(f32x16* o, const char* Vs, int vrd, v8i p8, f32x16& p0, f32x16& p1, f32x16& mb, float& alpha, v8i v0, const v8i v1, const v8i v2) {
  asm volatile("s_nop 1" : "+v"(p8));
  MF8(o[0], p8, v0); SBAR();
  v0 = ld32(Vs + vrd + 96 * VP);
  float pmax = fmaxf(fmaxf(p0[0], p0[1]), p0[2]);
#pragma unroll
  for (int r = 3; r < 15; r += 2) pmax = fmaxf(fmaxf(pmax, p0[r]), p0[r + 1]);
  pmax = fmaxf(fmaxf(pmax, p0[15]), p1[0]);
#pragma unroll
  for (int r = 1; r < 7; r += 2) pmax = fmaxf(fmaxf(pmax, p1[r]), p1[r + 1]);
  SBAR();
  MF8(o[1], p8, v1); SBAR();
#pragma unroll
  for (int r = 7; r < 15; r += 2) pmax = fmaxf(fmaxf(pmax, p1[r]), p1[r + 1]);
  pmax = fmaxf(pmax, p1[15]);
  { auto rr = __builtin_amdgcn_permlane32_swap(__float_as_uint(pmax), __float_as_uint(pmax), false, false); pmax = fmaxf(__uint_as_float(rr[0]), __uint_as_float(rr[1])); }
  const bool keep = __all(pmax <= PSH + THR2);
  SBAR();
  MF8(o[2], p8, v2); SBAR();
  alpha = 1.f;
  if (__builtin_expect(!keep, 0)) {
    const float d = fmaxf(pmax - PSH, 0.f); alpha = __builtin_amdgcn_exp2f(-d);
#pragma unroll
    for (int r = 0; r < 16; ++r) { mb[r] -= d; p0[r] -= d; p1[r] -= d; } }
#pragma unroll
  for (int r = 0; r < 8; ++r) p0[r] = __builtin_amdgcn_exp2f(p0[r]);
  SBAR();
  MF8(o[3], p8, v0); SBAR();
}

constexpr float PLIM = 440.f;
__device__ __forceinline__ void qkt_fin_c(f32x16& n0, f32x16& n1, const char* Ks, int kb, const v8i (&qf8)[3], f32x16& mb, f32x16& p0, f32x16& p1, float& l_reg, v8i& p8,
                                          v8i& f0, v8i& f1, v8i& f2, const char* Vs, int vrd, float& alpha_out) {
  float ps = 0.f, pt = 0.f;
  MF8C(n0, f0, qf8[0], mb); SBAR();
  f0 = ld32(Ks + kb + 64 + 32 * KP);
#pragma unroll
  for (int r = 0; r < 4; ++r) p1[r] = __builtin_amdgcn_exp2f(p1[r]);
  ps += p0[0]; pt += p0[1]; ps += p0[2]; pt += p0[3]; ps += p0[4]; pt += p0[5]; SBAR();
  MF8C(n1, f1, qf8[0], mb); SBAR();
  f1 = ld32(Ks + kb + 128);
#pragma unroll
  for (int r = 4; r < 8; ++r) p1[r] = __builtin_amdgcn_exp2f(p1[r]);
  ps += p0[6]; pt += p0[7]; ps += p0[8]; pt += p0[9]; ps += p0[10]; pt += p0[11]; SBAR();
  MF8(n0, f2, qf8[1]); SBAR();
  f2 = ld32(Ks + kb + 128 + 32 * KP);
#pragma unroll
  for (int r = 8; r < 12; ++r) p1[r] = __builtin_amdgcn_exp2f(p1[r]);
  ps += p0[12]; pt += p0[13]; ps += p0[14]; pt += p0[15]; ps += p1[0]; pt += p1[1]; SBAR();
  MF8(n1, f0, qf8[1]); SBAR();
#pragma unroll
  for (int r = 12; r < 16; ++r) p1[r] = __builtin_amdgcn_exp2f(p1[r]);
  ps += p1[2]; pt += p1[3]; ps += p1[4]; pt += p1[5]; ps += p1[6]; pt += p1[7]; SBAR();
  MF8(n0, f1, qf8[2]); SBAR();
  ps += p1[8]; pt += p1[9]; ps += p1[10]; pt += p1[11]; ps += p1[12]; pt += p1[13]; ps += p1[14]; pt += p1[15];
  ps += pt;
  { auto rr = __builtin_amdgcn_permlane32_swap(__float_as_uint(ps), __float_as_uint(ps), false, false); ps = __uint_as_float(rr[0]) + __uint_as_float(rr[1]); }
  SBAR();
  MF8(n1, f2, qf8[2]); SBAR();
  f0 = ld32(Vs + vrd); f1 = ld32(Vs + vrd + 32 * VP); f2 = ld32(Vs + vrd + 64 * VP);
  alpha_out = 1.f;
  if (__builtin_expect(!__all(ps <= PLIM), 0)) {
    asm volatile("s_nop 15\n\ts_nop 7" : "+v"(n0), "+v"(n1));
    float pm = fmaxf(fmaxf(p0[0], p0[1]), p0[2]);
#pragma unroll
    for (int r = 3; r < 15; r += 2) pm = fmaxf(fmaxf(pm, p0[r]), p0[r + 1]);
    pm = fmaxf(fmaxf(pm, p0[15]), p1[0]);
#pragma unroll
    for (int r = 1; r < 15; r += 2) pm = fmaxf(fmaxf(pm, p1[r]), p1[r + 1]);
    pm = fmaxf(pm, p1[15]);
    { auto rr = __builtin_amdgcn_permlane32_swap(__float_as_uint(pm), __float_as_uint(pm), false, false); pm = fmaxf(__uint_as_float(rr[0]), __uint_as_float(rr[1])); }
    const float d = fmaxf(__log2f(pm) - PSH, 0.f), sc = __builtin_amdgcn_exp2f(-d);
    alpha_out = sc; ps *= sc;
#pragma unroll
    for (int r = 0; r < 16; ++r) { p0[r] *= sc; p1[r] *= sc; mb[r] -= d; n0[r] -= d; n1[r] -= d; } }
  l_reg = l_reg * alpha_out + ps;
#pragma unroll
  for (int w = 0; w < 4; ++w) { p8[w] = (int)pk4f8o(p0[4 * w], p0[4 * w + 1], p0[4 * w + 2], p0[4 * w + 3], p8[w]); p8[4 + w] = (int)pk4f8o(p1[4 * w], p1[4 * w + 1], p1[4 * w + 2], p1[4 * w + 3], p8[4 + w]); }
  asm volatile("s_nop 15\n\ts_nop 7" : "+v"(n0), "+v"(n1));
}
__device__ __forceinline__ void pv_part_c(f32x16* o, const char* Vs, int vrd, v8i p8, f32x16& p0, v8i v0, const v8i v1, const v8i v2) {
  asm volatile("s_nop 1" : "+v"(p8), "+v"(o[0]), "+v"(o[1]), "+v"(o[2]), "+v"(o[3]));
  MF8(o[0], p8, v0); SBAR();
  v0 = ld32(Vs + vrd + 96 * VP);
#pragma unroll
  for (int r = 0; r < 4; ++r) p0[r] = __builtin_amdgcn_exp2f(p0[r]);
  SBAR();
  MF8(o[1], p8, v1); SBAR();
#pragma unroll
  for (int r = 4; r < 8; ++r) p0[r] = __builtin_amdgcn_exp2f(p0[r]);
  SBAR();
  MF8(o[2], p8, v2); SBAR();
#pragma unroll
  for (int r = 8; r < 12; ++r) p0[r] = __builtin_amdgcn_exp2f(p0[r]);
  SBAR();
  MF8(o[3], p8, v0); SBAR();
#pragma unroll
  for (int r = 12; r < 16; ++r) p0[r] = __builtin_amdgcn_exp2f(p0[r]);
}

__device__ __forceinline__ void attn_unit(const bf16* __restrict__ Qb, const char* __restrict__ KVh,
                                          bf16* __restrict__ Ob, int seq, int rope_t0, const float* __restrict__ rope, char* lds, const int tid) {
  const int wid = tid >> 6, lane = tid & 63, r32 = lane & 31, hi = lane >> 5;
  char* V_lds = lds + OFF_V; char* K_lds = lds + OFF_K;
  const int kb = r32 * KP + hi * 32;
  float* wsf = (float*)(lds + OFF_W) + wid * 64; float* li_l = wsf; float* al_l = wsf + 32;
  float m_reg = -1e30f, l_reg = 0; f32x16 o[4] = {}; bf16x8 qr[12];
  int qoff = (wid * QBLK + r32) * 192 + hi * 8; asm volatile("" : "+v"(qoff));
  const bf16* Qw = Qb + qoff;
#pragma unroll
  for (int d0 = 0; d0 < 12; ++d0) qr[d0] = *reinterpret_cast<const bf16x8*>(Qw + d0 * 16);
  if (rope_t0 >= 0) {
    const int t = rope_t0 + wid * QBLK + r32; const float* ta = rope + (t >> 6) * 32 + hi * 8; const float* tb = rope + (t & 63) * 32 + hi * 8;
#pragma unroll
    for (int e = 0; e < 8; ++e) {
      { const float x1 = bf2f((unsigned short)qr[8][e]), x2 = bf2f((unsigned short)qr[10][e]), c = ta[e], s = ta[16 + e];
        qr[8][e] = (short)f2bf(x1 * c - x2 * s); qr[10][e] = (short)f2bf(x2 * c + x1 * s); }
      { const float x1 = bf2f((unsigned short)qr[9][e]), x2 = bf2f((unsigned short)qr[11][e]), c = tb[e], s = tb[16 + e];
        qr[9][e] = (short)f2bf(x1 * c - x2 * s); qr[11][e] = (short)f2bf(x2 * c + x1 * s); }
    }
  }
  v8i qf8[3];
#pragma unroll
  for (int s = 0; s < 3; ++s)
#pragma unroll
    for (int a = 0; a < 4; ++a) { const bf16x8 v = qr[4 * s + a]; constexpr float QC = SCALE * 1.4426950408889634f;
      qf8[s][2 * a] = (int)pk4f8(bf2f((unsigned short)v[0]) * QC, bf2f((unsigned short)v[1]) * QC, bf2f((unsigned short)v[2]) * QC, bf2f((unsigned short)v[3]) * QC);
      qf8[s][2 * a + 1] = (int)pk4f8(bf2f((unsigned short)v[4]) * QC, bf2f((unsigned short)v[5]) * QC, bf2f((unsigned short)v[6]) * QC, bf2f((unsigned short)v[7]) * QC); }
  int l16 = lane * 16; asm volatile("" : "+v"(l16));
  const int widu = __builtin_amdgcn_readfirstlane(wid);
  const int vrd = r32 * VP + hi * 32;
#define SDMA(k0, b) do { asm volatile("" : "+v"(l16));   const char* kt_ = KVh + (long)((k0) >> 6) * SLOT; \
    _Pragma("unroll") for (int i_ = 0; i_ < 3; ++i_) { const int c_ = widu + 8 * i_; \
      if (c_ < 23) __builtin_amdgcn_global_load_lds((const unsigned*)(kt_ + c_ * 1024 + l16), (LAS unsigned*)(lds + (b) * SLOT + c_ * 1024), 16, 0, 0); } } while (0)
#define RESC(a) do { if (__any((a) < 1.f)) { if (hi == 0) al_l[r32] = (a); asm volatile("s_waitcnt lgkmcnt(0)" ::: "memory"); \
    _Pragma("unroll") for (int d = 0; d < 4; ++d) _Pragma("unroll") for (int r = 0; r < 16; ++r) o[d][r] *= al_l[crow(r, hi)]; asm volatile("s_nop 1" : "+v"(o[0]), "+v"(o[1]), "+v"(o[2]), "+v"(o[3])); } } while (0)
  f32x16 pA0, pA1, pB0, pB1, mb; float alA, alB; v8i p8 = {}; const int NTL = seq / KVBLK;
#define KLOAD(Ks_) v8i f0 = ld32((Ks_) + kb), f1 = ld32((Ks_) + kb + 32 * KP), f2 = ld32((Ks_) + kb + 64)
  __syncthreads();
  SDMA(0, 0); SDMA(KVBLK, 1); asm volatile("s_waitcnt vmcnt(0)" ::: "memory"); __syncthreads();
  qkt(pA0, pA1, K_lds, kb, qf8);
  { float pmax = pA0[0];
#pragma unroll
    for (int r = 1; r < 16; ++r) pmax = fmaxf(pmax, pA0[r]);
#pragma unroll
    for (int r = 0; r < 16; ++r) pmax = fmaxf(pmax, pA1[r]);
    { auto rr = __builtin_amdgcn_permlane32_swap(__float_as_uint(pmax), __float_as_uint(pmax), false, false); pmax = fmaxf(__uint_as_float(rr[0]), __uint_as_float(rr[1])); }
    const float b0_ = PSH - pmax; alA = 1.f;
#pragma unroll
    for (int r = 0; r < 16; ++r) { mb[r] = b0_; pA0[r] = __builtin_amdgcn_exp2f(pA0[r] + b0_); pA1[r] += b0_; } }
  int bj = 1;
  if (wid >= 4) __builtin_amdgcn_s_setprio(1);
  for (int j = 1; j + 1 < NTL; j += 2) {
    const int b0 = bj == 0 ? 2 : bj - 1, b1 = bj, b2 = bj == 2 ? 0 : bj + 1;
    { KLOAD(K_lds + b1 * SLOT); SDMA((j + 1) * KVBLK, b2);
      SBAR(); qkt_fin_c(pB0, pB1, K_lds + b1 * SLOT, kb, qf8, mb, pA0, pA1, l_reg, p8, f0, f1, f2, V_lds + b0 * SLOT, vrd, alA); SBAR();
      RESC(alA);
      pv_part_c(o, V_lds + b0 * SLOT, vrd, p8, pB0, f0, f1, f2); SBAR(); }
    asm volatile("s_waitcnt vmcnt(0)" ::: "memory"); __syncthreads();
    { KLOAD(K_lds + b2 * SLOT); if (j + 2 < NTL) SDMA((j + 2) * KVBLK, b0);
      SBAR(); qkt_fin_c(pA0, pA1, K_lds + b2 * SLOT, kb, qf8, mb, pB0, pB1, l_reg, p8, f0, f1, f2, V_lds + b1 * SLOT, vrd, alB); SBAR();
      RESC(alB);
      pv_part_c(o, V_lds + b1 * SLOT, vrd, p8, pA0, f0, f1, f2); SBAR(); }
    asm volatile("s_waitcnt vmcnt(0)" ::: "memory"); __syncthreads();
    bj = bj == 0 ? 2 : bj - 1;
  }
  { const int b0 = bj == 0 ? 2 : bj - 1, b1 = bj;
    { KLOAD(K_lds + b1 * SLOT);
      SBAR(); qkt_fin_c(pB0, pB1, K_lds + b1 * SLOT, kb, qf8, mb, pA0, pA1, l_reg, p8, f0, f1, f2, V_lds + b0 * SLOT, vrd, alA); SBAR();
      RESC(alA);
      pv_part_b(o, V_lds + b0 * SLOT, vrd, p8, pB0, pB1, mb, alB, f0, f1, f2); SBAR(); }
    RESC(alB);
#pragma unroll
    for (int r = 8; r < 16; ++r) pB0[r] = __builtin_amdgcn_exp2f(pB0[r]);
    finishSM(pB0, pB1, alB, l_reg, p8); SBAR();
    pv_d0(o, V_lds + b1 * SLOT, vrd, p8); }
  asm volatile("s_nop 15\n\ts_nop 7" : "+v"(o[0]), "+v"(o[1]), "+v"(o[2]), "+v"(o[3]));
  __builtin_amdgcn_s_setprio(0);
  if (hi == 0) li_l[r32] = l_reg; asm volatile("s_waitcnt lgkmcnt(0)" ::: "memory");
  float rli[16];
#pragma unroll
  for (int r = 0; r < 16; ++r) rli[r] = __builtin_amdgcn_rcpf(li_l[crow(r, hi)]);
  bf16* Ow = Ob + (long)(wid * QBLK) * 1024;
#pragma unroll
  for (int r = 0; r < 16; ++r) { const int orow = crow(r, hi);
#pragma unroll
    for (int d0 = 0; d0 < 4; ++d0) Ow[(long)orow * 1024 + d0 * 32 + r32] = (bf16)f2bf(o[d0][r] * rli[r]); }
#undef SDMA
#undef KLOAD
#undef RESC
}
}

struct Args { const float* in[N_IN]; float* out; unsigned char* ws; int ph_lo, ph_hi; };
struct Frame {
    LAS unsigned char* lds; int tid, lane, wave, G, gw, NGW;
    const float* const* in; float* out; unsigned char* ws;
};
__device__ __forceinline__ void row_decode(int row, int& b, int& j) { b = row >= NT ? 1 : 0; j = row - b * NT; }
__device__ __forceinline__ bf16* res_row(const Frame& F, int row) { return (bf16*)(F.ws + WS_RES) + (size_t)row * DM; }
__device__ __forceinline__ float* out_row(const Frame& F, int row) { int b, j; row_decode(row, b, j); return F.out + (size_t)(b * SEQ + (j - CTXL)) * DM; }
__device__ __forceinline__ const float* in_row(const Frame& F, int row) { int b, j; row_decode(row, b, j);
    return j < CTXL ? F.in[I_CTX] + (size_t)(b * CTXL + j) * DM : F.in[I_X] + (size_t)(b * SEQ + (j - CTXL)) * DM; }
__device__ __forceinline__ const float* mod_vec(const Frame& F, int layer, int row, int chunk) { int b, j; row_decode(row, b, j);
    const int who = j < CTXL ? 2 : b; return (const float*)(F.ws + WS_MOD) + (size_t)(layer * 3 + who) * 6144 + chunk * 1024; }

template <class Src, class Dst>
__device__ __forceinline__ void transpose_items(const Frame& F, int Ktot, int Ntot, bf16* WT, Src src, Dst dstrow) {
    LAS float* scr = (LAS float*)(F.lds + F.wave * 16384);
    const int nblk = Ntot / 32, nitems = (Ktot / 64) * nblk, lane = F.lane;
    for (int it = F.gw; it < nitems; it += F.NGW) {
        const int kb = it / nblk, nb = it - kb * nblk, k0 = 64 * kb, n0 = 32 * nb;
        float tv[32];
#pragma unroll
        for (int i = 0; i < 32; ++i) tv[i] = src(k0 + 2 * i + (lane >> 5), n0 + (lane & 31));
#pragma unroll
        for (int i = 0; i < 32; ++i) { const int kk = 2 * i + (lane >> 5); scr[kk * 33 + (lane & 31)] = tv[i]; }
        LDS_WAIT(); asm volatile("" ::: "memory");
        const int c = lane & 7;
#pragma unroll
        for (int j = 0; j < 4; ++j) { const int n = (lane >> 3) + 8 * j; const LAS float* s = scr + (8 * c) * 33 + n;
            u32x4 o; o.x = pk2(s[0 * 33], s[1 * 33]); o.y = pk2(s[2 * 33], s[3 * 33]); o.z = pk2(s[4 * 33], s[5 * 33]); o.w = pk2(s[6 * 33], s[7 * 33]);
            *(u32x4*)(WT + (size_t)dstrow(n0 + n) * Ktot + k0 + 8 * c) = o; }
        LDS_WAIT(); asm volatile("" ::: "memory");
    }
}
__device__ __forceinline__ unsigned pk4_fp8(float a, float b, float c, float d) { int w = __builtin_amdgcn_cvt_pk_fp8_f32(a, b, 0, false); w = __builtin_amdgcn_cvt_pk_fp8_f32(c, d, w, true); return (unsigned)w; }
template <class Src, class Dst>
__device__ __forceinline__ void transpose_items_f8(const Frame& F, int Ktot, int Ntot, unsigned char* WT, Src src, Dst dstrow, float wscale) {
    LAS float* scr = (LAS float*)(F.lds + F.wave * 16384);
    const int nblk = Ntot / 32, nitems = (Ktot / 64) * nblk, lane = F.lane;
    for (int it = F.gw; it < nitems; it += F.NGW) {
        const int kb = it / nblk, nb = it - kb * nblk, k0 = 64 * kb, n0 = 32 * nb;
        float tv[32];
#pragma unroll
        for (int i = 0; i < 32; ++i) tv[i] = src(k0 + 2 * i + (lane >> 5), n0 + (lane & 31));
#pragma unroll
        for (int i = 0; i < 32; ++i) { const int kk = 2 * i + (lane >> 5); scr[kk * 33 + (lane & 31)] = tv[i] * wscale; }
        LDS_WAIT(); asm volatile("" ::: "memory");
        const int c = lane & 3;
#pragma unroll
        for (int j = 0; j < 2; ++j) { const int n = (lane >> 2) + 16 * j; const LAS float* s = scr + (16 * c) * 33 + n;
            u32x4 o; o.x = pk4_fp8(s[0 * 33], s[1 * 33], s[2 * 33], s[3 * 33]); o.y = pk4_fp8(s[4 * 33], s[5 * 33], s[6 * 33], s[7 * 33]);
            o.z = pk4_fp8(s[8 * 33], s[9 * 33], s[10 * 33], s[11 * 33]); o.w = pk4_fp8(s[12 * 33], s[13 * 33], s[14 * 33], s[15 * 33]);
            *(u32x4*)(WT + (size_t)dstrow(n0 + n) * Ktot + k0 + 16 * c) = o; }
        LDS_WAIT(); asm volatile("" ::: "memory");
    }
}
__device__ __forceinline__ unsigned pk4_i8(float a, float b, float c, float d) {
    const int q0 = __float2int_rn(a), q1 = __float2int_rn(b), q2 = __float2int_rn(c), q3 = __float2int_rn(d);
    return (unsigned)(q0 & 255) | ((unsigned)(q1 & 255) << 8) | ((unsigned)(q2 & 255) << 16) | ((unsigned)q3 << 24); }
template <class Src, class Dst>
__device__ __forceinline__ void transpose_items_i8(const Frame& F, int Ktot, int Ntot, unsigned char* WT, Src src, Dst dstrow, const float* cmaxp, float* colsc) {
    LAS float* scr = (LAS float*)(F.lds + F.wave * 16384);
    const int nblk = Ntot / 32, nitems = (Ktot / 64) * nblk, lane = F.lane;
    for (int it = F.gw; it < nitems; it += F.NGW) {
        const int kb = it / nblk, nb = it - kb * nblk, k0 = 64 * kb, n0 = 32 * nb;
        float tv[32];
#pragma unroll
        for (int i = 0; i < 32; ++i) tv[i] = src(k0 + 2 * i + (lane >> 5), n0 + (lane & 31));
        float am = 1e-30f;
#pragma unroll
        for (int c = 0; c < 16; ++c) am = fmaxf(am, cmaxp[c * 12800 + n0 + (lane & 31)]);
        const float qscale = 127.f / am;
        if (kb == 0 && lane < 32) colsc[dstrow(n0 + lane)] = am * (1.f / 127.f);
#pragma unroll
        for (int i = 0; i < 32; ++i) { const int kk = 2 * i + (lane >> 5); scr[kk * 33 + (lane & 31)] = tv[i] * qscale; }
        LDS_WAIT(); asm volatile("" ::: "memory");
        const int c = lane & 3;
#pragma unroll
        for (int j = 0; j < 2; ++j) { const int n = (lane >> 2) + 16 * j; const LAS float* s = scr + (16 * c) * 33 + n;
            u32x4 o; o.x = pk4_i8(s[0 * 33], s[1 * 33], s[2 * 33], s[3 * 33]); o.y = pk4_i8(s[4 * 33], s[5 * 33], s[6 * 33], s[7 * 33]);
            o.z = pk4_i8(s[8 * 33], s[9 * 33], s[10 * 33], s[11 * 33]); o.w = pk4_i8(s[12 * 33], s[13 * 33], s[14 * 33], s[15 * 33]);
            *(u32x4*)(WT + (size_t)dstrow(n0 + n) * Ktot + k0 + 16 * c) = o; }
        LDS_WAIT(); asm volatile("" ::: "memory");
    }
}
__device__ __forceinline__ float wave_max(float v) {
#pragma unroll
    for (int off = 32; off > 0; off >>= 1) v = fmaxf(v, __shfl_xor(v, off));
    return v; }
__device__ __forceinline__ void absmax_cols(const Frame& F, const float* W, int K, int N, float* cmaxp, int wave0) {
    const int nblk = (N + 255) / 256, nitems = nblk * (K / 64);
    for (int it = F.gw >= wave0 ? F.gw - wave0 : F.gw - wave0 + F.NGW; it < nitems; it += F.NGW) { const int nb = it % nblk, kc = it / nblk, n = nb * 256 + 4 * F.lane;
        if (n < N) { const float* p = W + (size_t)(kc * 64) * N + n; f32x4 m = {0.f, 0.f, 0.f, 0.f};
#pragma unroll 32
            for (int k = 0; k < 64; ++k) { const f32x4 v = *(const f32x4*)(p + (size_t)k * N); m.x = fmaxf(m.x, fabsf(v.x)); m.y = fmaxf(m.y, fabsf(v.y)); m.z = fmaxf(m.z, fabsf(v.z)); m.w = fmaxf(m.w, fabsf(v.w)); }
            *(f32x4*)(cmaxp + kc * 12800 + n) = m; } }
}
struct SrcPlain { const float* W; int N, Nvalid; __device__ __forceinline__ float operator()(int k, int n) const { return n < Nvalid ? W[(size_t)k * N + n] : 0.f; } };
struct SrcUp { const float* Wq; const float* Wkv;
    __device__ __forceinline__ float operator()(int k, int n) const { if (k < 256) return n < 768 ? Wq[(size_t)k * 768 + n] : 0.f; return n >= 768 ? Wkv[(size_t)(k - 256) * 1024 + (n - 768)] : 0.f; } };
struct DstPlain { __device__ __forceinline__ int operator()(int n) const { return n; } };
struct DstGU { __device__ __forceinline__ int operator()(int n) const { const int u = n >= DFF ? 1 : 0, m = n - u * DFF; return 8 * (m >> 2) + 4 * u + (m & 3); } };

__device__ __forceinline__ void p0_prologue(const Frame& F) {
    absmax_cols(F, F.in[I_WINAB], 1024, 2000, (float*)(F.ws + WS_CMAXP) + 10752, 1400);
    transpose_items(F, 384, 1792, (bf16*)(F.ws + WS_W_UP), SrcUp{F.in[I_WUQ], F.in[I_WUKV]}, DstPlain{});
    transpose_items(F, 1024, 1024, (bf16*)(F.ws + WS_W_OUTAB), SrcPlain{F.in[I_WOUTAB], 1024, 1024}, DstPlain{});
    absmax_cols(F, F.in[I_FFNGU], 1024, 2 * DFF, (float*)(F.ws + WS_CMAXP) + 0, 0);
    absmax_cols(F, F.in[I_WINC], 1024, 5120, (float*)(F.ws + WS_CMAXP) + 5632, 700);
    __syncthreads();
    LAS float* sil = (LAS float*)F.lds;
    LAS float* red = (LAS float*)(F.lds + 16384);
    for (int i = F.tid; i < 3 * 1024; i += NTHREADS) { const int who = i >> 10, k = i & 1023; const float c = who < 2 ? F.in[I_C][who * 1024 + k] : F.in[I_CCTX][k]; sil[i] = siluf(c); }
    __syncthreads();
    for (int it = blockIdx.x; it < 2 * 96; it += F.G) {
        const int l = it / 96, col = (it % 96) * 64 + F.lane; const float* W = F.in[I_WMOD] + (size_t)l * 1024 * 6144 + col;
        float a0 = 0.f, a1 = 0.f, a2 = 0.f; const int kb = F.wave * 128;
#pragma unroll 1
        for (int k0 = 0; k0 < 128; k0 += 32) { float wv[32];
#pragma unroll
            for (int k = 0; k < 32; ++k) wv[k] = W[(size_t)(kb + k0 + k) * 6144];
#pragma unroll
            for (int k = 0; k < 32; ++k) { a0 += sil[kb + k0 + k] * wv[k]; a1 += sil[1024 + kb + k0 + k] * wv[k]; a2 += sil[2048 + kb + k0 + k] * wv[k]; } }
        red[(F.wave * 3 + 0) * 64 + F.lane] = a0; red[(F.wave * 3 + 1) * 64 + F.lane] = a1; red[(F.wave * 3 + 2) * 64 + F.lane] = a2;
        __syncthreads();
        if (F.wave < 3) { float s = 0.f;
#pragma unroll
            for (int w = 0; w < 8; ++w) s += red[(w * 3 + F.wave) * 64 + F.lane];
            ((float*)(F.ws + WS_MOD))[(size_t)(l * 3 + F.wave) * 6144 + col] = s + F.in[I_BMOD][l * 6144 + col]; }
        __syncthreads();
    }
    if (blockIdx.x == F.G - 1) for (int i = F.tid; i < 1024; i += NTHREADS) { const float l0 = F.in[I_LBLOG][i], l1 = F.in[I_LBLOG][1024 + i]; ((float*)(F.ws + WS_LB))[i] = 1.f / (1.f + expf(l0 - l1)); }
    if (blockIdx.x == F.G - 2) for (int i = F.tid; i < 256 * 16; i += NTHREADS) { const int pos = i >> 4, f = i & 15; const float inv = powf(10000.f, -(float)f / 16.f), a = (float)pos * inv;
        ((float*)(F.ws + WS_ROPE))[pos * 32 + f] = cosf(a); ((float*)(F.ws + WS_ROPE))[pos * 32 + 16 + f] = sinf(a); }
}

__device__ __forceinline__ void load_row_f32(const float* p, int lane, f32x4 (&v)[4]) {
#pragma unroll
    for (int j = 0; j < 4; ++j) v[j] = *((const f32x4*)p + lane + 64 * j);
}
__device__ __forceinline__ void load_row_bf16(const bf16* p, int lane, f32x4 (&v)[4]) {
#pragma unroll
    for (int j = 0; j < 4; ++j) { const u32x2 w = *((const u32x2*)p + lane + 64 * j); v[j] = (f32x4){bf2f(w.x & 0xffffu), bf2f(w.x >> 16), bf2f(w.y & 0xffffu), bf2f(w.y >> 16)}; }
}
__device__ __forceinline__ void load_row_raw(const bf16* p, int lane, u32x2 (&w)[4]) {
#pragma unroll
    for (int j = 0; j < 4; ++j) w[j] = *((const u32x2*)p + lane + 64 * j);
}
__device__ __forceinline__ void cvt_row(const u32x2 (&w)[4], f32x4 (&v)[4]) {
#pragma unroll
    for (int j = 0; j < 4; ++j) v[j] = (f32x4){bf2f(w[j].x & 0xffffu), bf2f(w[j].x >> 16), bf2f(w[j].y & 0xffffu), bf2f(w[j].y >> 16)};
}
__device__ __forceinline__ void store_res(bf16* xr, int idx, const f32x4 v) { u32x2 w; w.x = pk2(v.x, v.y); w.y = pk2(v.z, v.w); *((u32x2*)xr + idx) = w; }
__device__ __forceinline__ float row_rstd(const f32x4 (&v)[4]) { float s = 0.f;
#pragma unroll
    for (int j = 0; j < 4; ++j) s += (v[j].x * v[j].x + v[j].y * v[j].y) + (v[j].z * v[j].z + v[j].w * v[j].w);
    return rsqrtf(wave_sum(s) * (1.f / DM) + RMS_EPS); }
__device__ __forceinline__ void norm_mod_store(const f32x4 (&v)[4], const float* gain, const float* sh, const float* sc, bf16* orow, int lane) {
    const float rstd = row_rstd(v);
#pragma unroll
    for (int j = 0; j < 4; ++j) { const int idx = lane + 64 * j; const f32x4 g = ((const f32x4*)gain)[idx], a = ((const f32x4*)sh)[idx], c = ((const f32x4*)sc)[idx];
        const f32x4 h = (v[j] * rstd * g) * (1.f + c) + a;
        u32x2 w; w.x = pk2(h.x, h.y); w.y = pk2(h.z, h.w); *((u32x2*)orow + idx) = w; }
}
__device__ __forceinline__ void load_vec(const float* p, int lane, f32x4 (&v)[4]) {
#pragma unroll
    for (int j = 0; j < 4; ++j) v[j] = ((const f32x4*)p)[lane + 64 * j];
}
__device__ __forceinline__ int row_who(int row) { int b, j; row_decode(row, b, j); return j < CTXL ? 2 : b; }
template <bool I8OUT = false>
__device__ __forceinline__ void norm_mod_store_r(const f32x4 (&v)[4], const f32x4 (&g)[4], const f32x4 (&sh)[4], const f32x4 (&sc)[4], bf16* orow, int lane, float* sa = nullptr) {
    const float rstd = row_rstd(v);
    if (I8OUT) {
        f32x4 h[4]; float am = 0.f;
#pragma unroll
        for (int j = 0; j < 4; ++j) { h[j] = (v[j] * rstd * g[j]) * (1.f + sc[j]) + sh[j]; am = fmaxf(fmaxf(am, fmaxf(fabsf(h[j].x), fabsf(h[j].y))), fmaxf(fabsf(h[j].z), fabsf(h[j].w))); }
        am = fmaxf(wave_max(am), 1e-20f); const float qs = 127.f / am;
#pragma unroll
        for (int j = 0; j < 4; ++j) *((unsigned*)orow + lane + 64 * j) = pk4_i8(h[j].x * qs, h[j].y * qs, h[j].z * qs, h[j].w * qs);
        if (lane == 0) *sa = am * (1.f / 127.f);
    } else {
#pragma unroll
    for (int j = 0; j < 4; ++j) { const f32x4 h = (v[j] * rstd * g[j]) * (1.f + sc[j]) + sh[j];
        u32x2 w; w.x = pk2(h.x, h.y); w.y = pk2(h.z, h.w); *((u32x2*)orow + lane + 64 * j) = w; }
    }
}
__device__ __forceinline__ void p1_norm0(const Frame& F) {
    const float* gain = F.in[I_GAINS] + 0;
    f32x4 v[4], vn[4], vg[4], vsh[4], vsc[4]; int cur = -1; load_vec(gain, F.lane, vg); int row = F.gw; if (row < NR) load_row_f32(in_row(F, row), F.lane, v);
    while (row < NR) { const int nrow = row + F.NGW; if (nrow < NR) load_row_f32(in_row(F, nrow), F.lane, vn);
        { const int who = row_who(row); if (who != cur) { cur = who; load_vec(mod_vec(F, 0, row, 0), F.lane, vsh); load_vec(mod_vec(F, 0, row, 1), F.lane, vsc); } }
        norm_mod_store_r<true>(v, vg, vsh, vsc, (bf16*)(F.ws + WS_H + (size_t)row * DM), F.lane, (float*)(F.ws + WS_SA) + row);
#pragma unroll
        for (int j = 0; j < 4; ++j) v[j] = vn[j];
        row = nrow; }
    __syncthreads(); transpose_items_i8(F, 1024, 2048, F.ws + WS_W_INAB, SrcPlain{F.in[I_WINAB], 2000, 2000}, DstPlain{}, (const float*)(F.ws + WS_CMAXP) + 10752, (float*)(F.ws + WS_CTL) + CW_COLSC + 10752); __syncthreads();
}
template <bool FIRST, bool I8OUT = false>
__device__ __forceinline__ void resnorm_rows(const Frame& F, const bf16* Y, int layer_a, int gate_chunk, const float* gain_a, int layer_b, int sh_chunk, const float* gain_b, bf16* H, int mode  , int gw, int ngw) {
    u32x2 yw[4], ywn[4], xw[4], xwn[4]; f32x4 x[4], xn[4], vga[4], vgb[4], vgt[4], vsh[4], vsc[4]; int cur = -1;
    load_vec(gain_a, F.lane, vga); load_vec(gain_b, F.lane, vgb);
    int row = gw;
#define RN_SKIP(r) do { if (mode) { while ((r) < NR) { int b_, j_; row_decode((r), b_, j_); if ((mode == 1) == (j_ >= CTXL)) break; (r) += ngw; } } } while (0)
    RN_SKIP(row);
    if (row < NR) { load_row_raw(Y + (size_t)row * DM, F.lane, yw); if (FIRST) load_row_f32(in_row(F, row), F.lane, x); else load_row_raw(res_row(F, row), F.lane, xw); }
    while (row < NR) {
        int nrow = row + ngw;
        RN_SKIP(nrow);
        if (nrow < NR) { load_row_raw(Y + (size_t)nrow * DM, F.lane, ywn); if (FIRST) load_row_f32(in_row(F, nrow), F.lane, xn); else load_row_raw(res_row(F, nrow), F.lane, xwn); }
        f32x4 y[4]; cvt_row(yw, y); if (!FIRST) cvt_row(xw, x); bf16* xr = res_row(F, row);
        { const int who = row_who(row); if (who != cur) { cur = who; load_vec(mod_vec(F, layer_a, row, gate_chunk), F.lane, vgt); load_vec(mod_vec(F, layer_b, row, sh_chunk), F.lane, vsh); load_vec(mod_vec(F, layer_b, row, sh_chunk + 1), F.lane, vsc); } }
        const float rstd = row_rstd(y);
#pragma unroll
        for (int q = 0; q < 4; ++q) { const int idx = F.lane + 64 * q; x[q] = x[q] + vgt[q] * (y[q] * rstd * vga[q]); store_res(xr, idx, x[q]); }
        norm_mod_store_r<I8OUT>(x, vgb, vsh, vsc, I8OUT ? (bf16*)((unsigned char*)H + (size_t)row * DM) : H + (size_t)row * DM, F.lane, (float*)(F.ws + WS_SA) + row);
#pragma unroll
        for (int q = 0; q < 4; ++q) { yw[q] = ywn[q]; if (FIRST) x[q] = xn[q]; else xw[q] = xwn[q]; }
        row = nrow;
    }
#undef RN_SKIP
}
__device__ __forceinline__ void p3_prep(const Frame& F) {
    const bf16* P = (const bf16*)(F.ws + WS_P); bf16* A2 = (bf16*)(F.ws + WS_A2); bf16* KR = (bf16*)(F.ws + WS_KR); bf16* QKP = (bf16*)(F.ws + WS_QKP); float* GT = (float*)(F.ws + WS_GATES);
    const float* rope = (const float*)(F.ws + WS_ROPE); const int lane = F.lane;
    for (int row = F.gw; row < NR; row += F.NGW) {
        int b, j; row_decode(row, b, j); const bf16* pr = P + (size_t)row * P_LD;
        {
            const u32x2 w = *((const u32x2*)pr + lane); const f32x4 v = (f32x4){bf2f(w.x & 0xffffu), bf2f(w.x >> 16), bf2f(w.y & 0xffffu), bf2f(w.y >> 16)};
            const float rstd = rsqrtf(wave_sum(v.x * v.x + v.y * v.y + v.z * v.z + v.w * v.w) * (1.f / 256.f) + RMS_EPS); const f32x4 g = ((const f32x4*)F.in[I_QGAIN])[lane]; const f32x4 h = v * rstd * g;
            u32x2 o; o.x = pk2(h.x, h.y); o.y = pk2(h.z, h.w); *((u32x2*)(A2 + (size_t)row * 384) + lane) = o; }
        {
            const unsigned w = *((const unsigned*)(pr + 256) + lane); const float v0 = bf2f(w & 0xffffu), v1 = bf2f(w >> 16);
            const float rstd = rsqrtf(wave_sum(v0 * v0 + v1 * v1) * (1.f / 128.f) + RMS_EPS); const float g0 = F.in[I_KVGAIN][2 * lane], g1 = F.in[I_KVGAIN][2 * lane + 1];
            *((unsigned*)(A2 + (size_t)row * 384 + 256) + lane) = pk2(v0 * rstd * g0, v1 * rstd * g1); }
        {
            if (lane < 32) { float x1 = bf2f(pr[384 + lane]), x2 = bf2f(pr[384 + 32 + lane]);
                if (j >= CTXL) { const int t = j - CTXL; const int pos = lane < 16 ? (t >> 6) : (t & 63), f = lane & 15; const float c = rope[pos * 32 + f], s = rope[pos * 32 + 16 + f];
                    const float o1 = x1 * c - x2 * s, o2 = x2 * c + x1 * s; x1 = o1; x2 = o2; }
                bf16* kr = KR + (size_t)row * 64; kr[lane] = (bf16)f2bf(x1); kr[32 + lane] = (bf16)f2bf(x2); } }
        {
            const bool hasp = (j != 0) && (j != CTXL), hasn = (j != CTXL - 1) && (j != NT - 1);
            const bf16x8 xc = *((const bf16x8*)(pr + 448) + lane); bf16x8 xp = {}, xn = {};
            if (hasp) xp = *((const bf16x8*)(pr - P_LD + 448) + lane);
            if (hasn) xn = *((const bf16x8*)(pr + P_LD + 448) + lane);
            const float* cw = F.in[I_CONVW]; const float* cb = F.in[I_CONVB]; const float ksc = lane >= 32 ? 0.125f : 1.f; unsigned o[4];
#pragma unroll
            for (int e = 0; e < 8; e += 2) { float r[2];
#pragma unroll
                for (int q = 0; q < 2; ++q) { const int ch = lane * 8 + e + q;
                    const float a = cw[ch] * bf2f((unsigned short)xp[e + q]) + cw[512 + ch] * bf2f((unsigned short)xc[e + q]) + cw[1024 + ch] * bf2f((unsigned short)xn[e + q]) + cb[ch];
                    r[q] = siluf(a) * ksc; }
                o[e >> 1] = pk2(r[0], r[1]); }
            *((u32x4*)(QKP + (size_t)row * 512) + lane) = (u32x4){o[0], o[1], o[2], o[3]}; }
        {
            if (lane < 16) { float g = GT[(size_t)row * 16 + lane] + F.in[I_GATEB][lane]; const int gi = lane >> 2; if (gi & 1) g = logsig(g); ((float*)(F.ws + WS_GL))[(size_t)row * 16 + lane] = g; } }
    }
}

namespace lin {
using att::crow; using att::cvtpk;
__device__ __forceinline__ float wave_prefix_add(float v, int lane) {
#pragma unroll
    for (int o = 1; o < 64; o <<= 1) { const float t = __shfl_up(v, o); if (lane >= o) v += t; }
    return v; }
__device__ __forceinline__ float wave_suffix_add(float v, int lane) {
#pragma unroll
    for (int o = 1; o < 64; o <<= 1) { const float t = __shfl_down(v, o); if (lane + o < 64) v += t; }
    return v; }
__device__ __forceinline__ float wave_prefix_max(float v, int lane) {
#pragma unroll
    for (int o = 1; o < 64; o <<= 1) { const float t = __shfl_up(v, o); if (lane >= o) v = fmaxf(v, t); }
    return v; }
__device__ __forceinline__ float wave_suffix_max(float v, int lane) {
#pragma unroll
    for (int o = 1; o < 64; o <<= 1) { const float t = __shfl_down(v, o); if (lane + o < 64) v = fmaxf(v, t); }
    return v; }
__device__ __forceinline__ float wave_max(float v) {
#pragma unroll
    for (int o = 1; o < 64; o <<= 1) v = fmaxf(v, __shfl_xor(v, o));
    return v; }
__device__ __forceinline__ unsigned voff(unsigned row, unsigned ch) { return 256u * row + 16u * (ch ^ (((row & 3u) << 2) | ((row >> 2) & 3u))); }
__device__ __forceinline__ unsigned v_tr_addr(unsigned lane, unsigned row0, unsigned c, unsigned t) {
    const unsigned h = lane >> 5, blk = (lane >> 4) & 1u, q = (lane & 15u) >> 2, p = lane & 3u;
    return voff(row0 + 8u * h + 4u * t + q, 4u * c + 2u * blk + (p >> 1)) + 8u * (p & 1u); }
__device__ __forceinline__ unsigned p_tr_addr(unsigned lane, unsigned pitchB, unsigned row0, unsigned c, unsigned t) {
    const unsigned h = lane >> 5, blk = (lane >> 4) & 1u, q = (lane & 15u) >> 2, p = lane & 3u;
    return (row0 + 8u * h + 4u * t + q) * pitchB + c * 64u + blk * 32u + p * 8u; }
__device__ __forceinline__ bf16x8 tr_frag(LAS unsigned char* base, unsigned a0, unsigned a1) {
    const s16x4 lo = __builtin_amdgcn_ds_read_tr16_b64_v4i16((LAS s16x4*)(base + a0)), hi = __builtin_amdgcn_ds_read_tr16_b64_v4i16((LAS s16x4*)(base + a1));
    return (bf16x8){lo[0], lo[1], lo[2], lo[3], hi[0], hi[1], hi[2], hi[3]}; }
#define LPK4(P, BASE, OUT) do { unsigned a0 = cvtpk(P[BASE + 0], P[BASE + 1]), a1 = cvtpk(P[BASE + 2], P[BASE + 3]);   \
    unsigned b0 = cvtpk(P[BASE + 4], P[BASE + 5]), b1 = cvtpk(P[BASE + 6], P[BASE + 7]);                              \
    auto r0 = __builtin_amdgcn_permlane32_swap(a0, b0, false, false); auto r1 = __builtin_amdgcn_permlane32_swap(a1, b1, false, false); \
    u32x4 w = {r0[0], r1[0], r0[1], r1[1]}; OUT = *reinterpret_cast<bf16x8*>(&w); } while (0)
__device__ __forceinline__ float half_sum32(float v) {
#pragma unroll
    for (int o = 1; o < 32; o <<= 1) v += __shfl_xor(v, o);
    return v; }
__device__ __forceinline__ float swap_add(float v) { auto rr = __builtin_amdgcn_permlane32_swap(__float_as_uint(v), __float_as_uint(v), false, false); return __uint_as_float(rr[0]) + __uint_as_float(rr[1]); }
}

namespace ml {
using att::cvtpk;
constexpr int ITEM_U = 8448;
constexpr int ITEM_S = 16896;
constexpr int L_V = 0, L_K = 65536, L_SC = 98304, L_WS = 98304 + 8192, L_CT = 98304 + 8192 + 1024;

__device__ __forceinline__ void load_gates(const float* GT, int row0, int h, int dir, int lane, float (&li)[4], float (&lf)[4]) {
#pragma unroll
    for (int i = 0; i < 4; ++i) { const float* g = GT + (size_t)(row0 + 4 * lane + i) * 16; li[i] = g[(2 * dir) * 4 + h]; lf[i] = g[(2 * dir + 1) * 4 + h]; }
}
__device__ __forceinline__ float cum_gates(const float (&lf)[4], int dir, int lane, float (&G)[4]) {
    float tot;
    if (dir == 0) { G[0] = lf[0]; G[1] = G[0] + lf[1]; G[2] = G[1] + lf[2]; G[3] = G[2] + lf[3]; const float inc = lin::wave_prefix_add(G[3], lane), ex = inc - G[3];
#pragma unroll
        for (int i = 0; i < 4; ++i) G[i] += ex;
        tot = __shfl(inc, 63); }
    else { G[3] = lf[3]; G[2] = G[3] + lf[2]; G[1] = G[2] + lf[1]; G[0] = G[1] + lf[0]; const float inc = lin::wave_suffix_add(G[0], lane), ex = inc - G[0];
#pragma unroll
        for (int i = 0; i < 4; ++i) G[i] += ex;
        tot = __shfl(inc, 0); }
    return tot;
}

__device__ __forceinline__ void pass_b(const Frame& F) {
    const bf16* P = (const bf16*)(F.ws + WS_P); const bf16* QKP = (const bf16*)(F.ws + WS_QKP); const float* GT = (const float*)(F.ws + WS_GL); float* MLU = (float*)(F.ws + WS_MLU);
    LAS unsigned char* Vl = F.lds + L_V; LAS unsigned char* Kl = F.lds + L_K; LAS float* wts = (LAS float*)(F.lds + L_SC); LAS float* part = (LAS float*)(F.lds + L_SC + 2048);
    const int tid = F.tid, lane = F.lane, wave = F.wave;
    for (int it = blockIdx.x; it < 16 * NGRP; it += F.G) {
        const int seq = it / NGRP, g = it - seq * NGRP, dir = seq & 1, h = (seq >> 1) & 3, b = seq >> 3, row0 = b * NT + g * 256;
        float* rec = MLU + (size_t)it * ITEM_U;
        __syncthreads();
        if (wave == 0) { float li[4], lf[4], G[4]; load_gates(GT, row0, h, dir, lane, li, lf); const float tot = cum_gates(lf, dir, lane, G);
            float e[4], mx = -3.0e38f;
#pragma unroll
            for (int i = 0; i < 4; ++i) { e[i] = li[i] + tot - G[i]; mx = fmaxf(mx, e[i]); }
            mx = lin::wave_max(mx);
#pragma unroll
            for (int i = 0; i < 4; ++i) wts[4 * lane + i] = __expf(e[i] - mx);
            if (lane == 0) { rec[8192 + 64] = mx; rec[8192 + 65] = tot; } }
        { const bf16* vb_ = P + (size_t)row0 * P_LD + 960 + h * 128;
#pragma unroll
            for (int c = 0; c < 8; ++c) { const int idx = c * 512 + tid, r = idx >> 4, ch = idx & 15; *(LAS bf16x8*)(Vl + (r >> 6) * 16384 + att::v_st(r & 63, ch * 8)) = *((const bf16x8*)(vb_ + (size_t)r * P_LD) + ch); } }
        __syncthreads();
        { const bf16* kb_ = QKP + (size_t)row0 * 512 + 256 + h * 64;
#pragma unroll
            for (int c = 0; c < 4; ++c) { const int idx = c * 512 + tid, r = idx >> 3, c0 = (idx & 7) * 8; const float w = wts[r]; const bf16x8 kv = *(const bf16x8*)(kb_ + (size_t)r * 512 + c0); u32x4 o;
                o.x = pk2(bf2f((unsigned short)kv[0]) * w, bf2f((unsigned short)kv[1]) * w); o.y = pk2(bf2f((unsigned short)kv[2]) * w, bf2f((unsigned short)kv[3]) * w);
                o.z = pk2(bf2f((unsigned short)kv[4]) * w, bf2f((unsigned short)kv[5]) * w); o.w = pk2(bf2f((unsigned short)kv[6]) * w, bf2f((unsigned short)kv[7]) * w);
                *(LAS u32x4*)(Kl + r * 128 + c0 * 2) = o; } }
        __syncthreads();
        { const int ei = wave >> 1, di = wave & 1; f32x16 acc = {}; const int vbase = att::v_rd_base(lane);
#pragma unroll
            for (int ks = 0; ks < 16; ++ks) {
                const bf16x8 a = lin::tr_frag(Vl + vbase + (ks >> 2) * 16384, ei * 512 + (ks & 3) * 4096, ei * 512 + (ks & 3) * 4096 + 2048);
                const bf16x8 bb = lin::tr_frag(Kl, lin::p_tr_addr(lane, 128, 16 * ks, di, 0), lin::p_tr_addr(lane, 128, 16 * ks, di, 1));
                acc = __builtin_amdgcn_mfma_f32_32x32x16_bf16(a, bb, acc, 0, 0, 0); }
            const int hi = lane >> 5;
#pragma unroll
            for (int r = 0; r < 16; ++r) rec[(32 * ei + lin::crow(r, hi)) * 64 + 32 * di + (lane & 31)] = acc[r]; }
        { const int d = tid & 63, sg = tid >> 6; float s = 0.f;
#pragma unroll 8
            for (int r = 0; r < 32; ++r) s += bf2f(*(LAS unsigned short*)(Kl + (sg * 32 + r) * 128 + d * 2));
            part[sg * 64 + d] = s; }
        __syncthreads();
        if (tid < 64) { float s = 0.f;
#pragma unroll
            for (int sg = 0; sg < 8; ++sg) s += part[sg * 64 + tid];
            rec[8192 + tid] = s; }
    }
}

__device__ __forceinline__ void pass_c(const Frame& F) {
    const float* __restrict__ MLU = (const float*)(F.ws + WS_MLU); unsigned char* __restrict__ MLS = F.ws + WS_MLS;
    for (int wgi = blockIdx.x; wgi < 16 * 16; wgi += F.G) {
        const int seq = wgi >> 4, part = wgi & 15, dir = seq & 1, el = part * 512 + F.tid;
        const bool do_n = (part == 0) && (F.tid < 64);
        float c = 0.f, n = 0.f, m = -1.0e30f;
#pragma unroll 1
        for (int blk = 0; blk < 3; ++blk) {
            float u[22], nu[22], mU[22], D[22];
#pragma unroll
            for (int i = 0; i < 22; ++i) { const int st = blk * 22 + i; if (st >= NGRP) break; const int g = dir == 0 ? st : (st == 0 ? 0 : NGRP - st); const float* rec = MLU + (size_t)(seq * NGRP + g) * ITEM_U;
                mU[i] = rec[8192 + 64]; D[i] = rec[8192 + 65]; u[i] = rec[el]; nu[i] = do_n ? rec[8192 + F.tid] : 0.f; }
#pragma unroll
            for (int i = 0; i < 22; ++i) { const int st = blk * 22 + i; if (st >= NGRP) break; const int g = dir == 0 ? st : (st == 0 ? 0 : NGRP - st); unsigned char* srec = MLS + (size_t)(seq * NGRP + g) * ITEM_S;
                ((bf16*)srec)[el] = (bf16)f2bf(c);
                if (do_n) ((float*)(srec + 16384))[F.tid] = n;
                if (part == 0 && F.tid == 0) *(float*)(srec + 16384 + 256) = m;
                const float mn = fmaxf(m + D[i], mU[i]), f1 = __expf(m + D[i] - mn), f2 = __expf(mU[i] - mn);
                c = f1 * c + f2 * u[i]; n = f1 * n + f2 * nu[i]; m = mn; }
        }
    }
}

__device__ __forceinline__ void pass_d(const Frame& F) {
    const bf16* P = (const bf16*)(F.ws + WS_P); const bf16* QKP = (const bf16*)(F.ws + WS_QKP); const float* GT = (const float*)(F.ws + WS_GL);
    const unsigned char* MLS = F.ws + WS_MLS; bf16* CAT = (bf16*)(F.ws + WS_CAT);
    LAS unsigned char* Vl = F.lds + L_V; LAS unsigned char* Kl = F.lds + L_K; LAS float* sc = (LAS float*)(F.lds + L_SC);
    const int tid = F.tid, lane = F.lane, wave = F.wave, t32 = lane & 31, hi = lane >> 5;
    LAS float* wsc = (LAS float*)(F.lds + L_WS) + wave * 32;
    for (int it = blockIdx.x; it < 8 * NGRP; it += F.G) {
        const int bh = it / NGRP, g = it - bh * NGRP, b = bh >> 2, h = bh & 3, row0 = b * NT + g * 256;
        __syncthreads();
        if (wave < 2) { const int dir = wave; const unsigned char* srec = MLS + (size_t)((bh * 2 + dir) * NGRP + g) * ITEM_S; const float mg = *(const float*)(srec + 16384 + 256);
            float li[4], lf[4], G[4]; load_gates(GT, row0, h, dir, lane, li, lf); (void)cum_gates(lf, dir, lane, G);
            float a[4], M[4];
#pragma unroll
            for (int i = 0; i < 4; ++i) a[i] = li[i] - G[i];
            if (dir == 0) { M[0] = a[0]; M[1] = fmaxf(M[0], a[1]); M[2] = fmaxf(M[1], a[2]); M[3] = fmaxf(M[2], a[3]);
                const float inc = lin::wave_prefix_max(M[3], lane); float ex = __shfl_up(inc, 1); if (lane == 0) ex = -3.0e38f; ex = fmaxf(ex, mg);
#pragma unroll
                for (int i = 0; i < 4; ++i) M[i] = fmaxf(M[i], ex); }
            else { M[3] = a[3]; M[2] = fmaxf(M[3], a[2]); M[1] = fmaxf(M[2], a[1]); M[0] = fmaxf(M[1], a[0]);
                const float inc = lin::wave_suffix_max(M[0], lane); float ex = __shfl_down(inc, 1); if (lane == 63) ex = -3.0e38f; ex = fmaxf(ex, mg);
#pragma unroll
                for (int i = 0; i < 4; ++i) M[i] = fmaxf(M[i], ex); }
            LAS float* s = sc + dir * 1024;
#pragma unroll
            for (int i = 0; i < 4; ++i) { const int r = 4 * lane + i; s[r] = a[i]; s[256 + r] = M[i]; s[512 + r] = __expf(-G[i] - M[i]); s[768 + r] = __expf(mg - M[i]); } }
        {
#pragma unroll 1
            for (int dd = 0; dd < 2; ++dd) { const bf16x8* src = (const bf16x8*)(MLS + (size_t)((bh * 2 + dd) * NGRP + g) * ITEM_S);
#pragma unroll
                for (int c = 0; c < 2; ++c) *(LAS bf16x8*)(F.lds + L_CT + dd * 16384 + tid * 32 + c * 16) = src[tid * 2 + c]; } }
        __builtin_amdgcn_sched_barrier(0);
        { const int r = tid >> 1, c0 = (tid & 1) * 8; const bf16* vp = P + (size_t)(row0 + r) * P_LD + 960 + h * 128 + c0 * 8;
#pragma unroll
            for (int c = 0; c < 8; ++c) *(LAS bf16x8*)(Vl + (r >> 6) * 16384 + att::v_st(r & 63, (c0 + c) * 8)) = *((const bf16x8*)vp + c);
            const int k0 = (tid & 1) * 4; const bf16* kp = QKP + (size_t)(row0 + r) * 512 + 256 + h * 64 + k0 * 8;
#pragma unroll
            for (int c = 0; c < 4; ++c) *(LAS bf16x8*)(Kl + r * 128 + (((k0 + c) ^ (r & 7)) << 4)) = *((const bf16x8*)kp + c); }
        __syncthreads();
        const int I = wave < 4 ? wave : 11 - wave, trow = 32 * I + t32, vbase = att::v_rd_base(lane);
        bf16x8 qr[4];
        { const bf16* qp = QKP + (size_t)(row0 + trow) * 512 + h * 64 + hi * 8;
#pragma unroll
            for (int kk = 0; kk < 4; ++kk) qr[kk] = *(const bf16x8*)(qp + kk * 16); }
        u32x2 hpk[4][4];
        f32x16 o[4];
#pragma unroll 1
        for (int dir = 0; dir < 2; ++dir) {
            const LAS float* s = sc + dir * 1024; const float Mt = s[256 + trow];
#pragma unroll
            for (int c = 0; c < 4; ++c) o[c] = f32x16{};
            float den = 0.f;
            const int Jlo = dir == 0 ? 0 : I, Jhi = dir == 0 ? I : 7;
#pragma unroll 1
            for (int J = Jlo; J <= Jhi; ++J) {
                f32x16 p = {};
#pragma unroll
                for (int kk = 0; kk < 4; ++kk) { const int kr = 32 * J + t32; const bf16x8 kf = *(LAS bf16x8*)(Kl + kr * 128 + (((2 * kk + hi) ^ (kr & 7)) << 4));
                    p = __builtin_amdgcn_mfma_f32_32x32x16_bf16(kf, qr[kk], p, 0, 0, 0); }
                const bool diag = (J == I);
#pragma unroll
                for (int r = 0; r < 16; ++r) { const int sl = lin::crow(r, hi); const float w = __expf(s[32 * J + sl] - Mt);
                    const bool keep = !diag || (dir == 0 ? (sl <= t32) : (sl >= t32)); p[r] = keep ? p[r] * w : 0.f; den += p[r]; }
                bf16x8 pa0, pa1; LPK4(p, 0, pa0); LPK4(p, 8, pa1);
                LAS unsigned char* vj = Vl + vbase + (J >> 1) * 16384 + (J & 1) * 8192;
#pragma unroll
                for (int c = 0; c < 4; ++c) {
                    const bf16x8 v0 = lin::tr_frag(vj, c * 512, c * 512 + 2048);
                    const bf16x8 v1 = lin::tr_frag(vj, c * 512 + 4096, c * 512 + 4096 + 2048);
                    o[c] = __builtin_amdgcn_mfma_f32_32x32x16_bf16(pa0, v0, o[c], 0, 0, 0);
                    o[c] = __builtin_amdgcn_mfma_f32_32x32x16_bf16(pa1, v1, o[c], 0, 0, 0); }
            }
            { const unsigned char* srec = MLS + (size_t)((bh * 2 + dir) * NGRP + g) * ITEM_S; const float* nv = (const float*)(srec + 16384);
                const float wi = s[768 + trow]; float dn = 0.f;
#pragma unroll
                for (int kk = 0; kk < 4; ++kk) { float qf[8];
#pragma unroll
                    for (int e = 0; e < 8; ++e) { qf[e] = bf2f((unsigned short)qr[kk][e]); dn += qf[e] * nv[kk * 16 + hi * 8 + e]; qf[e] *= wi; }
                    u32x4 w = {cvtpk(qf[0], qf[1]), cvtpk(qf[2], qf[3]), cvtpk(qf[4], qf[5]), cvtpk(qf[6], qf[7])}; const bf16x8 aq = *reinterpret_cast<bf16x8*>(&w);
#pragma unroll
                    for (int c = 0; c < 4; ++c) { const int e_ = 32 * c + t32; const bf16x8 cf = *(LAS bf16x8*)(F.lds + L_CT + dir * 16384 + e_ * 128 + (2 * kk + hi) * 16);
                        o[c] = __builtin_amdgcn_mfma_f32_32x32x16_bf16(aq, cf, o[c], 0, 0, 0); } }
                den += wi * dn; }
            den = lin::swap_add(den);
            const float inv = 1.f / fmaxf(fabsf(den), s[512 + trow]);
            if (hi == 0) wsc[t32] = inv;
            LDS_WAIT(); asm volatile("" ::: "memory");
            if (dir == 0) {
#pragma unroll
                for (int r = 0; r < 16; r += 4) { const float i0 = wsc[lin::crow(r, hi)], i1 = wsc[lin::crow(r + 1, hi)], i2 = wsc[lin::crow(r + 2, hi)], i3 = wsc[lin::crow(r + 3, hi)];
#pragma unroll
                    for (int c = 0; c < 4; ++c) { hpk[c][r >> 2].x = cvtpk(o[c][r] * i0, o[c][r + 1] * i1); hpk[c][r >> 2].y = cvtpk(o[c][r + 2] * i2, o[c][r + 3] * i3); } }
            } else {
#pragma unroll
                for (int r = 0; r < 16; r += 4) { const float i0 = wsc[lin::crow(r, hi)], i1 = wsc[lin::crow(r + 1, hi)], i2 = wsc[lin::crow(r + 2, hi)], i3 = wsc[lin::crow(r + 3, hi)];
#pragma unroll
                    for (int c = 0; c < 4; ++c) { const u32x2 hp = hpk[c][r >> 2];
                        o[c][r] = o[c][r] * i0 + bf2f(hp.x & 0xffffu); o[c][r + 1] = o[c][r + 1] * i1 + bf2f(hp.x >> 16);
                        o[c][r + 2] = o[c][r + 2] * i2 + bf2f(hp.y & 0xffffu); o[c][r + 3] = o[c][r + 3] * i3 + bf2f(hp.y >> 16); } }
            }
            LDS_WAIT(); asm volatile("" ::: "memory");
        }
        const float* hg = F.in[I_MLGAIN] + h * 128;
        int lane_r = F.lane; asm volatile("" : "+v"(lane_r)); const int t32r = lane_r & 31, hir = lane_r >> 5;
#pragma unroll
        for (int r = 0; r < 16; ++r) { float ss = 0.f;
#pragma unroll
            for (int c = 0; c < 4; ++c) ss += o[c][r] * o[c][r];
            ss = lin::half_sum32(ss); const float rstd = rsqrtf(ss * (1.f / 128.f) + RMS_EPS); const int row = row0 + 32 * I + lin::crow(r, hir);
            const bf16* op = P + (size_t)row * P_LD + 1472 + h * 128; bf16* cp = CAT + (size_t)row * DM + 512 + h * 128;
#pragma unroll
            for (int c = 0; c < 4; ++c) { const int e = 32 * c + t32r; cp[e] = (bf16)f2bf(o[c][r] * rstd * hg[e] * sigm(bf2f(op[e]))); }
            __builtin_amdgcn_sched_barrier(0); }
    }
}
}

namespace hg {
using att::cvtpk;
constexpr size_t WS_HGD = 3 * MiB;
constexpr size_t WS_QT = WS_D;
constexpr int L_V = 0, L_K = 65536, L_ET = 131072, L_WS = 131072 + 4096;
#define K256(row, colB) ((row) * 256 + ((colB) ^ (((row) & 7) << 4)))

struct Cols { const bf16* pc; const float* lb; int h, dir; };
__device__ __forceinline__ void fk(float z, float lb, float& logf, float& k) { const float sg = __builtin_amdgcn_rcpf(1.f + __expf(-z)); logf = __logf(lb + (1.f - lb) * sg); k = (1.f - lb) * (1.f - sg); }
__device__ __forceinline__ void ffk(float z, float lb, float& f, float& k) { const float sg = __builtin_amdgcn_rcpf(1.f + __expf(-z)); f = lb + (1.f - lb) * sg; k = (1.f - lb) * (1.f - sg); }

__device__ __forceinline__ int vimg(int row, int c) { return (row >> 6) * 16384 + att::v_st(row & 63, c); }
__device__ __forceinline__ void pass_b(const Frame& F) {
    const bf16* PC = (const bf16*)(F.ws + WS1_PC); const float* LB = (const float*)(F.ws + WS_LB); bf16* U = (bf16*)(F.ws + WS1_U); float* HGD = (float*)(F.ws + WS_HGD);
    LAS unsigned char* Vl = F.lds + L_V; LAS unsigned char* Kl = F.lds + L_K; LAS float* tot = (LAS float*)(F.lds + L_ET);
    const int wave = F.wave;
    bf16x8 vv[8], zz[8];
#define HGB_FETCH(item) do { const int seq_ = (item) / NGRP, g_ = (item) - seq_ * NGRP, dir_ = seq_ & 1, h_ = (seq_ >> 1) & 7, b_ = seq_ >> 4, row0_ = b_ * NT + g_ * 256; \
        const bf16* vb_ = PC + (size_t)row0_ * 5120 + 3072 + h_ * 128; const bf16* zb_ = PC + (size_t)row0_ * 5120 + 1024 * (1 + dir_) + h_ * 128; \
        _Pragma("unroll") for (int c = 0; c < 8; ++c) { const unsigned off = (unsigned)(F.tid >> 4) * 10240u + (unsigned)(F.tid & 15) * 16u + (unsigned)c * 327680u; vv[c] = *(const bf16x8*)((const char*)vb_ + off); zz[c] = *(const bf16x8*)((const char*)zb_ + off); } } while (0)
    if ((int)blockIdx.x < 32 * NGRP) HGB_FETCH((int)blockIdx.x);
    for (int it = blockIdx.x; it < 32 * NGRP; it += F.G) {
        const int seq = it / NGRP, g = it - seq * NGRP, dir = seq & 1, h = (seq >> 1) & 7;
        int tid = F.tid, lane = F.lane; asm volatile("" : "+v"(tid), "+v"(lane));
        __syncthreads();
#pragma unroll
        for (int c = 0; c < 8; ++c) { const int idx = c * 512 + tid, r = idx >> 4, ch = idx & 15; const int o = vimg(r, ch * 8); *(LAS bf16x8*)(Vl + o) = vv[c]; *(LAS bf16x8*)(Kl + o) = zz[c]; }
        if (it + F.G < 32 * NGRP) HGB_FETCH(it + F.G);
        __syncthreads();
        const int d = tid & 127, sg = tid >> 7; const float lb = LB[h * 128 + d];
        { float acc = 1.f;
#pragma unroll 4
            for (int i = 0; i < 64; ++i) { const int row = sg * 64 + (dir == 0 ? 63 - i : i); LAS unsigned short* p = (LAS unsigned short*)(Kl + vimg(row, d));
                const float k = bf2f(*p); *p = (unsigned short)f2bf(k * acc); acc *= (1.f - k); }
            tot[sg * 128 + d] = acc; }
        __syncthreads();
        if (sg == 0) HGD[(size_t)it * 128 + d] = (tot[d] * tot[128 + d]) * (tot[256 + d] * tot[384 + d]);
        { const int ei = wave >> 1, dj = 2 * (wave & 1), vb = att::v_rd_base(lane), hi = lane >> 5, d0 = 32 * dj + (lane & 31), d1 = d0 + 32; f32x16 a0 = {}, a1 = {};
#pragma unroll
            for (int sgm = 0; sgm < 4; ++sgm) { f32x16 s0 = {}, s1 = {};
#pragma unroll
                for (int k4 = 0; k4 < 4; ++k4) { const int to = sgm * 16384 + k4 * 4096;
                    const bf16x8 a = lin::tr_frag(Vl + vb + to, ei * 512, ei * 512 + 2048);
                    const bf16x8 b0 = lin::tr_frag(Kl + vb + to, dj * 512, dj * 512 + 2048), b1 = lin::tr_frag(Kl + vb + to, (dj + 1) * 512, (dj + 1) * 512 + 2048);
                    s0 = __builtin_amdgcn_mfma_f32_32x32x16_bf16(a, b0, s0, 0, 0, 0); s1 = __builtin_amdgcn_mfma_f32_32x32x16_bf16(a, b1, s1, 0, 0, 0); }
                float f0 = 1.f, f1 = 1.f;
                if (dir == 0) { for (int s2 = sgm + 1; s2 < 4; ++s2) { f0 *= tot[s2 * 128 + d0]; f1 *= tot[s2 * 128 + d1]; } } else { for (int s2 = 0; s2 < sgm; ++s2) { f0 *= tot[s2 * 128 + d0]; f1 *= tot[s2 * 128 + d1]; } }
#pragma unroll
                for (int r = 0; r < 16; ++r) { a0[r] += s0[r] * f0; a1[r] += s1[r] * f1; } }
            bf16* rec = U + (size_t)it * 16384;
#pragma unroll
            for (int r = 0; r < 16; ++r) { bf16* p = rec + (32 * ei + lin::crow(r, hi)) * 128 + 32 * dj + (lane & 31); p[0] = (bf16)f2bf(a0[r]); p[32] = (bf16)f2bf(a1[r]); } }
    }
}

#undef HGB_FETCH
__device__ __forceinline__ void pass_c(const Frame& F) {
    const unsigned* __restrict__ U2 = (const unsigned*)(F.ws + WS1_U); const float* __restrict__ HGD = (const float*)(F.ws + WS_HGD); unsigned* __restrict__ S2 = (unsigned*)(F.ws + WS1_S);
    for (int wgi = blockIdx.x; wgi < 32 * 16; wgi += F.G) {
        const int seq = wgi >> 4, part = wgi & 15, dir = seq & 1, pr = part * 512 + F.tid, d = (2 * pr) & 127;
        float c0 = 0.f, c1 = 0.f;
#pragma unroll 1
        for (int blk = 0; blk < 3; ++blk) {
            unsigned u[22]; float dg0[22], dg1[22];
#pragma unroll
            for (int i = 0; i < 22; ++i) { const int st = blk * 22 + i; if (st >= NGRP) break; const int g = dir == 0 ? st : (st == 0 ? 0 : NGRP - st); const size_t ix = (size_t)(seq * NGRP + g);
                u[i] = U2[ix * 8192 + pr]; const float* hp = HGD + ix * 128 + d; dg0[i] = hp[0]; dg1[i] = hp[1]; }
#pragma unroll
            for (int i = 0; i < 22; ++i) { const int st = blk * 22 + i; if (st >= NGRP) break; const int g = dir == 0 ? st : (st == 0 ? 0 : NGRP - st); const size_t ix = (size_t)(seq * NGRP + g);
                S2[ix * 8192 + pr] = pk2(c0, c1); c0 = dg0[i] * c0 + bf2f(u[i] & 0xffffu); c1 = dg1[i] * c1 + bf2f(u[i] >> 16); }
        }
    }
}

__device__ __forceinline__ void pass_d(const Frame& F) {
    const bf16* PC = (const bf16*)(F.ws + WS1_PC); const float* LB = (const float*)(F.ws + WS_LB); const bf16* S = (const bf16*)(F.ws + WS1_S); bf16* CAT = (bf16*)(F.ws + WS1_CAT);
    bf16* QT = (bf16*)(F.ws + WS_QT) + (size_t)blockIdx.x * 32768;
    LAS unsigned char* Vl = F.lds + L_V; LAS unsigned char* Kl = F.lds + L_K; LAS float* ET = (LAS float*)(F.lds + L_ET);
    const int tid = F.tid, lane = F.lane, wave = F.wave, t32 = lane & 31, hi = lane >> 5, vb = att::v_rd_base(lane);
    for (int it = blockIdx.x; it < 16 * 64; it += F.G) {
        const int bh = it >> 6, g = (it & 63) + 1, b = bh >> 3, h = bh & 7, row0 = b * NT + g * 256;
        const int I = wave < 4 ? wave : 11 - wave, trow = 32 * I + t32;
        f32x16 o[4] = {};
#pragma unroll 1
        for (int dir = 0; dir < 2; ++dir) {
            __syncthreads();
            {
                const bf16* zb_ = PC + (size_t)row0 * 5120 + 1024 * (1 + dir) + h * 128; const bf16* qb_ = PC + (size_t)row0 * 5120 + h * 128;
#pragma unroll 1
                for (int c0 = 0; c0 < 8; c0 += 4) {
                    bf16x8 zz[4], qq[4];
#pragma unroll
                    for (int c = 0; c < 4; ++c) { const unsigned off = (unsigned)(tid >> 4) * 10240u + (unsigned)(tid & 15) * 16u + (unsigned)(c0 + c) * 327680u;
                        zz[c] = *(const bf16x8*)((const char*)zb_ + off); qq[c] = *(const bf16x8*)((const char*)qb_ + off); }
#pragma unroll
                    for (int c = 0; c < 4; ++c) { const int idx = (c0 + c) * 512 + tid, r = idx >> 4, ch = idx & 15; *(LAS bf16x8*)(Kl + K256(r, ch * 16)) = zz[c]; *(LAS bf16x8*)(Vl + r * 256 + ch * 16) = qq[c]; } } }
            __syncthreads();
            {
                const int d = tid & 127; const float lb = LB[h * 128 + d];
#pragma unroll 1
                for (int q2 = 0; q2 < 2; ++q2) { const int B = (tid >> 7) + 4 * q2; float x = 1.f;
#pragma unroll 4
                    for (int i = 0; i < 32; ++i) { const int row = 32 * B + (dir == 0 ? i : 31 - i);
                        LAS unsigned short* zp = (LAS unsigned short*)(Kl + K256(row, d * 2)); LAS unsigned short* qp = (LAS unsigned short*)(Vl + row * 256 + d * 2);
                        const float k = bf2f(*zp); x *= (1.f - k);
                        *zp = (unsigned short)f2bf(k * __builtin_amdgcn_rcpf(fmaxf(x, 1.0e-30f))); *qp = (unsigned short)f2bf(bf2f(*qp) * x); }
                    ET[B * 128 + d] = x; } }
            __syncthreads();
            float qf[8][8];
            { const LAS unsigned char* qp = Vl + trow * 256 + hi * 16;
#pragma unroll
                for (int kk = 0; kk < 8; ++kk) { const bf16x8 v = *(const LAS bf16x8*)(qp + kk * 32);
#pragma unroll
                    for (int e = 0; e < 8; ++e) qf[kk][e] = bf2f((unsigned short)v[e]); } }
            __syncthreads();
            { const bf16* vb_ = PC + (size_t)row0 * 5120 + 3072 + h * 128; bf16x8 vv[8];
#pragma unroll
                for (int c = 0; c < 8; ++c) { const unsigned off = (unsigned)(tid >> 4) * 10240u + (unsigned)(tid & 15) * 16u + (unsigned)c * 327680u; vv[c] = *(const bf16x8*)((const char*)vb_ + off); }
#pragma unroll
                for (int c = 0; c < 8; ++c) { const int idx = c * 512 + tid, r = idx >> 4, ch = idx & 15; *(LAS bf16x8*)(Vl + vimg(r, ch * 8)) = vv[c]; } }
            __syncthreads();
            const bf16* ST = S + (size_t)((bh * 2 + dir) * NGRP + g) * 16384; bf16x8 sreg[4];
#pragma unroll
            for (int c = 0; c < 4; ++c) sreg[c] = *((const bf16x8*)ST + c * 512 + tid);
            const int nst = dir == 0 ? I + 1 : 8 - I;
#pragma unroll 1
            for (int st = 0; st < nst; ++st) {
                const int J = dir == 0 ? I - st : I + st;
                if (st != 0) {
#pragma unroll
                    for (int kk = 0; kk < 8; ++kk) { const f32x4 e0 = *(LAS f32x4*)(ET + J * 128 + kk * 16 + hi * 8), e1 = *(LAS f32x4*)(ET + J * 128 + kk * 16 + hi * 8 + 4);
                        qf[kk][0] *= e0[0]; qf[kk][1] *= e0[1]; qf[kk][2] *= e0[2]; qf[kk][3] *= e0[3]; qf[kk][4] *= e1[0]; qf[kk][5] *= e1[1]; qf[kk][6] *= e1[2]; qf[kk][7] *= e1[3]; } }
                f32x16 p = {};
#pragma unroll
                for (int kk = 0; kk < 8; ++kk) { const int kr = 32 * J + t32; const bf16x8 kf = *(LAS bf16x8*)(Kl + K256(kr, (2 * kk + hi) * 16));
                    u32x4 w = {cvtpk(qf[kk][0], qf[kk][1]), cvtpk(qf[kk][2], qf[kk][3]), cvtpk(qf[kk][4], qf[kk][5]), cvtpk(qf[kk][6], qf[kk][7])};
                    p = __builtin_amdgcn_mfma_f32_32x32x16_bf16(kf, *reinterpret_cast<bf16x8*>(&w), p, 0, 0, 0); }
                if (st == 0) {
#pragma unroll
                    for (int r = 0; r < 16; ++r) { const int sl = lin::crow(r, hi); const bool keep = dir == 0 ? (sl <= t32) : (sl >= t32); p[r] = keep ? p[r] : 0.f; } }
                asm volatile("s_nop 15\n\ts_nop 7" : "+v"(p));
                bf16x8 pa0, pa1; LPK4(p, 0, pa0); LPK4(p, 8, pa1);
                LAS unsigned char* vj = Vl + vb + (J >> 1) * 16384 + (J & 1) * 8192;
#pragma unroll
                for (int c = 0; c < 4; ++c) {
                    const bf16x8 v0 = lin::tr_frag(vj, c * 512, c * 512 + 2048);
                    const bf16x8 v1 = lin::tr_frag(vj, c * 512 + 4096, c * 512 + 4096 + 2048);
                    o[c] = __builtin_amdgcn_mfma_f32_32x32x16_bf16(pa0, v0, o[c], 0, 0, 0);
                    o[c] = __builtin_amdgcn_mfma_f32_32x32x16_bf16(pa1, v1, o[c], 0, 0, 0); }
            }
            __syncthreads();
#pragma unroll
            for (int c = 0; c < 4; ++c) { const int ch = c * 512 + tid, e = ch >> 4, cc = ch & 15; *(LAS bf16x8*)(Kl + K256(e, cc * 16)) = sreg[c]; }
            __syncthreads();
#pragma unroll
            for (int kk = 0; kk < 8; ++kk) { u32x4 w = {cvtpk(qf[kk][0], qf[kk][1]), cvtpk(qf[kk][2], qf[kk][3]), cvtpk(qf[kk][4], qf[kk][5]), cvtpk(qf[kk][6], qf[kk][7])};
                const bf16x8 aq = *reinterpret_cast<bf16x8*>(&w);
#pragma unroll
                for (int c = 0; c < 4; ++c) { const bf16x8 sf = *(LAS bf16x8*)(Kl + K256(32 * c + t32, (2 * kk + hi) * 16));
                    o[c] = __builtin_amdgcn_mfma_f32_32x32x16_bf16(aq, sf, o[c], 0, 0, 0); } }
        }
        __syncthreads();
        { const bf16* gb_ = PC + (size_t)row0 * 5120 + 4096 + h * 128;
#pragma unroll
            for (int c = 0; c < 8; ++c) { const unsigned off = (unsigned)(tid >> 4) * 10240u + (unsigned)(tid & 15) * 16u + (unsigned)c * 327680u;
                __builtin_amdgcn_global_load_lds((const unsigned*)((const char*)gb_ + off), (LAS unsigned*)(Kl + c * 8192 + wave * 1024), 16, 0, 0); }
            VM_WAIT(); }
        __syncthreads();
        const float* gn = F.in[I_HGGAIN] + h * 128; LAS unsigned char* gbase = Kl + (32 * I + 4 * hi) * 256 + t32 * 2;
#pragma unroll
        for (int r = 0; r < 16; ++r) { float ss = 0.f;
#pragma unroll
            for (int c = 0; c < 4; ++c) ss += o[c][r] * o[c][r];
            ss = lin::half_sum32(ss); const float rstd = rsqrtf(ss * (1.f / 128.f) + RMS_EPS); const int row = row0 + 32 * I + lin::crow(r, hi);
            const LAS unsigned short* gp = (const LAS unsigned short*)(gbase + ((r & 3) + 8 * (r >> 2)) * 256); bf16* cp = CAT + (size_t)row * DM + h * 128;
#pragma unroll
            for (int c = 0; c < 4; ++c) { const int e = 32 * c + t32; cp[e] = (bf16)f2bf(o[c][r] * rstd * gn[e] * siluf(bf2f(gp[32 * c]))); }
            __builtin_amdgcn_sched_barrier(0); }
    }
}
}


namespace moe {
constexpr size_t WS_TILEE = WS_WGBASE + 65536;
constexpr size_t GU_SLAB = (size_t)2 * DFF * 1024, DN_SLAB = (size_t)1024 * DFF;
constexpr float GU_WSCALE = 32.f, DN_WSCALE = 64.f;
constexpr size_t MWGU_OFF = 0, MWDN_OFF = 8 * GU_SLAB;
static_assert(MWDN_OFF + 8 * DN_SLAB <= (size_t)2 * SEQ * DM * 4, "MoE weights");
struct TokRec { int e0, e1, p0, p1; float g0, g1; int s0, s1; };

__device__ __forceinline__ void convert_expert_weights(const Frame& F) {
    __syncthreads();
    transpose_items_i8(F, 1024, 2 * DFF, F.ws + WS_W_GU, SrcPlain{F.in[I_FFNGU], 2 * DFF, 2 * DFF}, DstGU{}, (const float*)(F.ws + WS_CMAXP) + 0, (float*)(F.ws + WS_CTL) + CW_COLSC + 0);
    transpose_items_f8(F, DFF, 1024, F.ws + WS_W_DN, SrcPlain{F.in[I_FFNDN], 1024, 1024}, DstPlain{}, DN_WSCALE);
    transpose_items_i8(F, 1024, 5120, F.ws + WS_W_INC, SrcPlain{F.in[I_WINC], 5120, 5120}, DstPlain{}, (const float*)(F.ws + WS_CMAXP) + 5632, (float*)(F.ws + WS_CTL) + CW_COLSC + 5632);
    transpose_items(F, 1024, 1024, (bf16*)(F.ws + WS_W_OUTC), SrcPlain{F.in[I_WOUTC], 1024, 1024}, DstPlain{});
    for (int e = 0; e < NEXP; ++e) {
        transpose_items_f8(F, 1024, 2 * DFF, (unsigned char*)F.out + MWGU_OFF + e * GU_SLAB, SrcPlain{F.in[I_MOEGU] + (size_t)e * 1024 * 2 * DFF, 2 * DFF, 2 * DFF}, DstGU{}, GU_WSCALE);
        transpose_items_f8(F, DFF, 1024, (unsigned char*)F.out + MWDN_OFF + e * DN_SLAB, SrcPlain{F.in[I_MOEDN] + (size_t)e * DFF * 1024, 1024, 1024}, DstPlain{}, DN_WSCALE);
    }
    __syncthreads();
}
__device__ __forceinline__ void p19_route(const Frame& F) {
    LAS float* wr = (LAS float*)F.lds;
    LAS int* cntl = (LAS int*)(F.lds + 32768);
    for (int i = F.tid; i < 8192; i += NTHREADS) wr[i] = F.in[I_ROUTER][i];
    if (F.tid < 8) cntl[F.tid] = 0;
    __syncthreads();
    const bf16* Y = (const bf16*)(F.ws + WS1_Y); unsigned char* H2 = F.ws + WS1_H2; TokRec* TR = (TokRec*)(F.ws + WS_TOKREC);
    const float* gain_a = F.in[I_GAINS] + 5 * 1024; const float* gain_b = F.in[I_GAINS] + 6 * 1024; const int lane = F.lane;
    u32x2 yw[4], ywn[4], xw[4], xwn[4]; f32x4 x[4], vga[4], vgb[4], vgt[4], vsh[4], vsc[4]; int cur = -1; load_vec(gain_a, lane, vga); load_vec(gain_b, lane, vgb);
    int row = F.gw; { while (row < NR) { int b, j; row_decode(row, b, j); if (j >= CTXL) break; row += F.NGW; } }
    if (row < NR) { load_row_raw(Y + (size_t)row * DM, lane, yw); load_row_raw(res_row(F, row), lane, xw); }
    while (row < NR) {
        int nrow = row + F.NGW; { while (nrow < NR) { int b, j; row_decode(nrow, b, j); if (j >= CTXL) break; nrow += F.NGW; } }
        if (nrow < NR) { load_row_raw(Y + (size_t)nrow * DM, lane, ywn); load_row_raw(res_row(F, nrow), lane, xwn); }
        int b, j; row_decode(row, b, j);
        f32x4 y[4]; cvt_row(yw, y); cvt_row(xw, x); bf16* xr = res_row(F, row);
        if (b != cur) { cur = b; load_vec(mod_vec(F, 1, row, 2), lane, vgt); load_vec(mod_vec(F, 1, row, 3), lane, vsh); load_vec(mod_vec(F, 1, row, 4), lane, vsc); }
        const float rstd = row_rstd(y);
#pragma unroll
        for (int q = 0; q < 4; ++q) { const int idx = lane + 64 * q; x[q] = x[q] + vgt[q] * (y[q] * rstd * vga[q]); store_res(xr, idx, x[q]); }
        const float rs2 = row_rstd(x);
        float lg[8] = {0.f, 0.f, 0.f, 0.f, 0.f, 0.f, 0.f, 0.f};
#pragma unroll
        for (int q = 0; q < 4; ++q) { const int idx = lane + 64 * q;
            const f32x4 hv = (x[q] * rs2 * vgb[q]) * (1.f + vsc[q]) + vsh[q];
            *((unsigned*)(H2 + (size_t)row * DM) + idx) = pk4_fp8(hv.x, hv.y, hv.z, hv.w);
#pragma unroll
            for (int i = 0; i < 4; ++i) { const f32x4 w0 = *(LAS f32x4*)(wr + (4 * idx + i) * 8), w1 = *(LAS f32x4*)(wr + (4 * idx + i) * 8 + 4); const float hh = hv[i];
                lg[0] += hh * w0[0]; lg[1] += hh * w0[1]; lg[2] += hh * w0[2]; lg[3] += hh * w0[3]; lg[4] += hh * w1[0]; lg[5] += hh * w1[1]; lg[6] += hh * w1[2]; lg[7] += hh * w1[3]; } }
#pragma unroll
        for (int e = 0; e < 8; ++e) lg[e] = wave_sum(lg[e]);
        int e0 = 0; float v0 = lg[0];
#pragma unroll
        for (int e = 1; e < 8; ++e) if (lg[e] > v0) { v0 = lg[e]; e0 = e; }
        int e1 = -1; float v1 = -3.0e38f;
#pragma unroll
        for (int e = 0; e < 8; ++e) if (e != e0 && lg[e] > v1) { v1 = lg[e]; e1 = e; }
        if (lane == 0) { const float ga = 1.f / (1.f + __expf(v1 - v0)); const int p0 = atomicAdd((int*)&cntl[e0], 1), p1 = atomicAdd((int*)&cntl[e1], 1);
            TokRec t; t.e0 = e0; t.e1 = e1; t.p0 = p0; t.p1 = p1; t.g0 = ga; t.g1 = 1.f - ga; t.s0 = 0; t.s1 = 0; TR[b * SEQ + (j - CTXL)] = t; }
#pragma unroll
        for (int q = 0; q < 4; ++q) { yw[q] = ywn[q]; xw[q] = xwn[q]; }
        row = nrow;
    }
    __syncthreads();
    if (F.tid < 8) { unsigned* cnt = (unsigned*)(F.ws + WS_CTL) + CW_MOECNT + 64 * F.tid;
        ((unsigned*)(F.ws + WS_WGBASE))[blockIdx.x * 64 + F.tid] = __hip_atomic_fetch_add(cnt, (unsigned)cntl[F.tid], __ATOMIC_RELAXED, __HIP_MEMORY_SCOPE_AGENT); }
}
__device__ __forceinline__ int slot_layout(const Frame& F, int (&base)[8], int (&cnt)[8]) {
    int acc = 0;
#pragma unroll
    for (int e = 0; e < 8; ++e) { cnt[e] = (int)__hip_atomic_load((unsigned*)(F.ws + WS_CTL) + CW_MOECNT + 64 * e, __ATOMIC_RELAXED, __HIP_MEMORY_SCOPE_AGENT); base[e] = acc; acc += (cnt[e] + 255) & ~255; }
    return acc >> 8;
}
__device__ __forceinline__ void p20_gather(const Frame& F) {
    int base[8], cnt[8]; const int ntiles = slot_layout(F, base, cnt);
    if (blockIdx.x == 0) { int* te = (int*)(F.ws + WS_TILEE);
        for (int t = F.tid; t < 264; t += NTHREADS) { int e = 0;
#pragma unroll
            for (int q = 1; q < 8; ++q) if (t * 256 >= base[q]) e = q;
            te[t] = e; }
        if (F.tid == 0) te[264] = ntiles; }
    const unsigned char* H2 = F.ws + WS1_H2; unsigned char* XS = F.ws + WS1_XS; TokRec* TR = (TokRec*)(F.ws + WS_TOKREC);
    const unsigned* wgb = (const unsigned*)(F.ws + WS_WGBASE) + blockIdx.x * 64; const int lane = F.lane;
    for (int row = F.gw; row < NR; row += F.NGW) {
        int b, j; row_decode(row, b, j); if (j < CTXL) continue;
        TokRec* tr = TR + (b * SEQ + (j - CTXL)); const int e0 = tr->e0, e1 = tr->e1;
        int s0 = 0, s1 = 0;
#pragma unroll
        for (int e = 0; e < 8; ++e) { if (e == e0) s0 = base[e] + (int)wgb[e] + tr->p0; if (e == e1) s1 = base[e] + (int)wgb[e] + tr->p1; }
        const u32x4 a = ((const u32x4*)(H2 + (size_t)row * DM))[lane];
        ((u32x4*)(XS + (size_t)s0 * DM))[lane] = a; ((u32x4*)(XS + (size_t)s1 * DM))[lane] = a;
        if (lane == 0) { tr->s0 = s0; tr->s1 = s1; }
    }
    if (blockIdx.x < 8) { const int e = blockIdx.x, lo = base[e] + cnt[e], hi = base[e] + ((cnt[e] + 255) & ~255);
        for (int s = lo + F.wave; s < hi; s += NWAVES) { ((u32x4*)(XS + (size_t)s * DM))[lane] = (u32x4){0u, 0u, 0u, 0u}; } }
}
__device__ __forceinline__ void p23_combine(const Frame& F) {
    const bf16* YS = (const bf16*)(F.ws + WS1_YS); const TokRec* TR = (const TokRec*)(F.ws + WS_TOKREC); const float* gain = F.in[I_GAINS] + 7 * 1024; const int lane = F.lane;
    u32x2 w0[4], w1[4], w0n[4], w1n[4], xw[4], xwn[4]; f32x4 x[4], vg[4], vgt[4]; int cur = -1; load_vec(gain, lane, vg); float g0 = 0.f, g1 = 0.f, g0n = 0.f, g1n = 0.f;
    int row = F.gw; { while (row < NR) { int b, j; row_decode(row, b, j); if (j >= CTXL) break; row += F.NGW; } }
    if (row < NR) { int b, j; row_decode(row, b, j); const TokRec tr = TR[b * SEQ + (j - CTXL)]; g0 = tr.g0; g1 = tr.g1;
        load_row_raw(YS + (size_t)tr.s0 * DM, lane, w0); load_row_raw(YS + (size_t)tr.s1 * DM, lane, w1); load_row_raw(res_row(F, row), lane, xw); }
    while (row < NR) {
        int nrow = row + F.NGW; { while (nrow < NR) { int b, j; row_decode(nrow, b, j); if (j >= CTXL) break; nrow += F.NGW; } }
        if (nrow < NR) { int b, j; row_decode(nrow, b, j); const TokRec tr = TR[b * SEQ + (j - CTXL)]; g0n = tr.g0; g1n = tr.g1;
            load_row_raw(YS + (size_t)tr.s0 * DM, lane, w0n); load_row_raw(YS + (size_t)tr.s1 * DM, lane, w1n); load_row_raw(res_row(F, nrow), lane, xwn); }
        f32x4 y0[4], y1[4]; cvt_row(w0, y0); cvt_row(w1, y1); cvt_row(xw, x); float* xr = out_row(F, row);
#pragma unroll
        for (int q = 0; q < 4; ++q) y0[q] = y0[q] * g0 + y1[q] * g1;
        { const int who = row_who(row); if (who != cur) { cur = who; load_vec(mod_vec(F, 1, row, 5), lane, vgt); } }
        const float rstd = row_rstd(y0);
#pragma unroll
        for (int q = 0; q < 4; ++q) { const int idx = lane + 64 * q; *((f32x4*)xr + idx) = x[q] + vgt[q] * (y0[q] * rstd * vg[q]); }
#pragma unroll
        for (int q = 0; q < 4; ++q) { w0[q] = w0n[q]; w1[q] = w1n[q]; xw[q] = xwn[q]; }
        g0 = g0n; g1 = g1n; row = nrow;
    }
}
}

__device__ __forceinline__ int opaque(int v) { asm volatile("" : "+s"(v)); return v; }
__device__ __forceinline__ void convert_v(const Frame& F) {
    const bf16* V = (const bf16*)(F.ws + WS_V); char* VT = (char*)(F.ws + WS_KV8) + 64 * 208;
    for (int item = F.gw; item < 8 * (NT / 64); item += F.NGW) {
        const unsigned* src = (const unsigned*)(V + (size_t)item * 64 * 128) + F.lane;
        unsigned v[64];
#pragma unroll
        for (int k = 0; k < 64; ++k) v[k] = src[k * 64];
        u32x4 lo[4], hi4[4];
#pragma unroll
        for (int w = 0; w < 16; ++w) { const int k0 = 32 * ((w >> 2) & 1) + 8 * (w & 3) + 4 * (w >> 3);
            const unsigned a = att::pk4f8(__uint_as_float(v[k0] << 16), __uint_as_float(v[k0 + 1] << 16), __uint_as_float(v[k0 + 2] << 16), __uint_as_float(v[k0 + 3] << 16));
            const unsigned b = att::pk4f8(__uint_as_float(v[k0] & 0xffff0000u), __uint_as_float(v[k0 + 1] & 0xffff0000u), __uint_as_float(v[k0 + 2] & 0xffff0000u), __uint_as_float(v[k0 + 3] & 0xffff0000u));
            if ((w & 3) == 0) { lo[w >> 2].x = a; hi4[w >> 2].x = b; } else if ((w & 3) == 1) { lo[w >> 2].y = a; hi4[w >> 2].y = b; } else if ((w & 3) == 2) { lo[w >> 2].z = a; hi4[w >> 2].z = b; } else { lo[w >> 2].w = a; hi4[w >> 2].w = b; } }
        u32x4* dst = (u32x4*)(VT + (size_t)item * 23552 + F.lane * 160);
#pragma unroll
        for (int q = 0; q < 4; ++q) { dst[q] = lo[q]; dst[5 + q] = hi4[q]; }
    }
}
__device__ __forceinline__ void convert_k(const Frame& F) {
    const bf16* KN = (const bf16*)(F.ws + WS_KN); const bf16* KR = (const bf16*)(F.ws + WS_KR); char* K8 = (char*)(F.ws + WS_KV8);
    for (int item = F.gw; item < 8 * (NT / 64); item += F.NGW) {
        const int bh = item / (NT / 64), key = (item - bh * (NT / 64)) * 64 + F.lane;
        const bf16x8* sn = (const bf16x8*)(KN + ((size_t)bh * NT + key) * 128); const bf16x8* sr = (const bf16x8*)(KR + ((size_t)(bh >> 2) * NT + key) * 64);
        bf16x8 c[24];
#pragma unroll
        for (int i = 0; i < 16; ++i) c[i] = sn[i];
#pragma unroll
        for (int i = 0; i < 8; ++i) c[16 + i] = sr[i];
        u32x4* dst = (u32x4*)(K8 + (size_t)item * 23552 + F.lane * 208);
#pragma unroll
        for (int g = 0; g < 3; ++g)
#pragma unroll
            for (int u = 0; u < 4; ++u) {
                const int u0 = 2 * u, u1 = 2 * u + 1; const u32x2 x = att::bf8_to_f8(c[8 * g + 2 * (u0 & 3) + (u0 >> 2)]), y = att::bf8_to_f8(c[8 * g + 2 * (u1 & 3) + (u1 >> 2)]);
                dst[4 * g + u] = (u32x4){x.x, x.y, y.x, y.y}; }
    }
}
__global__ void __launch_bounds__(NTHREADS, 2) fwd_kernel(Args args) {
    extern __shared__ __attribute__((aligned(16))) unsigned char lds_raw[];
    Frame F;
    F.lds = (LAS unsigned char*)lds_raw; F.tid = threadIdx.x; asm volatile("" : "+v"(F.tid));     F.lane = F.tid & 63; F.wave = __builtin_amdgcn_readfirstlane(F.tid >> 6);
    F.G = gridDim.x; F.gw = blockIdx.x * NWAVES + F.wave; F.NGW = F.G * NWAVES; F.in = args.in; F.out = args.out; F.ws = args.ws;
    volatile LAS unsigned* MISC = (volatile LAS unsigned*)(F.lds + MISC_OFF);
    for (int u = F.tid; u < (LDS_BYTES - RING_BYTES) / 4; u += NTHREADS) ((LAS unsigned*)(F.lds + RING_BYTES))[u] = 0u;
    __syncthreads();
    unsigned* ctl = (unsigned*)(F.ws + WS_CTL);
    XcdBarrier bar = xcd_barrier_post(ctl + CW_BAR, MISC + 8, F.tid);
    const int lo = args.ph_lo, hi = args.ph_hi;
#define IN(k) (lo <= (k) && (k) < hi)
#ifndef DUP_MASK
#define DUP_MASK 0u
#endif
#define REP(k) (1 + (int)(((unsigned)(DUP_MASK) >> (k)) & 1u))
#define LAUNDER() do { asm volatile("" : "+v"(F.tid), "+v"(F.lane)); } while (0)
#define SEAM(k) do { if (IN(k) && IN((k) + 1)) xcd_barrier(bar, F.tid); } while (0)

#if BAR_PROBE
    for (int i_ = 0; i_ < BAR_PROBE; ++i_) xcd_barrier(bar, F.tid);
#endif
    if (IN(0)) for (int rep_ = 0; rep_ < REP(0); ++rep_) { LAUNDER(); p0_prologue(F); } SEAM(0);
    if (IN(1)) for (int rep_ = 0; rep_ < REP(1); ++rep_) { LAUNDER(); p1_norm0(F); } SEAM(1);
    if (IN(2)) for (int rep_ = 0; rep_ < REP(2); ++rep_) { LAUNDER();
        pg8::Gemm g{(const bf16*)(F.ws + WS_H), (const bf16*)(F.ws + WS_W_INAB), opaque(1024 / 2), 0, (const float*)(F.ws + WS_SA), (const float*)(F.ws + WS_CTL) + CW_COLSC + 10752}; pg8::StaticOrder S; S.init(NR / 256, 2048 / 256, F.G, (int)blockIdx.x, 0);
        epi::InAB E{(bf16*)(F.ws + WS_P), (float*)(F.ws + WS_GATES)};
        pg8::gemm_phase<epi::InAB, pg8::StaticOrder, true, true, 2>(F.lds, g, S, E, F.tid);
    } SEAM(2);
    if (IN(3)) for (int rep_ = 0; rep_ < REP(3); ++rep_) { LAUNDER(); p3_prep(F); } SEAM(3);
    if (IN(4)) for (int rep_ = 0; rep_ < REP(4); ++rep_) { LAUNDER();
        pg8::Gemm g{(const bf16*)(F.ws + WS_A2), (const bf16*)(F.ws + WS_W_UP), opaque(384), 0}; pg8::StaticOrder S; S.init(NR / 256, 1792 / 256, F.G, (int)blockIdx.x, 0);
        epi::UpProj E{F.ws};
        pg8::gemm_phase<epi::UpProj, pg8::StaticOrder, true, true>(F.lds, g, S, E, F.tid);
    } if (IN(4)) xcd_barrier(bar, F.tid);
    if (IN(4)) { LAUNDER(); convert_v(F); LAUNDER(); convert_k(F); } SEAM(4);
    if (IN(5)) for (int rep_ = 0; rep_ < REP(5); ++rep_) { LAUNDER();
        const bf16* Q = (const bf16*)(F.ws + WS_Q); const bf16* KN = (const bf16*)(F.ws + WS_KN); const bf16* KR = (const bf16*)(F.ws + WS_KR); const char* KV = (const char*)(F.ws + WS_KV8);
        bf16* CAT = (bf16*)(F.ws + WS_CAT); const float* rope = (const float*)(F.ws + WS_ROPE);
#if !MLSTM_STUB
        ml::pass_b(F);
#endif
        const int c = blockIdx.x, bh = c & 7, b = bh >> 2, h = bh & 3;
        const int cslot = (c >> 3) & 1;
        if (cslot == 0) moe::convert_expert_weights(F);
        for (int i = 0; i < 3; ++i) {
            int j0, seq, rt0;
            if (i < 2) { const int qb = (c >> 3) + 32 * i; if (qb >= 64) continue; j0 = CTXL + qb * 256; seq = NT; rt0 = qb * 256; }
            else { if ((c >> 3) != 0) continue; j0 = 0; seq = CTXL; rt0 = -1; }
            att::attn_unit(Q + ((size_t)bh * NT + j0) * 192, KV + (size_t)bh * (NT / 64) * 23552  ,
                           CAT + ((size_t)b * NT + j0) * DM + h * 128, seq, rt0, rope, (char*)lds_raw, F.tid);
        }
        if (cslot == 1) moe::convert_expert_weights(F);
        __syncthreads();
#if MLSTM_STUB
        for (int row = F.gw; row < NR; row += F.NGW) { *((u32x4*)((bf16*)CAT + (size_t)row * DM + 512) + F.lane) = (u32x4){0u, 0u, 0u, 0u}; }
#endif
    } SEAM(5);
#if !MLSTM_STUB
    if (IN(7)) for (int rep_ = 0; rep_ < REP(7); ++rep_) { LAUNDER(); ml::pass_c(F); } SEAM(7);
    if (IN(8)) for (int rep_ = 0; rep_ < REP(8); ++rep_) { LAUNDER(); ml::pass_d(F); } SEAM(8);
#endif
    if (IN(9)) for (int rep_ = 0; rep_ < REP(9); ++rep_) { LAUNDER();
        pg8::Gemm g{(const bf16*)(F.ws + WS_CAT), (const bf16*)(F.ws + WS_W_OUTAB), opaque(1024), 0}; pg8::StaticOrder S; S.init(128, 4, F.G, (int)blockIdx.x, 1);
        epi::Bf16 E{(bf16*)(F.ws + WS_Y), DM};
        pg8::gemm_phase<epi::Bf16, pg8::StaticOrder, true, true>(F.lds, g, S, E, F.tid);
    } SEAM(9);
    if (IN(10)) for (int rep_ = 0; rep_ < REP(10); ++rep_) { LAUNDER();
        if (blockIdx.x < 8) { pg8::Gemm g{(const bf16*)(F.ws + WS_CAT), (const bf16*)(F.ws + WS_W_OUTAB), opaque(1024), 0}; pg8::CtxOrder S{(int)blockIdx.x}; epi::Bf16 E{(bf16*)(F.ws + WS_Y), DM};
            pg8::gemm_phase<epi::Bf16, pg8::CtxOrder, true, true>(F.lds, g, S, E, F.tid); }
        else resnorm_rows<true, true>(F, (const bf16*)(F.ws + WS_Y), 0, 2, F.in[I_GAINS] + 1 * 1024, 0, 3, F.in[I_GAINS] + 2 * 1024, (bf16*)(F.ws + WS_H), 1, F.gw - 8 * NWAVES, F.NGW - 8 * NWAVES);
    } if (IN(10)) xcd_barrier(bar, F.tid);
    if (IN(10)) { LAUNDER(); resnorm_rows<true, true>(F, (const bf16*)(F.ws + WS_Y), 0, 2, F.in[I_GAINS] + 1 * 1024, 0, 3, F.in[I_GAINS] + 2 * 1024, (bf16*)(F.ws + WS_H), 2, F.gw, F.NGW); } SEAM(10);
    if (IN(11)) for (int rep_ = 0; rep_ < REP(11); ++rep_) { LAUNDER();
        pg8::Gemm g{(const bf16*)(F.ws + WS_H), (const bf16*)(F.ws + WS_W_GU), opaque(1024 / 2), 0, (const float*)(F.ws + WS_SA), (const float*)(F.ws + WS_CTL) + CW_COLSC + 0}; pg8::StaticOrder S; S.init(NR / 256, 2 * DFF / 256, F.G, (int)blockIdx.x, 0);
        epi::SwiGLUf8 E{F.ws + WS_HID, DFF, 1.f};
        pg8::gemm_phase<epi::SwiGLUf8, pg8::StaticOrder, true, true, 2>(F.lds, g, S, E, F.tid);
    } SEAM(11);
    if (IN(12)) for (int rep_ = 0; rep_ < REP(12); ++rep_) { LAUNDER();
        pg8::Gemm g{(const bf16*)(F.ws + WS_HID), (const bf16*)(F.ws + WS_W_DN), opaque(DFF / 2), 0}; pg8::StaticOrder S; S.init(128, 4, F.G, (int)blockIdx.x, 1);
        epi::Bf16 E{(bf16*)(F.ws + WS_Y), DM, 1.f / moe::DN_WSCALE};
        pg8::gemm_phase<epi::Bf16, pg8::StaticOrder, true, true, 1>(F.lds, g, S, E, F.tid);
    } SEAM(12);
    if (IN(13)) { LAUNDER();
        if (blockIdx.x < 8) { pg8::Gemm g{(const bf16*)(F.ws + WS_HID), (const bf16*)(F.ws + WS_W_DN), opaque(DFF / 2), 0}; pg8::CtxOrder S{(int)blockIdx.x}; epi::Bf16 E{(bf16*)(F.ws + WS_Y), DM, 1.f / moe::DN_WSCALE};
            pg8::gemm_phase<epi::Bf16, pg8::CtxOrder, true, true, 1>(F.lds, g, S, E, F.tid); }
        else resnorm_rows<false, true>(F, (const bf16*)(F.ws + WS_Y), 0, 5, F.in[I_GAINS] + 3 * 1024, 1, 0, F.in[I_GAINS] + 4 * 1024, (bf16*)(F.ws + WS1_H1), 1, F.gw - 8 * NWAVES, F.NGW - 8 * NWAVES);
    } if (IN(13)) xcd_barrier(bar, F.tid);
    if (IN(13)) { LAUNDER(); resnorm_rows<false, true>(F, (const bf16*)(F.ws + WS_Y), 0, 5, F.in[I_GAINS] + 3 * 1024, 1, 0, F.in[I_GAINS] + 4 * 1024, (bf16*)(F.ws + WS1_H1), 2, F.gw, F.NGW); } SEAM(13);
    if (IN(14)) for (int rep_ = 0; rep_ < REP(14); ++rep_) { LAUNDER();
        pg8::Gemm g{(const bf16*)(F.ws + WS1_H1), (const bf16*)(F.ws + WS_W_INC), opaque(1024 / 2), 0, (const float*)(F.ws + WS_SA), (const float*)(F.ws + WS_CTL) + CW_COLSC + 5632}; pg8::StaticOrder S; S.init(NR / 256, 5120 / 256, F.G, (int)blockIdx.x, 0);
        epi::InC E{(bf16*)(F.ws + WS1_PC), (const float*)(F.ws + WS_LB)};
        pg8::gemm_phase<epi::InC, pg8::StaticOrder, true, true, 2>(F.lds, g, S, E, F.tid);
    } SEAM(14);
    if (IN(15)) for (int rep_ = 0; rep_ < REP(15); ++rep_) { LAUNDER(); hg::pass_b(F); } SEAM(15);
    if (IN(16)) for (int rep_ = 0; rep_ < REP(16); ++rep_) { LAUNDER(); hg::pass_c(F); } SEAM(16);
    if (IN(17)) for (int rep_ = 0; rep_ < REP(17); ++rep_) { LAUNDER(); hg::pass_d(F); } SEAM(17);
    if (IN(18)) for (int rep_ = 0; rep_ < REP(18); ++rep_) { LAUNDER();
        pg8::Gemm g{(const bf16*)(F.ws + WS1_CAT), (const bf16*)(F.ws + WS_W_OUTC), opaque(1024), 0}; pg8::StaticOrder S; S.init(128, 4, F.G, (int)blockIdx.x, 1);
        epi::Bf16 E{(bf16*)(F.ws + WS1_Y), DM};
        pg8::gemm_phase<epi::Bf16, pg8::StaticOrder, true, true>(F.lds, g, S, E, F.tid);
    } SEAM(18);
    if (IN(19)) for (int rep_ = 0; rep_ < REP(19); ++rep_) { LAUNDER(); moe::p19_route(F); } SEAM(19);
    if (IN(20)) for (int rep_ = 0; rep_ < REP(20); ++rep_) { LAUNDER(); moe::p20_gather(F); } SEAM(20);
    if (IN(21)) for (int rep_ = 0; rep_ < REP(21); ++rep_) { LAUNDER();
        const int* te = (const int*)(F.ws + moe::WS_TILEE); const int ntiles = te[264];
        pg8::Gemm g{(const bf16*)(F.ws + WS1_XS), (const bf16*)((const unsigned char*)F.out + moe::MWGU_OFF), opaque(1024 / 2), moe::GU_SLAB}; pg8::GroupedOrder S; S.init(ntiles, 2 * DFF / 256, F.G, (int)blockIdx.x, te);
        epi::SwiGLUf8 E{F.ws + WS1_MHID, DFF, 1.f / moe::GU_WSCALE};
        pg8::gemm_phase<epi::SwiGLUf8, pg8::GroupedOrder, true, true, true>(F.lds, g, S, E, F.tid);
    } SEAM(21);
    if (IN(22)) for (int rep_ = 0; rep_ < REP(22); ++rep_) { LAUNDER();
        const int* te = (const int*)(F.ws + moe::WS_TILEE); const int ntiles = te[264];
        pg8::Gemm g{(const bf16*)(F.ws + WS1_MHID), (const bf16*)((const unsigned char*)F.out + moe::MWDN_OFF), opaque(DFF / 2), moe::DN_SLAB}; pg8::GroupedOrder S; S.init(ntiles, 4, F.G, (int)blockIdx.x, te);
        epi::Bf16 E{(bf16*)(F.ws + WS1_YS), DM, 1.f / moe::DN_WSCALE};
        pg8::gemm_phase<epi::Bf16, pg8::GroupedOrder, true, true, true>(F.lds, g, S, E, F.tid);
    } SEAM(22);
    if (IN(23)) for (int rep_ = 0; rep_ < REP(23); ++rep_) { LAUNDER(); moe::p23_combine(F); }
#undef IN
#undef SEAM
}

extern "C" void kernel_launch(void* const* d_in, const int* in_sizes, int n_in, void* d_out, int out_size, void* d_ws, size_t ws_size, hipStream_t stream) {
    static int grid = 0;
    if (grid == 0) {
        if (n_in != N_IN || out_size != NB * SEQ * DM || ws_size < WS_END) { fprintf(stderr, "kernel_launch: unexpected shapes: n_in %d out %d ws %zu (need %zu)\n", n_in, out_size, ws_size, (size_t)WS_END); grid = -1; return; }
        int dev = 0, cus = 0, per_cu = 0;
        if (hipGetDevice(&dev) != hipSuccess || hipDeviceGetAttribute(&cus, hipDeviceAttributeMultiprocessorCount, dev) != hipSuccess) { grid = -1; return; }
        if (hipFuncSetAttribute((const void*)fwd_kernel, hipFuncAttributeMaxDynamicSharedMemorySize, LDS_BYTES) != hipSuccess) { fprintf(stderr, "kernel_launch: hipFuncSetAttribute failed\n"); grid = -1; return; }
        if (hipOccupancyMaxActiveBlocksPerMultiprocessor(&per_cu, (const void*)fwd_kernel, NTHREADS, LDS_BYTES) != hipSuccess || per_cu < 1) { fprintf(stderr, "kernel_launch: occupancy query reports %d\n", per_cu); }
        (void)hipGetLastError();
        grid = cus;
    }
    if (grid < 0) return;
    if (hipMemsetAsync((char*)d_ws + WS_CTL, 0, CTL_ZERO_BYTES, stream) != hipSuccess) return;
    Args a{};
    for (int i = 0; i < N_IN; ++i) a.in[i] = (const float*)d_in[i];
    a.out = (float*)d_out; a.ws = (unsigned char*)d_ws;
#if N_LAUNCHES == 1
    a.ph_lo = 0; a.ph_hi = 64;
    hipLaunchKernelGGL(fwd_kernel, dim3(grid), dim3(NTHREADS), LDS_BYTES, stream, a);
#else
    for (int p = 0; p < 64; ++p) { a.ph_lo = p; a.ph_hi = p + 1; hipLaunchKernelGGL(fwd_kernel, dim3(grid), dim3(NTHREADS), LDS_BYTES, stream, a); }
#endif
}
```

```cpp
#define MLSTM_STUB 0
#define N_LAUNCHES 1
#define BAR_PROBE 0
#include <hip/hip_runtime.h>
#include <cstdio>
#include <cstdint>

#define GAS __attribute__((address_space(1)))
#define LAS __attribute__((address_space(3)))
typedef unsigned short bf16;
typedef short bf16x8 __attribute__((ext_vector_type(8)));
typedef short s16x4 __attribute__((ext_vector_type(4)));
typedef float f32x4 __attribute__((ext_vector_type(4)));
typedef float f32x16 __attribute__((ext_vector_type(16)));
typedef unsigned u32x4 __attribute__((ext_vector_type(4)));
typedef unsigned u32x2 __attribute__((ext_vector_type(2)));

constexpr int DM = 1024, NB = 2, SEQ = 16384, CTXL = 256, NT = SEQ + CTXL  , NR = NB * NT  ;
constexpr int NGRP = NT / 256;
constexpr int NH = 4;
constexpr int P_LD = 2048;
constexpr int DFF = 2816, NEXP = 8;
constexpr float RMS_EPS = 1e-6f;
constexpr int NWAVES = 8, NTHREADS = 512;

enum { I_X = 0, I_C, I_CTX, I_CCTX, I_WMOD, I_BMOD, I_GAINS, I_WINAB, I_QGAIN, I_WUQ, I_KVGAIN, I_WUKV, I_CONVW, I_CONVB, I_GATEB, I_MLGAIN, I_WOUTAB,
       I_FFNGU, I_FFNDN, I_WINC, I_LBLOG, I_HGGAIN, I_WOUTC, I_ROUTER, I_MOEGU, I_MOEDN, N_IN };

constexpr size_t MiB = 1u << 20;
constexpr size_t WS_CTL = 0, CTL_ZERO_BYTES = 1 * MiB;
constexpr size_t WS_MOD = 1 * MiB;
constexpr size_t WS_LB = WS_MOD + 160 * 1024;
constexpr size_t WS_ROPE = WS_MOD + 192 * 1024;
constexpr size_t WS_WGBASE = WS_MOD + 256 * 1024;
constexpr size_t WS_TOKREC = 2 * MiB;
constexpr size_t WS_SA = 5 * MiB;
constexpr size_t WS_W_INAB = 8 * MiB, WS_W_UP = 12 * MiB, WS_W_OUTAB = 14 * MiB, WS_W_GU = 16 * MiB, WS_W_DN = 27 * MiB, WS_W_INC = 33 * MiB, WS_W_OUTC = 43 * MiB;
constexpr size_t WS_D = 46 * MiB;
constexpr size_t WS_H = WS_D + 0 * MiB;
constexpr size_t WS_P = WS_D + 65 * MiB;
constexpr size_t WS_A2 = WS_D + 195 * MiB;
constexpr size_t WS_QKP = WS_D + 220 * MiB;
constexpr size_t WS_GATES = WS_D + 253 * MiB;
constexpr size_t WS_GL = WS_D + 255 * MiB + 512 * 1024;
constexpr size_t WS_Q = WS_D + 258 * MiB;
constexpr size_t WS_KN = WS_D + 307 * MiB;
constexpr size_t WS_KR = WS_D + 340 * MiB;
constexpr size_t WS_V = WS_D + 345 * MiB;
constexpr size_t WS_CAT = WS_D + 378 * MiB;
constexpr size_t WS_Y = WS_D + 443 * MiB;
constexpr size_t WS_VT8 = WS_D + 443 * MiB;
constexpr size_t WS_KV8 = WS_D + 443 * MiB;
constexpr size_t WS_K8 = WS_KV8;
constexpr size_t WS_MLU = WS_D + 508 * MiB;
constexpr size_t WS_MLS = WS_D + 542 * MiB;
constexpr size_t WS_HID = WS_D + 65 * MiB;
constexpr size_t WS1_Y = WS_D + 0 * MiB, WS1_H1 = WS_D + 0 * MiB, WS1_CAT = WS_D + 65 * MiB, WS1_H2 = WS_D + 65 * MiB, WS1_PC = WS_D + 130 * MiB, WS1_S = WS_D + 455 * MiB, WS1_U = WS_D + 0 * MiB  ;
constexpr size_t WS1_MHID = WS_D + 0 * MiB  , WS_RES = WS_D + 560 * MiB  , WS1_XS = WS_D + 430 * MiB  , WS1_YS = WS_D + 183 * MiB  ;
constexpr size_t WS_END = WS_D + 651 * MiB;
static_assert(WS_HID + (size_t)NR * DFF * 2 <= WS_Q, "HID overlay");
static_assert(WS1_YS + (size_t)67584 * 2048 <= WS1_XS && WS1_U + (size_t)32 * 65 * 65536 <= WS1_PC && WS1_XS + (size_t)67584 * 1024 <= WS_RES && WS_RES + 66 * MiB <= WS_END && WS1_MHID + (size_t)67584 * 2816 <= WS1_YS && WS_MLS + 18 * MiB <= WS_RES, "ws map");

constexpr int CW_BAR = 4096;
constexpr int CW_MOECNT = 8192;
constexpr size_t WS_CMAXP = 6 * MiB;
constexpr int CW_COLSC = 32768;

constexpr int RING_BYTES = 131072;
constexpr int MISC_OFF = 147456 - 256;
constexpr int LDS_BYTES = 147456;

#define LDS_WAIT() asm volatile("s_waitcnt lgkmcnt(0)" ::: "memory")
#define VM_WAIT() asm volatile("s_waitcnt vmcnt(0)" ::: "memory")
__device__ __forceinline__ float bf2f(unsigned h) { return __uint_as_float(h << 16); }
typedef __bf16 bf16x2_n __attribute__((ext_vector_type(2)));
typedef float f32x2_n __attribute__((ext_vector_type(2)));
__device__ __forceinline__ unsigned pk2(float lo, float hi) { const f32x2_n v = {lo, hi}; const bf16x2_n b = __builtin_convertvector(v, bf16x2_n); return __builtin_bit_cast(unsigned, b); }
__device__ __forceinline__ unsigned f2bf(float f) { return pk2(f, f) & 0xffffu; }
__device__ __forceinline__ float wave_sum(float v) {
#pragma unroll
    for (int o = 1; o < 64; o <<= 1) v += __shfl_xor(v, o);
    return v;
}
__device__ __forceinline__ float sigm(float x) { return __builtin_amdgcn_rcpf(1.f + __expf(-x)); }
__device__ __forceinline__ float siluf(float x) { return x * __builtin_amdgcn_rcpf(1.f + __expf(-x)); }
__device__ __forceinline__ float logsig(float x) { return fminf(x, 0.f) - log1pf(__expf(-fabsf(x))); }

#define XB_TMO      128
#define XB_XCNT(j)  (256  + 64 * (j))
#define XB_XSUB(j)  (1280 + 64 * (j))
#define XB_XGEN(j)  (2304 + 64 * (j))
#define XB_TOP      3328
#define XB_TOPGEN   3392
#define XCD_BAR_WORDS 3456
#define XB_SPIN_CAP (1u << 18)
__device__ __forceinline__ unsigned xb_ld(unsigned* p)              { return __hip_atomic_load(p, __ATOMIC_RELAXED, __HIP_MEMORY_SCOPE_AGENT); }
__device__ __forceinline__ unsigned xb_add(unsigned* p, unsigned v) { return __hip_atomic_fetch_add(p, v, __ATOMIC_RELAXED, __HIP_MEMORY_SCOPE_AGENT); }
__device__ __forceinline__ unsigned xb_xcc_id() { return (unsigned)__builtin_amdgcn_s_getreg((3 << 11) | 20) & 0xFu; }
#define XB_SPIN(cond, bar) do { unsigned _sp = 0; while (cond) { __builtin_amdgcn_s_sleep(1); \
    if ((++_sp & 255u) == 0u) { if (xb_ld(&(bar)[XB_TMO])) break; if (_sp > XB_SPIN_CAP) { atomicAdd(&(bar)[XB_TMO], 1u); break; } } } } while (0)
struct XcdBarrier { unsigned* bar; unsigned x; volatile LAS unsigned* st; };
__device__ __forceinline__ XcdBarrier xcd_barrier_post(unsigned* bar, volatile LAS unsigned* st, const int tid) {
    XcdBarrier b; b.bar = bar; b.x = xb_xcc_id(); b.st = st;
    if (tid == 0) (void)xb_add(&bar[XB_XCNT(b.x)], 1u);
    return b;
}
__device__ __forceinline__ void xcd_barrier_complete(unsigned* bar, unsigned x, unsigned& nloc, unsigned& nx) {
    const unsigned G = gridDim.x * gridDim.y * gridDim.z;
    unsigned sum, cnt, mine, sp = 0u;
    for (;;) {
        sum = 0u; cnt = 0u; mine = 0u;
#pragma unroll
        for (unsigned j = 0; j < 16; ++j) { const unsigned c = xb_ld(&bar[XB_XCNT(j)]); sum += c; cnt += (c > 0u) ? 1u : 0u; mine = (j == x) ? c : mine; }
        if (sum == G) break;
        __builtin_amdgcn_s_sleep(1);
        if ((++sp & 255u) == 0u) { if (xb_ld(&bar[XB_TMO])) break; if (sp > XB_SPIN_CAP) { atomicAdd(&bar[XB_TMO], 1u); break; } }
    }
    nloc = mine > 0u ? mine : 1u; nx = cnt > 0u ? cnt : 1u;
}
__device__ __forceinline__ void xcd_barrier(const XcdBarrier& b, const int tid) {
    asm volatile("s_waitcnt vmcnt(0)" ::: "memory");
    __syncthreads();
    if (tid == 0) {
        unsigned* bar = b.bar;
        __builtin_amdgcn_s_waitcnt(0);
        unsigned nloc = b.st[0], nx = b.st[1];
        if (nloc == 0u) { xcd_barrier_complete(bar, b.x, nloc, nx); b.st[0] = nloc; b.st[1] = nx; }
        const unsigned old = xb_add(&bar[XB_XSUB(b.x)], 1u);
        const unsigned gen = old / nloc;
        if (old + 1u == (gen + 1u) * nloc) {
            __builtin_amdgcn_fence(__ATOMIC_RELEASE, "agent");
            asm volatile("s_waitcnt vmcnt(0)" ::: "memory");
            const unsigned og = xb_add(&bar[XB_TOP], 1u);
            const unsigned tg = og / nx;
            if (og + 1u == (tg + 1u) * nx) xb_add(&bar[XB_TOPGEN], 1u);
            else XB_SPIN(xb_ld(&bar[XB_TOPGEN]) == tg, bar);
            __builtin_amdgcn_fence(__ATOMIC_ACQUIRE, "agent");
            xb_add(&bar[XB_XGEN(b.x)], 1u);
            asm volatile("s_waitcnt vmcnt(0)" ::: "memory");
        } else {
            XB_SPIN(xb_ld(&bar[XB_XGEN(b.x)]) == gen, bar);
            __builtin_amdgcn_fence(__ATOMIC_ACQUIRE, "agent");
            asm volatile("s_waitcnt vmcnt(0)" ::: "memory");
        }
    }
    __syncthreads();
}

namespace pg8 {
#define PG8_LAS __attribute__((address_space(3)))
typedef unsigned short bf16_t;
constexpr int BM = 256, BK = 64, HALF = 128, HTB = HALF * BK * 2, STAGE_BYTES = 8 * HTB, NXCD = 8, WGM = 8;
__host__ __device__ __forceinline__ int lds_byte(int r, int c) { const int st = (r >> 4) * 2 + (c >> 5), rr = r & 15, cc = c & 31, ob = rr * 64 + cc * 2; return st * 1024 + (ob ^ (((ob >> 9) & 1) << 5)); }
__host__ __device__ __forceinline__ void stage_rc(int b, int& R, int& C) { const int st = b / 1024, sb = b % 1024, swz = sb ^ (((sb >> 9) & 1) << 5); R = (st >> 1) * 16 + swz / 64; C = (st & 1) * 32 + (swz % 64) / 2; }
__host__ __device__ __forceinline__ int perm32(int rho) { const int n = rho >> 4, i = rho & 15; return 8 * (i >> 2) + 4 * n + (i & 3); }
struct Unit { int pm, pn, eb; };
struct Gemm { const bf16_t* A; const bf16_t* Bt; int K; size_t estride; const float* sa = nullptr; const float* sw = nullptr; };
__device__ __forceinline__ unsigned cvt_pk_bf16(float lo, float hi) { unsigned r; asm volatile("v_cvt_pk_bf16_f32 %0, %1, %2" : "=v"(r) : "v"(lo), "v"(hi)); return r; }

struct StaticOrder {
    int nM, nN, nwg, G, c, lat_only;
    __device__ void init(int nM_, int nN_, int G_, int c_, int lat_only_) { nM = nM_; nN = nN_; nwg = nM * nN; G = G_; c = c_; lat_only = lat_only_; }
    __device__ bool next(int i, Unit& u) const {
        const long L = (long)i * G + c; if (L >= nwg) return false;
        int wgid = (int)L; { const int q = nwg / NXCD, r = nwg % NXCD, xcd = wgid % NXCD, off = wgid / NXCD; wgid = (xcd < r ? xcd * (q + 1) : r * (q + 1) + (xcd - r) * q) + off; }
        const int nig = WGM * nN, gid = wgid / nig, fm = gid * WGM, gsz = (nM - fm) < WGM ? (nM - fm) : WGM;
        int pm = fm + ((wgid % nig) % gsz); u.pn = (wgid % nig) / gsz; u.eb = 0;
        if (lat_only) pm = pm + 1 + (pm >= 64 ? 1 : 0);
        u.pm = pm; return true;
    }
    __device__ __forceinline__ void a_ready(const Unit&) const {}
    __device__ __forceinline__ void done(const Unit&) const {}
};
struct CtxOrder {
    int c;
    __device__ bool next(int i, Unit& u) const { if (i != 0 || c >= 8) return false; u.pm = (c >> 2) ? 65 : 0; u.pn = c & 3; u.eb = 0; return true; }
    __device__ __forceinline__ void a_ready(const Unit&) const {}
    __device__ __forceinline__ void done(const Unit&) const {}
};
struct GroupedOrder {
    int nM, nN, nwg, G, c; const int* tile_e;
    __device__ void init(int nM_, int nN_, int G_, int c_, const int* te) { nM = nM_; nN = nN_; nwg = nM * nN; G = G_; c = c_; tile_e = te; }
    __device__ bool next(int i, Unit& u) const {
        const long L = (long)i * G + c; if (L >= nwg) return false;
        int wgid = (int)L; { const int q = nwg / NXCD, r = nwg % NXCD, xcd = wgid % NXCD, off = wgid / NXCD; wgid = (xcd < r ? xcd * (q + 1) : r * (q + 1) + (xcd - r) * q) + off; }
        const int nig = WGM * nN, gid = wgid / nig, fm = gid * WGM, gsz = (nM - fm) < WGM ? (nM - fm) : WGM;
        u.pm = fm + ((wgid % nig) % gsz); u.pn = (wgid % nig) / gsz; u.eb = tile_e[u.pm]; return true;
    }
    __device__ __forceinline__ void a_ready(const Unit&) const {}
    __device__ __forceinline__ void done(const Unit&) const {}
};
typedef int pg8_v4i __attribute__((ext_vector_type(4))); typedef int pg8_v8i __attribute__((ext_vector_type(8)));
template <bool F8> struct pg8_frag;
template <> struct pg8_frag<false> { ::bf16x8 v[2]; };
template <> struct pg8_frag<true> { pg8_v8i w; };
__device__ __forceinline__ void pg8_put(pg8_v8i& w, ::bf16x8 t, int k) { const pg8_v4i a = __builtin_bit_cast(pg8_v4i, t); if (k == 0) { w[0] = a[0]; w[1] = a[1]; w[2] = a[2]; w[3] = a[3]; } else { w[4] = a[0]; w[5] = a[1]; w[6] = a[2]; w[7] = a[3]; } }
template <class Epi, class Sched, bool ALIGN_EPI = false, bool SP2 = false, int FP8 = 0>
__device__ __forceinline__ void gemm_phase(PG8_LAS unsigned char* lds, const Gemm g, const Sched& S, const Epi& E, const int tid_in) {
    const int tid = tid_in, wid = __builtin_amdgcn_readfirstlane(tid >> 6), lane = tid & 63, wr = wid >> 2, wc = wid & 3, fr = lane & 15, fq = lane >> 4;
    const int K = g.K, nt = K / BK;
    unsigned voffA[2], voffB[2];
#pragma unroll
    for (int i = 0; i < 2; ++i) { int R, C; stage_rc(tid * 16 + i * 8192, R, C); const int Rb = Epi::PERM ? ((R & ~31) + perm32(R & 31)) : R;
        voffA[i] = (unsigned)(R * K + C) * 2u; voffB[i] = (unsigned)(Rb * K + C) * 2u; }
    const size_t kstep = (size_t)(BK * 2);
    const size_t hstep = (size_t)HALF * K * 2;
    const size_t tstep = 2 * hstep;
    const unsigned ldsw = (unsigned)wid * 1024u;
    const int aoff = lds_byte(wr * 64 + fr, fq * 8), boff = lds_byte(wc * 32 + fr, fq * 8);
#define PG8_SA(b, h) (((b) * 2 + (h)) * HTB)
#define PG8_SB(b, h) ((4 + (b) * 2 + (h)) * HTB)
#define PG8_STAGE(bufoff, gbase, voff) do { _Pragma("unroll") for (int _i = 0; _i < 2; ++_i) \
        __builtin_amdgcn_global_load_lds((const unsigned*)((const char*)(gbase) + (voff)[_i]), (PG8_LAS unsigned*)(lds + (bufoff) + ldsw + _i * 8192), 16, 0, 0); } while (0)
#define PG8_LDA(dst, b, h) do { _Pragma("unroll") for (int m = 0; m < 4; ++m) _Pragma("unroll") for (int k = 0; k < 2; ++k) { const ::bf16x8 t_ = *(const PG8_LAS ::bf16x8*)(lds + PG8_SA(b, h) + aoff + m * 2048 + k * 1024); if constexpr (FP8 == 1) pg8_put(dst[m].w, t_, k); else dst[m].v[k] = t_; } } while (0)
#define PG8_LDB(dst, b, h) do { _Pragma("unroll") for (int n = 0; n < 2; ++n) _Pragma("unroll") for (int k = 0; k < 2; ++k) { const ::bf16x8 t_ = *(const PG8_LAS ::bf16x8*)(lds + PG8_SB(b, h) + boff + n * 2048 + k * 1024); if constexpr (FP8 == 1) pg8_put(dst[n].w, t_, k); else dst[n].v[k] = t_; } } while (0)
#define PG8_MMA(ai, bj, At, Bt) do { __builtin_amdgcn_s_setprio(1); _Pragma("unroll") for (int m = 0; m < 4; ++m) _Pragma("unroll") for (int n = 0; n < 2; ++n) _Pragma("unroll") for (int k = 0; k < 2; ++k) \
        { if constexpr (FP8 == 1) { if (k == 0) asm volatile("v_mfma_f32_16x16x128_f8f6f4 %0, %1, %2, %0" : "+v"(acc[ai][bj][m][n]) : "v"(Bt[n].w), "v"(At[m].w)); }     \
          else if constexpr (FP8 == 2) asm volatile("v_mfma_i32_16x16x64_i8 %0, %1, %2, %0" : "+v"(acc[ai][bj][m][n]) : "v"(Bt[n].v[k]), "v"(At[m].v[k])); \
          else acc[ai][bj][m][n] = __builtin_amdgcn_mfma_f32_16x16x32_bf16(Bt[n].v[k], At[m].v[k], acc[ai][bj][m][n], 0, 0, 0); } __builtin_amdgcn_s_setprio(0); } while (0)
#define PG8_WAIT_V(n) asm volatile("s_waitcnt vmcnt(" #n ")" ::: "memory")
#define PG8_WAIT_L(n) asm volatile("s_waitcnt lgkmcnt(" #n ")" ::: "memory")
#define PG8_BAR __builtin_amdgcn_s_barrier()
#define PG8_SCHED __builtin_amdgcn_sched_barrier(0)
    Unit cur, nxt; int ui = 0;
    if (!S.next(0, cur)) return;
    ::f32x4 acc[2][2][4][2];
#pragma unroll
    for (int a = 0; a < 2; ++a)
#pragma unroll
        for (int b = 0; b < 2; ++b)
#pragma unroll
            for (int m = 0; m < 4; ++m)
#pragma unroll
                for (int n = 0; n < 2; ++n) acc[a][b][m][n] = (::f32x4){0.f, 0.f, 0.f, 0.f};
    pg8_frag<FP8 == 1> At[4], B0[2], B1[2];
    const char* cA = (const char*)g.A + (size_t)cur.pm * tstep; const char* cB = (const char*)g.Bt + (size_t)cur.eb * g.estride + (size_t)cur.pn * tstep;
    S.a_ready(cur);
    if constexpr (SP2) {
        PG8_STAGE(PG8_SB(0, 0), cB, voffB); PG8_STAGE(PG8_SB(0, 1), cB + hstep, voffB); PG8_STAGE(PG8_SA(0, 0), cA, voffA); PG8_STAGE(PG8_SA(0, 1), cA + hstep, voffA);
        if (wr == 1) PG8_BAR;
        PG8_WAIT_V(2); PG8_BAR;
        PG8_STAGE(PG8_SB(1, 0), cB + kstep, voffB); PG8_STAGE(PG8_SA(1, 0), cA + kstep, voffA); PG8_STAGE(PG8_SB(1, 1), cB + hstep + kstep, voffB);
        PG8_WAIT_V(6); PG8_BAR;
    } else {
        PG8_STAGE(PG8_SB(0, 0), cB, voffB); PG8_STAGE(PG8_SA(0, 0), cA, voffA); PG8_STAGE(PG8_SB(0, 1), cB + hstep, voffB); PG8_STAGE(PG8_SA(0, 1), cA + hstep, voffA);
        if (wr == 1) PG8_BAR;
        PG8_WAIT_V(4); PG8_BAR;
        PG8_STAGE(PG8_SB(1, 0), cB + kstep, voffB); PG8_STAGE(PG8_SA(1, 0), cA + kstep, voffA); PG8_STAGE(PG8_SB(1, 1), cB + hstep + kstep, voffB);
        PG8_WAIT_V(6); PG8_BAR;
    }
    for (;;) {
        const bool has_next = S.next(ui + 1, nxt);
        const char* nA = has_next ? (const char*)g.A + (size_t)nxt.pm * tstep : cA; const char* nB = has_next ? (const char*)g.Bt + (size_t)nxt.eb * g.estride + (size_t)nxt.pn * tstep : cB;
        for (int t = 0; t < nt; t += 2) {
            const bool last = (t == nt - 2);
            const char* a1 = cA + (size_t)(t + 1) * kstep;
            const char* a2 = last ? nA : cA + (size_t)(t + 2) * kstep; const char* b2 = last ? nB : cB + (size_t)(t + 2) * kstep;
            const char* a3 = a2 + kstep; const char* b3 = b2 + kstep;
            if (last && has_next) S.a_ready(nxt);
            if constexpr (SP2) {
            PG8_LDB(B0, 0, 0); PG8_LDB(B1, 0, 1); PG8_SCHED; PG8_LDA(At, 0, 0); PG8_STAGE(PG8_SA(1, 1), a1 + hstep, voffA);
            PG8_WAIT_V(8); PG8_WAIT_L(0); PG8_BAR; PG8_MMA(0, 0, At, B0); PG8_MMA(0, 1, At, B1); PG8_BAR; PG8_SCHED;
            PG8_LDA(At, 0, 1); PG8_STAGE(PG8_SB(0, 0), b2, voffB); PG8_STAGE(PG8_SB(0, 1), b2 + hstep, voffB); PG8_STAGE(PG8_SA(0, 0), a2, voffA);
            PG8_WAIT_V(8); PG8_WAIT_L(0); PG8_BAR; PG8_MMA(1, 0, At, B0); PG8_MMA(1, 1, At, B1); PG8_BAR; PG8_SCHED;
            PG8_LDB(B0, 1, 0); PG8_LDB(B1, 1, 1); PG8_SCHED; PG8_LDA(At, 1, 0); PG8_STAGE(PG8_SA(0, 1), a2 + hstep, voffA);
            PG8_WAIT_V(8); PG8_WAIT_L(0); PG8_BAR; PG8_MMA(0, 0, At, B0); PG8_MMA(0, 1, At, B1); PG8_BAR; PG8_SCHED;
            PG8_LDA(At, 1, 1); PG8_STAGE(PG8_SB(1, 0), b3, voffB); PG8_STAGE(PG8_SB(1, 1), b3 + hstep, voffB); PG8_STAGE(PG8_SA(1, 0), a3, voffA);
            PG8_WAIT_V(8); PG8_WAIT_L(0); PG8_BAR; PG8_MMA(1, 0, At, B0); PG8_MMA(1, 1, At, B1); PG8_BAR; PG8_SCHED;
            } else {
            PG8_LDB(B0, 0, 0); PG8_SCHED; PG8_LDA(At, 0, 0); PG8_STAGE(PG8_SA(1, 1), a1 + hstep, voffA);
            PG8_WAIT_L(8); PG8_BAR; PG8_WAIT_L(0); PG8_MMA(0, 0, At, B0); PG8_BAR; PG8_SCHED;
            PG8_LDB(B1, 0, 1); PG8_STAGE(PG8_SB(0, 0), b2, voffB);
            PG8_BAR; PG8_WAIT_L(0); PG8_MMA(0, 1, At, B1); PG8_BAR;
            PG8_LDA(At, 0, 1); PG8_STAGE(PG8_SA(0, 0), a2, voffA);
            PG8_BAR; PG8_WAIT_L(0); PG8_MMA(1, 0, At, B0); PG8_BAR; PG8_SCHED;
            PG8_STAGE(PG8_SB(0, 1), b2 + hstep, voffB);
            PG8_WAIT_V(6); PG8_BAR; PG8_MMA(1, 1, At, B1); PG8_BAR;
            PG8_LDB(B0, 1, 0); PG8_SCHED; PG8_LDA(At, 1, 0); PG8_STAGE(PG8_SA(0, 1), a2 + hstep, voffA);
            PG8_WAIT_L(8); PG8_BAR; PG8_WAIT_L(0); PG8_MMA(0, 0, At, B0); PG8_BAR; PG8_SCHED;
            PG8_LDB(B1, 1, 1); PG8_STAGE(PG8_SB(1, 0), b3, voffB);
            PG8_BAR; PG8_WAIT_L(0); PG8_MMA(0, 1, At, B1); PG8_BAR;
            PG8_LDA(At, 1, 1); PG8_STAGE(PG8_SA(1, 0), a3, voffA);
            PG8_BAR; PG8_WAIT_L(0); PG8_MMA(1, 0, At, B0); PG8_BAR; PG8_SCHED;
            PG8_STAGE(PG8_SB(1, 1), b3 + hstep, voffB);
            PG8_WAIT_V(6); PG8_BAR; PG8_MMA(1, 1, At, B1); PG8_BAR;
            }
        }
        if constexpr (ALIGN_EPI) { if (wr == 0) PG8_BAR; }
        asm volatile("s_nop 15\n\ts_nop 15" : "+v"(acc[1][1][0][0]), "+v"(acc[1][1][0][1]), "+v"(acc[1][1][1][0]), "+v"(acc[1][1][1][1]), "+v"(acc[1][1][2][0]), "+v"(acc[1][1][2][1]), "+v"(acc[1][1][3][0]), "+v"(acc[1][1][3][1]));
        if constexpr (FP8 == 2) {
            const int r0_ = cur.pm * BM + wr * 64 + fr; ::f32x4 sw_[2][2];
#pragma unroll
            for (int bj = 0; bj < 2; ++bj)
#pragma unroll
                for (int n = 0; n < 2; ++n) sw_[bj][n] = *(const ::f32x4*)(g.sw + cur.pn * BM + bj * HALF + wc * 32 + 8 * fq + 4 * n);
#pragma unroll
            for (int ai = 0; ai < 2; ++ai)
#pragma unroll
                for (int m = 0; m < 4; ++m) { const float s_ = g.sa[r0_ + ai * HALF + m * 16];
#pragma unroll
                    for (int bj = 0; bj < 2; ++bj)
#pragma unroll
                        for (int n = 0; n < 2; ++n)
#pragma unroll
                            for (int e = 0; e < 4; ++e) acc[ai][bj][m][n][e] = (float)__float_as_int(acc[ai][bj][m][n][e]) * (s_ * sw_[bj][n][e]); } }
        if constexpr (!Epi::AFTER_DRAIN) { E(acc, cur, wr, wc, fr, fq); S.done(cur); }
        if (!has_next) break;
#pragma unroll
        for (int a = 0; a < 2; ++a)
#pragma unroll
            for (int b = 0; b < 2; ++b)
#pragma unroll
                for (int m = 0; m < 4; ++m)
#pragma unroll
                    for (int n = 0; n < 2; ++n) acc[a][b][m][n] = (::f32x4){0.f, 0.f, 0.f, 0.f};
        cur = nxt; cA = nA; cB = nB; ++ui;
        if constexpr (ALIGN_EPI) { if (wr == 1) PG8_BAR; }
    }
    PG8_WAIT_V(0);
    if constexpr (!ALIGN_EPI) { if (wr == 0) PG8_BAR; }
    PG8_BAR;
    if constexpr (Epi::AFTER_DRAIN) { E.fused(acc, cur, wr, wc, fr, fq, lds, wid, lane); S.done(cur); }
#undef PG8_SA
#undef PG8_SB
#undef PG8_STAGE
#undef PG8_LDA
#undef PG8_LDB
#undef PG8_MMA
#undef PG8_WAIT_V
#undef PG8_WAIT_L
#undef PG8_BAR
#undef PG8_SCHED
}
}

namespace epi {
using pg8::Unit; using pg8::cvt_pk_bf16; using pg8::BM; using pg8::HALF;
struct Bf16 {
    static constexpr bool PERM = true, AFTER_DRAIN = false;
    bf16* O; int ldc; float scale = 1.f;
    __device__ __forceinline__ void operator()(const f32x4 (&acc)[2][2][4][2], const Unit& u, int wr, int wc, int fr, int fq) const {
        const int row0 = u.pm * BM + wr * 64 + fr, col0 = u.pn * BM + wc * 32 + 8 * fq;
#pragma unroll
        for (int ai = 0; ai < 2; ++ai)
#pragma unroll
            for (int m = 0; m < 4; ++m) { bf16* rowp = O + (size_t)(row0 + ai * HALF + m * 16) * ldc + col0;
#pragma unroll
                for (int bj = 0; bj < 2; ++bj) { const f32x4 v0 = acc[ai][bj][m][0] * scale, v1 = acc[ai][bj][m][1] * scale;
                    u32x4 w; w.x = cvt_pk_bf16(v0[0], v0[1]); w.y = cvt_pk_bf16(v0[2], v0[3]); w.z = cvt_pk_bf16(v1[0], v1[1]); w.w = cvt_pk_bf16(v1[2], v1[3]);
                    *(u32x4*)(rowp + bj * HALF) = w; } }
    }
};
struct InAB {
    static constexpr bool PERM = true, AFTER_DRAIN = false;
    bf16* O; float* G;
    __device__ __forceinline__ void operator()(const f32x4 (&acc)[2][2][4][2], const Unit& u, int wr, int wc, int fr, int fq) const {
        const int row0 = u.pm * BM + wr * 64 + fr, col0 = u.pn * BM + wc * 32 + 8 * fq;
        const bool gates = (u.pn == 7) && (wc == 2) && (fq < 2);
#pragma unroll
        for (int ai = 0; ai < 2; ++ai)
#pragma unroll
            for (int m = 0; m < 4; ++m) { const int row = row0 + ai * HALF + m * 16; bf16* rowp = O + (size_t)row * P_LD + col0;
#pragma unroll
                for (int bj = 0; bj < 2; ++bj) { const f32x4 v0 = acc[ai][bj][m][0], v1 = acc[ai][bj][m][1];
                    u32x4 w; w.x = cvt_pk_bf16(v0[0], v0[1]); w.y = cvt_pk_bf16(v0[2], v0[3]); w.z = cvt_pk_bf16(v1[0], v1[1]); w.w = cvt_pk_bf16(v1[2], v1[3]);
                    *(u32x4*)(rowp + bj * HALF) = w;
                    if (bj == 1 && gates) { float* gp = G + (size_t)row * 16 + 8 * fq; *(f32x4*)gp = v0; *(f32x4*)(gp + 4) = v1; } } }
    }
};
struct UpProj {
    static constexpr bool PERM = true, AFTER_DRAIN = false;
    unsigned char* ws;
    __device__ __forceinline__ void operator()(const f32x4 (&acc)[2][2][4][2], const Unit& u, int wr, int wc, int fr, int fq) const {
        const int b = u.pm >= NGRP ? 1 : 0, j0 = u.pm * BM - b * NT + wr * 64 + fr;
        unsigned off[2], ldb[2];
#pragma unroll
        for (int bj = 0; bj < 2; ++bj) {
            const int col = u.pn * BM + bj * HALF + wc * 32 + 8 * fq; int hd, w; unsigned base;
            if (col < 768) { hd = col / 192; w = col - hd * 192; base = (unsigned)WS_Q; ldb[bj] = 384u; }
            else { const int c2 = col - 768; hd = c2 >> 8; w = c2 & 255; if (w < 128) base = (unsigned)WS_KN; else { base = (unsigned)WS_V; w -= 128; } ldb[bj] = 256u; }
            off[bj] = base + ((unsigned)(b * NH + hd) * NT + (unsigned)j0) * ldb[bj] + 2u * w;
        }
#pragma unroll
        for (int ai = 0; ai < 2; ++ai)
#pragma unroll
            for (int m = 0; m < 4; ++m) {
#pragma unroll
                for (int bj = 0; bj < 2; ++bj) { const f32x4 v0 = acc[ai][bj][m][0], v1 = acc[ai][bj][m][1];
                    u32x4 wv; wv.x = cvt_pk_bf16(v0[0], v0[1]); wv.y = cvt_pk_bf16(v0[2], v0[3]); wv.z = cvt_pk_bf16(v1[0], v1[1]); wv.w = cvt_pk_bf16(v1[2], v1[3]);
                    *(u32x4*)(ws + (off[bj] + (unsigned)(ai * HALF + m * 16) * ldb[bj])) = wv; }
                asm volatile("" ::: "memory"); }
    }
};
struct SwiGLU {
    static constexpr bool PERM = true, AFTER_DRAIN = false;
    bf16* Hd; int ldh;
    __device__ __forceinline__ void operator()(const f32x4 (&acc)[2][2][4][2], const Unit& u, int wr, int wc, int fr, int fq) const {
        const int row0 = u.pm * BM + wr * 64 + fr, hc0 = u.pn * 128 + wc * 16 + 4 * fq;
#pragma unroll
        for (int ai = 0; ai < 2; ++ai)
#pragma unroll
            for (int m = 0; m < 4; ++m) { bf16* rowp = Hd + (size_t)(row0 + ai * HALF + m * 16) * ldh + hc0;
#pragma unroll
                for (int bj = 0; bj < 2; ++bj) { const f32x4 g = acc[ai][bj][m][0], uu = acc[ai][bj][m][1];
                    u32x2 w; w.x = cvt_pk_bf16(siluf(g[0]) * uu[0], siluf(g[1]) * uu[1]); w.y = cvt_pk_bf16(siluf(g[2]) * uu[2], siluf(g[3]) * uu[3]);
                    *(u32x2*)(rowp + bj * 64) = w; } }
    }
};
struct InC {
    static constexpr bool PERM = true, AFTER_DRAIN = false;
    bf16* O; const float* lb;
    __device__ __forceinline__ void operator()(const f32x4 (&acc)[2][2][4][2], const Unit& u, int wr, int wc, int fr, int fq) const {
        const int row0 = u.pm * BM + wr * 64 + fr, col0 = u.pn * BM + wc * 32 + 8 * fq; const int mode = u.pn < 4 ? 1 : (u.pn < 12 ? 2 : 0);
        f32x4 om[2][2];
#pragma unroll
        for (int bj = 0; bj < 2; ++bj) { const float* lp = lb + ((col0 + bj * HALF) & 1023); const f32x4 l0 = mode == 2 ? *(const f32x4*)lp : (f32x4){0.f, 0.f, 0.f, 0.f}, l1 = mode == 2 ? *(const f32x4*)(lp + 4) : (f32x4){0.f, 0.f, 0.f, 0.f};
            om[bj][0] = 1.f - l0; om[bj][1] = 1.f - l1; }
#pragma unroll
        for (int ai = 0; ai < 2; ++ai)
#pragma unroll
            for (int m = 0; m < 4; ++m) { bf16* rowp = O + (size_t)(row0 + ai * HALF + m * 16) * 5120 + col0;
#pragma unroll
                for (int bj = 0; bj < 2; ++bj) { f32x4 v0 = acc[ai][bj][m][0], v1 = acc[ai][bj][m][1];
                    if (mode == 1) {
#pragma unroll
                        for (int j = 0; j < 4; ++j) { v0[j] = siluf(v0[j]); v1[j] = siluf(v1[j]); } }
                    else if (mode == 2) {
#pragma unroll
                        for (int j = 0; j < 4; ++j) { v0[j] = om[bj][0][j] * __builtin_amdgcn_rcpf(1.f + __expf(v0[j])); v1[j] = om[bj][1][j] * __builtin_amdgcn_rcpf(1.f + __expf(v1[j])); } }
                    u32x4 w; w.x = cvt_pk_bf16(v0[0], v0[1]); w.y = cvt_pk_bf16(v0[2], v0[3]); w.z = cvt_pk_bf16(v1[0], v1[1]); w.w = cvt_pk_bf16(v1[2], v1[3]);
                    *(u32x4*)(rowp + bj * HALF) = w; } }
    }
};
struct SwiGLUf8 {
    static constexpr bool PERM = true, AFTER_DRAIN = false;
    unsigned char* Hd; int ldh; float scale;
    __device__ __forceinline__ void operator()(const f32x4 (&acc)[2][2][4][2], const Unit& u, int wr, int wc, int fr, int fq) const {
        const int row0 = u.pm * BM + wr * 64 + fr, hc0 = u.pn * 128 + wc * 16 + 4 * fq;
#pragma unroll
        for (int ai = 0; ai < 2; ++ai)
#pragma unroll
            for (int m = 0; m < 4; ++m) { unsigned char* rowp = Hd + (size_t)(row0 + ai * HALF + m * 16) * ldh + hc0;
#pragma unroll
                for (int bj = 0; bj < 2; ++bj) { const f32x4 g = acc[ai][bj][m][0] * scale, uu = acc[ai][bj][m][1] * scale;
                    int w = __builtin_amdgcn_cvt_pk_fp8_f32(siluf(g[0]) * uu[0], siluf(g[1]) * uu[1], 0, false); w = __builtin_amdgcn_cvt_pk_fp8_f32(siluf(g[2]) * uu[2], siluf(g[3]) * uu[3], w, true);
                    *(int*)(rowp + bj * 64) = w; } }
    }
};
}

#ifndef ATT_PROBE
#define ATT_PROBE 0
#endif
namespace att {
constexpr int NW = 8, QBLK = 32, KVBLK = 64;
constexpr float SCALE = 0.07216878364870322f;
constexpr float THR = 2.f;
constexpr float PSH = 5.f;
constexpr int KP = 208;
constexpr int VP = 80;
constexpr int SHM_V = 128 * VP, SHM_K = 64 * KP;
constexpr int NBUF = 3;
constexpr int SLOT = SHM_K + SHM_V;
constexpr int OFF_K = 0, OFF_V = SHM_K, OFF_W = NBUF * SLOT, LDS_TOTAL = OFF_W + NW * 64 * 4;
static_assert(LDS_TOTAL <= RING_BYTES, "attention LDS");
#define KSWZ(row, colB) ((row) * 384 + ((colB) ^ (((row) & 7) << 4)))
#define SBAR() __builtin_amdgcn_sched_barrier(0)
__device__ __forceinline__ int crow(int r, int hi) { return (r & 3) + 8 * (r >> 2) + 4 * hi; }
__device__ __forceinline__ unsigned cvtpk(float lo, float hi) { unsigned r; asm volatile("v_cvt_pk_bf16_f32 %0, %1, %2" : "=v"(r) : "v"(lo), "v"(hi)); return r; }

__device__ __forceinline__ void partialSM(f32x16& p0, f32x16& p1, float& m_reg, float& mn, float& alpha) {
  constexpr float C = SCALE * 1.4426950408889634f;
  float pmax = p0[0];
#pragma unroll
  for (int r = 1; r < 16; ++r) pmax = fmaxf(pmax, p0[r]);
#pragma unroll
  for (int r = 0; r < 16; ++r) pmax = fmaxf(pmax, p1[r]);
  { auto rr = __builtin_amdgcn_permlane32_swap(__float_as_uint(pmax), __float_as_uint(pmax), false, false);
    pmax = fmaxf(__uint_as_float(rr[0]), __uint_as_float(rr[1])); }
  if (__builtin_expect(__all(pmax - m_reg <= THR / SCALE), 1)) { mn = m_reg; alpha = 1.f; }
  else { mn = fmaxf(m_reg, pmax); alpha = __builtin_amdgcn_exp2f((m_reg - mn) * C); m_reg = mn; }
  float mnC = PSH - mn * C;
#pragma unroll
  for (int r = 0; r < 16; ++r) p0[r] = fmaf(p0[r], C, mnC);
#pragma unroll
  for (int r = 0; r < 16; ++r) p1[r] = fmaf(p1[r], C, mnC);
#pragma unroll
  for (int r = 0; r < 16; ++r) p0[r] = __builtin_amdgcn_exp2f(p0[r]);
}
#define PK4(P, BASE, OUT) do { unsigned a0 = cvtpk(P[BASE + 0], P[BASE + 1]), a1 = cvtpk(P[BASE + 2], P[BASE + 3]);   \
    unsigned b0 = cvtpk(P[BASE + 4], P[BASE + 5]), b1 = cvtpk(P[BASE + 6], P[BASE + 7]);                              \
    auto r0 = __builtin_amdgcn_permlane32_swap(a0, b0, false, false); auto r1 = __builtin_amdgcn_permlane32_swap(a1, b1, false, false); \
    u32x4 w = {r0[0], r1[0], r0[1], r1[1]}; OUT = *reinterpret_cast<bf16x8*>(&w); } while (0)
typedef int v8i __attribute__((ext_vector_type(8)));
typedef int v4i __attribute__((ext_vector_type(4)));
__device__ __forceinline__ unsigned pk4f8(float a, float b, float c, float d) { int w = __builtin_amdgcn_cvt_pk_fp8_f32(a, b, 0, false); w = __builtin_amdgcn_cvt_pk_fp8_f32(c, d, w, true); return (unsigned)w; }
__device__ __forceinline__ unsigned pk4f8o(float a, float b, float c, float d, int old) { int w = __builtin_amdgcn_cvt_pk_fp8_f32(a, b, old, false); w = __builtin_amdgcn_cvt_pk_fp8_f32(c, d, w, true); return (unsigned)w; }
__device__ __forceinline__ void finishSM(f32x16& p0, f32x16& p1, float alpha, float& l_reg, v8i& p8) {
#pragma unroll
  for (int r = 0; r < 16; ++r) p1[r] = __builtin_amdgcn_exp2f(p1[r]);
#if ATT_PROBE == 2
#pragma unroll
  for (int r = 0; r < 16; ++r) { float t; asm volatile("v_exp_f32 %0, %1" : "=v"(t) : "v"(p0[r])); asm volatile("v_exp_f32 %0, %1" : "=v"(t) : "v"(p1[r])); }
#endif
  float ps = 0;
#pragma unroll
  for (int r = 0; r < 16; ++r) ps += p0[r];
#pragma unroll
  for (int r = 0; r < 16; ++r) ps += p1[r];
  { auto rr = __builtin_amdgcn_permlane32_swap(__float_as_uint(ps), __float_as_uint(ps), false, false);
    ps = __uint_as_float(rr[0]) + __uint_as_float(rr[1]); }
  l_reg = l_reg * alpha + ps;
#pragma unroll
  for (int w = 0; w < 4; ++w) { p8[w] = (int)pk4f8(p0[4 * w], p0[4 * w + 1], p0[4 * w + 2], p0[4 * w + 3]); p8[4 + w] = (int)pk4f8(p1[4 * w], p1[4 * w + 1], p1[4 * w + 2], p1[4 * w + 3]); }
}
__device__ __forceinline__ v8i ld32(const char* p) { const v4i a = *reinterpret_cast<const v4i*>(p), b = *reinterpret_cast<const v4i*>(p + 16); return __builtin_shufflevector(a, b, 0, 1, 2, 3, 4, 5, 6, 7); }
__device__ __forceinline__ void qkt1(f32x16& p0, f32x16& p1, const char* Ks, int kb, const v8i (&qf8)[3]) {
  v8i a0 = ld32(Ks + kb), a1 = ld32(Ks + kb + 32 * KP); const v8i c0 = ld32(Ks + kb + 64), c1 = ld32(Ks + kb + 64 + 32 * KP);
  asm volatile("v_mfma_f32_32x32x64_f8f6f4 %0, %1, %2, 0" : "=&v"(p0) : "v"(a0), "v"(qf8[0]));
  asm volatile("v_mfma_f32_32x32x64_f8f6f4 %0, %1, %2, 0" : "=&v"(p1) : "v"(a1), "v"(qf8[0]));
  a0 = ld32(Ks + kb + 128); a1 = ld32(Ks + kb + 128 + 32 * KP);
  asm volatile("v_mfma_f32_32x32x64_f8f6f4 %0, %1, %2, %0" : "+v"(p0) : "v"(c0), "v"(qf8[1]));
  asm volatile("v_mfma_f32_32x32x64_f8f6f4 %0, %1, %2, %0" : "+v"(p1) : "v"(c1), "v"(qf8[1]));
  asm volatile("v_mfma_f32_32x32x64_f8f6f4 %0, %1, %2, %0" : "+v"(p0) : "v"(a0), "v"(qf8[2]));
  asm volatile("v_mfma_f32_32x32x64_f8f6f4 %0, %1, %2, %0" : "+v"(p1) : "v"(a1), "v"(qf8[2]));
  asm volatile("s_nop 15\n\ts_nop 7" : "+v"(p0), "+v"(p1));
}

__device__ __forceinline__ void qkt(f32x16& p0, f32x16& p1, const char* Ks, int kb, const v8i (&qf8)[3]) {
  qkt1(p0, p1, Ks, kb, qf8);
#if ATT_PROBE == 1
  asm volatile("" : "+v"(kb)); qkt1(p0, p1, Ks, kb, qf8);
#endif
}
__device__ __forceinline__ u32x2 bf8_to_f8(bf16x8 v) { u32x2 o; o.x = pk4f8(bf2f((unsigned short)v[0]), bf2f((unsigned short)v[1]), bf2f((unsigned short)v[2]), bf2f((unsigned short)v[3]));
  o.y = pk4f8(bf2f((unsigned short)v[4]), bf2f((unsigned short)v[5]), bf2f((unsigned short)v[6]), bf2f((unsigned short)v[7])); return o; }
__device__ __forceinline__ int v_st(int k, int c) { const int kk = (k & ~0xC) | ((k & 4) << 1) | ((k & 8) >> 1); return ((kk >> 3) * 4 + (c >> 5)) * 512 + ((kk & 7) * 32 + (c & 31)) * 2; }
__device__ __forceinline__ int v_rd_base(int lane) { return ((lane & 3) << 3) | (((lane >> 2) & 3) << 6) | (((lane >> 4) & 1) << 5) | (((lane >> 5) & 1) << 8); }
constexpr int v_rd_off(int d0, int ks, int half) { return d0 * 512 + ks * 4096 + half * 2048; }
template <int OFF> __device__ __forceinline__ s16x4 tr_read(int vb) {
  s16x4 r; asm volatile("ds_read_b64_tr_b16 %0, %1 offset:%2" : "=&v"(r) : "v"(vb), "i"(OFF) : "memory"); return r;
}
__device__ __forceinline__ void pv_d0(f32x16* o, const char* Vs, int vrd, v8i p8) {
  asm volatile("s_nop 1" : "+v"(p8));
  const v8i v0 = ld32(Vs + vrd), v1 = ld32(Vs + vrd + 32 * VP), v2 = ld32(Vs + vrd + 64 * VP), v3 = ld32(Vs + vrd + 96 * VP);
  asm volatile("v_mfma_f32_32x32x64_f8f6f4 %0, %1, %2, %0" : "+v"(o[0]) : "v"(p8), "v"(v0));
  asm volatile("v_mfma_f32_32x32x64_f8f6f4 %0, %1, %2, %0" : "+v"(o[1]) : "v"(p8), "v"(v1));
  asm volatile("v_mfma_f32_32x32x64_f8f6f4 %0, %1, %2, %0" : "+v"(o[2]) : "v"(p8), "v"(v2));
  asm volatile("v_mfma_f32_32x32x64_f8f6f4 %0, %1, %2, %0" : "+v"(o[3]) : "v"(p8), "v"(v3));
}

#define MF8(ACC, A, B) asm volatile("v_mfma_f32_32x32x64_f8f6f4 %0, %1, %2, %0" : "+v"(ACC) : "v"(A), "v"(B))
#define MF8Z(ACC, A, B) asm volatile("v_mfma_f32_32x32x64_f8f6f4 %0, %1, %2, 0" : "=&v"(ACC) : "v"(A), "v"(B))
__device__ __forceinline__ void qkt_fin(f32x16& n0, f32x16& n1, const char* Ks, int kb, const v8i (&qf8)[3], f32x16& p0, f32x16& p1, float alpha, float& l_reg, v8i& p8) {
  v8i a0 = ld32(Ks + kb), a1 = ld32(Ks + kb + 32 * KP); const v8i c0 = ld32(Ks + kb + 64), c1 = ld32(Ks + kb + 64 + 32 * KP);
  float ps = 0.f, pt = 0.f;
  MF8Z(n0, a0, qf8[0]); SBAR();
#pragma unroll
  for (int r = 0; r < 4; ++r) p1[r] = __builtin_amdgcn_exp2f(p1[r]);
  ps += p0[0]; pt += p0[1]; ps += p0[2]; pt += p0[3]; ps += p0[4]; pt += p0[5]; SBAR();
  MF8Z(n1, a1, qf8[0]); SBAR();
  a0 = ld32(Ks + kb + 128); a1 = ld32(Ks + kb + 128 + 32 * KP);
#pragma unroll
  for (int r = 4; r < 8; ++r) p1[r] = __builtin_amdgcn_exp2f(p1[r]);
  ps += p0[6]; pt += p0[7]; ps += p0[8]; pt += p0[9]; ps += p0[10]; pt += p0[11]; SBAR();
  MF8(n0, c0, qf8[1]); SBAR();
#pragma unroll
  for (int r = 8; r < 12; ++r) p1[r] = __builtin_amdgcn_exp2f(p1[r]);
  ps += p0[12]; pt += p0[13]; ps += p0[14]; pt += p0[15]; ps += p1[0]; pt += p1[1]; SBAR();
  MF8(n1, c1, qf8[1]); SBAR();
#pragma unroll
  for (int r = 12; r < 16; ++r) p1[r] = __builtin_amdgcn_exp2f(p1[r]);
  ps += p1[2]; pt += p1[3]; ps += p1[4]; pt += p1[5]; ps += p1[6]; pt += p1[7]; SBAR();
  MF8(n0, a0, qf8[2]); SBAR();
  ps += p1[8]; pt += p1[9]; ps += p1[10]; pt += p1[11]; ps += p1[12]; pt += p1[13]; ps += p1[14]; pt += p1[15];
  p8[0] = (int)pk4f8(p0[0], p0[1], p0[2], p0[3]); p8[1] = (int)pk4f8(p0[4], p0[5], p0[6], p0[7]); p8[2] = (int)pk4f8(p0[8], p0[9], p0[10], p0[11]); SBAR();
  MF8(n1, a1, qf8[2]); SBAR();
  p8[3] = (int)pk4f8(p0[12], p0[13], p0[14], p0[15]);
#pragma unroll
  for (int w = 0; w < 4; ++w) p8[4 + w] = (int)pk4f8(p1[4 * w], p1[4 * w + 1], p1[4 * w + 2], p1[4 * w + 3]);
  ps += pt;
  { auto rr = __builtin_amdgcn_permlane32_swap(__float_as_uint(ps), __float_as_uint(ps), false, false); ps = __uint_as_float(rr[0]) + __uint_as_float(rr[1]); }
  l_reg = l_reg * alpha + ps;
  asm volatile("s_nop 15\n\ts_nop 7" : "+v"(n0), "+v"(n1));
}
__device__ __forceinline__ void pv_part(f32x16* o, const char* Vs, int vrd, v8i p8, f32x16& p0, f32x16& p1, float& m_reg, float& alpha) {
  constexpr float C = SCALE * 1.4426950408889634f;
  asm volatile("s_nop 1" : "+v"(p8));
  const v8i v0 = ld32(Vs + vrd), v1 = ld32(Vs + vrd + 32 * VP), v2 = ld32(Vs + vrd + 64 * VP), v3 = ld32(Vs + vrd + 96 * VP);
  MF8(o[0], p8, v0); SBAR();
  float pmax = fmaxf(fmaxf(p0[0], p0[1]), p0[2]);
#pragma unroll
  for (int r = 3; r < 15; r += 2) pmax = fmaxf(fmaxf(pmax, p0[r]), p0[r + 1]);
  pmax = fmaxf(fmaxf(pmax, p0[15]), p1[0]);
#pragma unroll
  for (int r = 1; r < 7; r += 2) pmax = fmaxf(fmaxf(pmax, p1[r]), p1[r + 1]);
  SBAR();
  MF8(o[1], p8, v1); SBAR();
#pragma unroll
  for (int r = 7; r < 15; r += 2) pmax = fmaxf(fmaxf(pmax, p1[r]), p1[r + 1]);
  pmax = fmaxf(pmax, p1[15]);
  { auto rr = __builtin_amdgcn_permlane32_swap(__float_as_uint(pmax), __float_as_uint(pmax), false, false); pmax = fmaxf(__uint_as_float(rr[0]), __uint_as_float(rr[1])); }
  const bool keep = __all(pmax - m_reg <= THR / SCALE);
  const float mn = keep ? m_reg : fmaxf(m_reg, pmax);
  alpha = __builtin_amdgcn_exp2f((m_reg - mn) * C); m_reg = mn;
  const float mnC = PSH - mn * C;
  SBAR();
  MF8(o[2], p8, v2); SBAR();
#pragma unroll
  for (int r = 0; r < 14; ++r) p0[r] = fmaf(p0[r], C, mnC);
  SBAR();
  MF8(o[3], p8, v3); SBAR();
  p0[14] = fmaf(p0[14], C, mnC); p0[15] = fmaf(p0[15], C, mnC);
#pragma unroll
  for (int r = 0; r < 16; ++r) p1[r] = fmaf(p1[r], C, mnC);
#pragma unroll
  for (int r = 0; r < 16; ++r) p0[r] = __builtin_amdgcn_exp2f(p0[r]);
}

#define MF8C(ACC, A, B, C_) asm volatile("v_mfma_f32_32x32x64_f8f6f4 %0, %1, %2, %3" : "=&v"(ACC) : "v"(A), "v"(B), "v"(C_))
constexpr float THR2 = THR * 1.4426950408889634f;
__device__ __forceinline__ void qkt_fin_b(f32x16& n0, f32x16& n1, const char* Ks, int kb, const v8i (&qf8)[3], const f32x16& mb, f32x16& p0, f32x16& p1, float alpha, float& l_reg, v8i& p8,
                                          v8i& f0, v8i& f1, v8i& f2, const char* Vs, int vrd) {
#pragma unroll
  for (int r = 8; r < 16; ++r) p0[r] = __builtin_amdgcn_exp2f(p0[r]);
  float ps = 0.f, pt = 0.f;
  MF8C(n0, f0, qf8[0], mb); SBAR();
  f0 = ld32(Ks + kb + 64 + 32 * KP);
#pragma unroll
  for (int r = 0; r < 4; ++r) p1[r] = __builtin_amdgcn_exp2f(p1[r]);
  ps += p0[0]; pt += p0[1]; ps += p0[2]; pt += p0[3]; ps += p0[4]; pt += p0[5]; SBAR();
  MF8C(n1, f1, qf8[0], mb); SBAR();
  f1 = ld32(Ks + kb + 128);
#pragma unroll
  for (int r = 4; r < 8; ++r) p1[r] = __builtin_amdgcn_exp2f(p1[r]);
  ps += p0[6]; pt += p0[7]; ps += p0[8]; pt += p0[9]; ps += p0[10]; pt += p0[11]; SBAR();
  MF8(n0, f2, qf8[1]); SBAR();
  f2 = ld32(Ks + kb + 128 + 32 * KP);
#pragma unroll
  for (int r = 8; r < 12; ++r) p1[r] = __builtin_amdgcn_exp2f(p1[r]);
  ps += p0[12]; pt += p0[13]; ps += p0[14]; pt += p0[15]; ps += p1[0]; pt += p1[1]; SBAR();
  MF8(n1, f0, qf8[1]); SBAR();
#pragma unroll
  for (int r = 12; r < 16; ++r) p1[r] = __builtin_amdgcn_exp2f(p1[r]);
  ps += p1[2]; pt += p1[3]; ps += p1[4]; pt += p1[5]; ps += p1[6]; pt += p1[7]; SBAR();
  MF8(n0, f1, qf8[2]); SBAR();
  ps += p1[8]; pt += p1[9]; ps += p1[10]; pt += p1[11]; ps += p1[12]; pt += p1[13]; ps += p1[14]; pt += p1[15];
  p8[0] = (int)pk4f8o(p0[0], p0[1], p0[2], p0[3], p8[0]); p8[1] = (int)pk4f8o(p0[4], p0[5], p0[6], p0[7], p8[1]); p8[2] = (int)pk4f8o(p0[8], p0[9], p0[10], p0[11], p8[2]); SBAR();
  MF8(n1, f2, qf8[2]); SBAR();
  f0 = ld32(Vs + vrd); f1 = ld32(Vs + vrd + 32 * VP); f2 = ld32(Vs + vrd + 64 * VP);
  p8[3] = (int)pk4f8o(p0[12], p0[13], p0[14], p0[15], p8[3]);
#pragma unroll
  for (int w = 0; w < 4; ++w) p8[4 + w] = (int)pk4f8o(p1[4 * w], p1[4 * w + 1], p1[4 * w + 2], p1[4 * w + 3], p8[4 + w]);
  ps += pt;
  { auto rr = __builtin_amdgcn_permlane32_swap(__float_as_uint(ps), __float_as_uint(ps), false, false); ps = __uint_as_float(rr[0]) + __uint_as_float(rr[1]); }
  l_reg = l_reg * alpha + ps;
  asm volatile("s_nop 15\n\ts_nop 7" : "+v"(n0), "+v"(n1));
}
__device__ __forceinline__ void pv_part_b(f32x16* o, const char* Vs, int vrd, v8i p8, f32x16& p0, f32x16& p1, f32x16& mb, float& alpha, v8i v0, const v8i v1, const v8i v2) {
  asm volatile("s_nop 1" : "+v"(p8));
  MF8(o[0], p8, v0); SBAR();
  v0 = ld32(Vs + vrd + 96 * VP);
  float pmax = fmaxf(fmaxf(p0[0], p0[1]), p0[2]);
#pragma unroll
  for (int r = 3; r < 15; r += 2) pmax = fmaxf(fmaxf(pmax, p0[r]), p0[r + 1]);
  pmax = fmaxf(fmaxf(pmax, p0[15]), p1[0]);
#pragma unroll
  for (int r = 1; r < 7; r += 2) pmax = fmaxf(fmaxf(pmax, p1[r]), p1[r + 1]);
  SBAR();
  MF8(o[1], p8, v1); SBAR();
#pragma unroll
  for (int r = 7; r < 15; r += 2) pmax = fmaxf(fmaxf(pmax, p1[r]), p1[r + 1]);
  pmax = fmaxf(pmax, p1[15]);
  { auto rr = __builtin_amdgcn_permlane32_swap(__float_as_uint(pmax), __float_as_uint(pmax), false, false); pmax = fmaxf(__uint_as_float(rr[0]), __uint_as_float(rr[1])); }
  const bool keep = __all(pmax <= PSH + THR2);
  SBAR();
  MF8(o[2], p8, v2); SBAR();
  alpha = 1.f;
  if (__builtin_expect(!keep, 0)) {
    const float d = fmaxf(pmax - PSH, 0.f); alpha = __builtin_amdgcn_exp2f(-d);
#pragma unroll
    for (int r = 0; r < 16; ++r) { mb[r] -= d; p0[r] -= d; p1[r] -= d; } }
#pragma unroll
  for (int r = 0; r < 8; ++r) p0[r] = __builtin_amdgcn_exp2f(p0[r]);
  SBAR();
  MF8(o[3], p8, v0); SBAR();
}

constexpr float PLIM = 440.f;
__device__ __forceinline__ void qkt_fin_c(f32x16& n0, f32x16& n1, const char* Ks, int kb, const v8i (&qf8)[3], f32x16& mb, f32x16& p0, f32x16& p1, float& l_reg, v8i& p8,
                                          v8i& f0, v8i& f1, v8i& f2, const char* Vs, int vrd, float& alpha_out) {
  float ps = 0.f, pt = 0.f;
  MF8C(n0, f0, qf8[0], mb); SBAR();
  f0 = ld32(Ks + kb + 64 + 32 * KP);
#pragma unroll
  for (int r = 0; r < 4; ++r) p1[r] = __builtin_amdgcn_exp2f(p1[r]);
  ps += p0[0]; pt += p0[1]; ps += p0[2]; pt += p0[3]; ps += p0[4]; pt += p0[5]; SBAR();
  MF8C(n1, f1, qf8[0], mb); SBAR();
  f1 = ld32(Ks + kb + 128);
#pragma unroll
  for (int r = 4; r < 8; ++r) p1[r] = __builtin_amdgcn_exp2f(p1[r]);
  ps += p0[6]; pt += p0[7]; ps += p0[8]; pt += p0[9]; ps += p0[10]; pt += p0[11]; SBAR();
  MF8(n0, f2, qf8[1]); SBAR();
  f2 = ld32(Ks + kb + 128 + 32 * KP);
#pragma unroll
  for (int r = 8; r < 12; ++r) p1[r] = __builtin_amdgcn_exp2f(p1[r]);
  ps += p0[12]; pt += p0[13]; ps += p0[14]; pt += p0[15]; ps += p1[0]; pt += p1[1]; SBAR();
  MF8(n1, f0, qf8[1]); SBAR();
#pragma unroll
  for (int r = 12; r < 16; ++r) p1[r] = __builtin_amdgcn_exp2f(p1[r]);
  ps += p1[2]; pt += p1[3]; ps += p1[4]; pt += p1[5]; ps += p1[6]; pt += p1[7]; SBAR();
  MF8(n0, f1, qf8[2]); SBAR();
  ps += p1[8]; pt += p1[9]; ps += p1[10]; pt += p1[11]; ps += p1[12]; pt += p1[13]; ps += p1[14]; pt += p1[15];
  ps += pt;
  { auto rr = __builtin_amdgcn_permlane32_swap(__float_as_uint(ps), __float_as_uint(ps), false, false); ps = __uint_as_float(rr[0]) + __uint_as_float(rr[1]); }
  SBAR();
  MF8(n1, f2, qf8[2]); SBAR();
  f0 = ld32(Vs + vrd); f1 = ld32(Vs + vrd + 32 * VP); f2 = ld32(Vs + vrd + 64 * VP);
  alpha_out = 1.f;
  if (__builtin_expect(!__all(ps <= PLIM), 0)) {
    asm volatile("s_nop 15\n\ts_nop 7" : "+v"(n0), "+v"(n1));
    float pm = fmaxf(fmaxf(p0[0], p0[1]), p0[2]);
#pragma unroll
    for (int r = 3; r < 15; r += 2) pm = fmaxf(fmaxf(pm, p0[r]), p0[r + 1]);
    pm = fmaxf(fmaxf(pm, p0[15]), p1[0]);
#pragma unroll
    for (int r = 1; r < 15; r += 2) pm = fmaxf(fmaxf(pm, p1[r]), p1[r + 1]);
    pm = fmaxf(pm, p1[15]);
    { auto rr = __builtin_amdgcn_permlane32_swap(__float_as_uint(pm), __float_as_uint(pm), false, false); pm = fmaxf(__uint_as_float(rr[0]), __uint_as_float(rr[1])); }
    const float d = fmaxf(__log2f(pm) - PSH, 0.f), sc = __builtin_amdgcn_exp2f(-d);
    alpha_out = sc; ps *= sc;
#pragma unroll
    for (int r = 0; r < 16; ++r) { p0[r] *= sc; p1[r] *= sc; mb[r] -= d; n0[r] -= d; n1[r] -= d; } }
  l_reg = l_reg * alpha_out + ps;
#pragma unroll
  for (int w = 0; w < 4; ++w) { p8[w] = (int)pk4f8o(p0[4 * w], p0[4 * w + 1], p0[4 * w + 2], p0[4 * w + 3], p8[w]); p8[4 + w] = (int)pk4f8o(p1[4 * w], p1[4 * w + 1], p1[4 * w + 2], p1[4 * w + 3], p8[4 + w]); }
  asm volatile("s_nop 15\n\ts_nop 7" : "+v"(n0), "+v"(n1));
}
__device__ __forceinline__ void pv_part_c(f32x16* o, const char* Vs, int vrd, v8i p8, f32x16& p0, v8i v0, const v8i v1, const v8i v2) {
  asm volatile("s_nop 1" : "+v"(p8), "+v"(o[0]), "+v"(o[1]), "+v"(o[2]), "+v"(o[3]));
  MF8(o[0], p8, v0); SBAR();
  v0 = ld32(Vs + vrd + 96 * VP);
#pragma unroll
  for (int r = 0; r < 4; ++r) p0[r] = __builtin_amdgcn_exp2f(p0[r]);
  SBAR();
  MF8(o[1], p8, v1); SBAR();
#pragma unroll
  for (int r = 4; r < 8; ++r) p0[r] = __builtin_amdgcn_exp2f(p0[r]);
  SBAR();
  MF8(o[2], p8, v2); SBAR();
#pragma unroll
  for (int r = 8; r < 12; ++r) p0[r] = __builtin_amdgcn_exp2f(p0[r]);
  SBAR();
  MF8(o[3], p8, v0); SBAR();
#pragma unroll
  for (int r = 12; r < 16; ++r) p0[r] = __builtin_amdgcn_exp2f(p0[r]);
}

__device__ __forceinline__ void attn_unit(const bf16* __restrict__ Qb, const char* __restrict__ KVh,
                                          bf16* __restrict__ Ob, int seq, int rope_t0, const float* __restrict__ rope, char* lds, const int tid) {
  const int wid = tid >> 6, lane = tid & 63, r32 = lane & 31, hi = lane >> 5;
  char* V_lds = lds + OFF_V; char* K_lds = lds + OFF_K;
  const int kb = r32 * KP + hi * 32;
  float* wsf = (float*)(lds + OFF_W) + wid * 64; float* li_l = wsf; float* al_l = wsf + 32;
  float m_reg = -1e30f, l_reg = 0; f32x16 o[4] = {}; bf16x8 qr[12];
  int qoff = (wid * QBLK + r32) * 192 + hi * 8; asm volatile("" : "+v"(qoff));
  const bf16* Qw = Qb + qoff;
#pragma unroll
  for (int d0 = 0; d0 < 12; ++d0) qr[d0] = *reinterpret_cast<const bf16x8*>(Qw + d0 * 16);
  if (rope_t0 >= 0) {
    const int t = rope_t0 + wid * QBLK + r32; const float* ta = rope + (t >> 6) * 32 + hi * 8; const float* tb = rope + (t & 63) * 32 + hi * 8;
#pragma unroll
    for (int e = 0; e < 8; ++e) {
      { const float x1 = bf2f((unsigned short)qr[8][e]), x2 = bf2f((unsigned short)qr[10][e]), c = ta[e], s = ta[16 + e];
        qr[8][e] = (short)f2bf(x1 * c - x2 * s); qr[10][e] = (short)f2bf(x2 * c + x1 * s); }
      { const float x1 = bf2f((unsigned short)qr[9][e]), x2 = bf2f((unsigned short)qr[11][e]), c = tb[e], s = tb[16 + e];
        qr[9][e] = (short)f2bf(x1 * c - x2 * s); qr[11][e] = (short)f2bf(x2 * c + x1 * s); }
    }
  }
  v8i qf8[3];
#pragma unroll
  for (int s = 0; s < 3; ++s)
#pragma unroll
    for (int a = 0; a < 4; ++a) { const bf16x8 v = qr[4 * s + a]; constexpr float QC = SCALE * 1.4426950408889634f;
      qf8[s][2 * a] = (int)pk4f8(bf2f((unsigned short)v[0]) * QC, bf2f((unsigned short)v[1]) * QC, bf2f((unsigned short)v[2]) * QC, bf2f((unsigned short)v[3]) * QC);
      qf8[s][2 * a + 1] = (int)pk4f8(bf2f((unsigned short)v[4]) * QC, bf2f((unsigned short)v[5]) * QC, bf2f((unsigned short)v[6]) * QC, bf2f((unsigned short)v[7]) * QC); }
  int l16 = lane * 16; asm volatile("" : "+v"(l16));
  const int widu = __builtin_amdgcn_readfirstlane(wid);
  const int vrd = r32 * VP + hi * 32;
#define SDMA(k0, b) do { asm volatile("" : "+v"(l16));   const char* kt_ = KVh + (long)((k0) >> 6) * SLOT; \
    _Pragma("unroll") for (int i_ = 0; i_ < 3; ++i_) { const int c_ = widu + 8 * i_; \
      if (c_ < 23) __builtin_amdgcn_global_load_lds((const unsigned*)(kt_ + c_ * 1024 + l16), (LAS unsigned*)(lds + (b) * SLOT + c_ * 1024), 16, 0, 0); } } while (0)
#define RESC(a) do { if (__any((a) < 1.f)) { if (hi == 0) al_l[r32] = (a); asm volatile("s_waitcnt lgkmcnt(0)" ::: "memory"); \
    _Pragma("unroll") for (int d = 0; d < 4; ++d) _Pragma("unroll") for (int r = 0; r < 16; ++r) o[d][r] *= al_l[crow(r, hi)]; asm volatile("s_nop 1" : "+v"(o[0]), "+v"(o[1]), "+v"(o[2]), "+v"(o[3])); } } while (0)
  f32x16 pA0, pA1, pB0, pB1, mb; float alA, alB; v8i p8 = {}; const int NTL = seq / KVBLK;
#define KLOAD(Ks_) v8i f0 = ld32((Ks_) + kb), f1 = ld32((Ks_) + kb + 32 * KP), f2 = ld32((Ks_) + kb + 64)
  __syncthreads();
  SDMA(0, 0); SDMA(KVBLK, 1); asm volatile("s_waitcnt vmcnt(0)" ::: "memory"); __syncthreads();
  qkt(pA0, pA1, K_lds, kb, qf8);
  { float pmax = pA0[0];
#pragma unroll
    for (int r = 1; r < 16; ++r) pmax = fmaxf(pmax, pA0[r]);
#pragma unroll
    for (int r = 0; r < 16; ++r) pmax = fmaxf(pmax, pA1[r]);
    { auto rr = __builtin_amdgcn_permlane32_swap(__float_as_uint(pmax), __float_as_uint(pmax), false, false); pmax = fmaxf(__uint_as_float(rr[0]), __uint_as_float(rr[1])); }
    const float b0_ = PSH - pmax; alA = 1.f;
#pragma unroll
    for (int r = 0; r < 16; ++r) { mb[r] = b0_; pA0[r] = __builtin_amdgcn_exp2f(pA0[r] + b0_); pA1[r] += b0_; } }
  int bj = 1;
  if (wid >= 4) __builtin_amdgcn_s_setprio(1);
  for (int j = 1; j + 1 < NTL; j += 2) {
    const int b0 = bj == 0 ? 2 : bj - 1, b1 = bj, b2 = bj == 2 ? 0 : bj + 1;
    { KLOAD(K_lds + b1 * SLOT); SDMA((j + 1) * KVBLK, b2);
      SBAR(); qkt_fin_c(pB0, pB1, K_lds + b1 * SLOT, kb, qf8, mb, pA0, pA1, l_reg, p8, f0, f1, f2, V_lds + b0 * SLOT, vrd, alA); SBAR();
      RESC(alA);
      pv_part_c(o, V_lds + b0 * SLOT, vrd, p8, pB0, f0, f1, f2); SBAR(); }
    asm volatile("s_waitcnt vmcnt(0)" ::: "memory"); __syncthreads();
    { KLOAD(K_lds + b2 * SLOT); if (j + 2 < NTL) SDMA((j + 2) * KVBLK, b0);
      SBAR(); qkt_fin_c(pA0, pA1, K_lds + b2 * SLOT, kb, qf8, mb, pB0, pB1, l_reg, p8, f0, f1, f2, V_lds + b1 * SLOT, vrd, alB); SBAR();
      RESC(alB);
      pv_part_c(o, V_lds + b1 * SLOT, vrd, p8, pA0, f0, f1, f2); SBAR(); }
    asm volatile("s_waitcnt vmcnt(0)" ::: "memory"); __syncthreads();
    bj = bj == 0 ? 2 : bj - 1;
  }
  { const int b0 = bj == 0 ? 2 : bj - 1, b1 = bj;
    { KLOAD(K_lds + b1 * SLOT);
      SBAR(); qkt_fin_c(pB0, pB1, K_lds + b1 * SLOT, kb, qf8, mb, pA0, pA1, l_reg, p8, f0, f1, f2, V_lds + b0 * SLOT, vrd, alA); SBAR();
      RESC(alA);
      pv_part_b(o, V_lds + b0 * SLOT, vrd, p8, pB0, pB1, mb, alB, f0, f1, f2); SBAR(); }
    RESC(alB);
#pragma unroll
    for (int r = 8; r < 16; ++r) pB0[r] = __builtin_amdgcn_exp2f(pB0[r]);
    finishSM(pB0, pB1, alB, l_reg, p8); SBAR();
    pv_d0(o, V_lds + b1 * SLOT, vrd, p8); }
  asm volatile("s_nop 15\n\ts_nop 7" : "+v"(o[0]), "+v"(o[1]), "+v"(o[2]), "+v"(o[3]));
  __builtin_amdgcn_s_setprio(0);
  if (hi == 0) li_l[r32] = l_reg; asm volatile("s_waitcnt lgkmcnt(0)" ::: "memory");
  float rli[16];
#pragma unroll
  for (int r = 0; r < 16; ++r) rli[r] = __builtin_amdgcn_rcpf(li_l[crow(r, hi)]);
  bf16* Ow = Ob + (long)(wid * QBLK) * 1024;
#pragma unroll
  for (int r = 0; r < 16; ++r) { const int orow = crow(r, hi);
#pragma unroll
    for (int d0 = 0; d0 < 4; ++d0) Ow[(long)orow * 1024 + d0 * 32 + r32] = (bf16)f2bf(o[d0][r] * rli[r]); }
#undef SDMA
#undef KLOAD
#undef RESC
}
}

struct Args { const float* in[N_IN]; float* out; unsigned char* ws; int ph_lo, ph_hi; };
struct Frame {
    LAS unsigned char* lds; int tid, lane, wave, G, gw, NGW;
    const float* const* in; float* out; unsigned char* ws;
};
__device__ __forceinline__ void row_decode(int row, int& b, int& j) { b = row >= NT ? 1 : 0; j = row - b * NT; }
__device__ __forceinline__ bf16* res_row(const Frame& F, int row) { return (bf16*)(F.ws + WS_RES) + (size_t)row * DM; }
__device__ __forceinline__ float* out_row(const Frame& F, int row) { int b, j; row_decode(row, b, j); return F.out + (size_t)(b * SEQ + (j - CTXL)) * DM; }
__device__ __forceinline__ const float* in_row(const Frame& F, int row) { int b, j; row_decode(row, b, j);
    return j < CTXL ? F.in[I_CTX] + (size_t)(b * CTXL + j) * DM : F.in[I_X] + (size_t)(b * SEQ + (j - CTXL)) * DM; }
__device__ __forceinline__ const float* mod_vec(const Frame& F, int layer, int row, int chunk) { int b, j; row_decode(row, b, j);
    const int who = j < CTXL ? 2 : b; return (const float*)(F.ws + WS_MOD) + (size_t)(layer * 3 + who) * 6144 + chunk * 1024; }

template <class Src, class Dst>
__device__ __forceinline__ void transpose_items(const Frame& F, int Ktot, int Ntot, bf16* WT, Src src, Dst dstrow) {
    LAS float* scr = (LAS float*)(F.lds + F.wave * 16384);
    const int nblk = Ntot / 32, nitems = (Ktot / 64) * nblk, lane = F.lane;
    for (int it = F.gw; it < nitems; it += F.NGW) {
        const int kb = it / nblk, nb = it - kb * nblk, k0 = 64 * kb, n0 = 32 * nb;
        float tv[32];
#pragma unroll
        for (int i = 0; i < 32; ++i) tv[i] = src(k0 + 2 * i + (lane >> 5), n0 + (lane & 31));
#pragma unroll
        for (int i = 0; i < 32; ++i) { const int kk = 2 * i + (lane >> 5); scr[kk * 33 + (lane & 31)] = tv[i]; }
        LDS_WAIT(); asm volatile("" ::: "memory");
        const int c = lane & 7;
#pragma unroll
        for (int j = 0; j < 4; ++j) { const int n = (lane >> 3) + 8 * j; const LAS float* s = scr + (8 * c) * 33 + n;
            u32x4 o; o.x = pk2(s[0 * 33], s[1 * 33]); o.y = pk2(s[2 * 33], s[3 * 33]); o.z = pk2(s[4 * 33], s[5 * 33]); o.w = pk2(s[6 * 33], s[7 * 33]);
            *(u32x4*)(WT + (size_t)dstrow(n0 + n) * Ktot + k0 + 8 * c) = o; }
        LDS_WAIT(); asm volatile("" ::: "memory");
    }
}
__device__ __forceinline__ unsigned pk4_fp8(float a, float b, float c, float d) { int w = __builtin_amdgcn_cvt_pk_fp8_f32(a, b, 0, false); w = __builtin_amdgcn_cvt_pk_fp8_f32(c, d, w, true); return (unsigned)w; }
template <class Src, class Dst>
__device__ __forceinline__ void transpose_items_f8(const Frame& F, int Ktot, int Ntot, unsigned char* WT, Src src, Dst dstrow, float wscale) {
    LAS float* scr = (LAS float*)(F.lds + F.wave * 16384);
    const int nblk = Ntot / 32, nitems = (Ktot / 64) * nblk, lane = F.lane;
    for (int it = F.gw; it < nitems; it += F.NGW) {
        const int kb = it / nblk, nb = it - kb * nblk, k0 = 64 * kb, n0 = 32 * nb;
        float tv[32];
#pragma unroll
        for (int i = 0; i < 32; ++i) tv[i] = src(k0 + 2 * i + (lane >> 5), n0 + (lane & 31));
#pragma unroll
        for (int i = 0; i < 32; ++i) { const int kk = 2 * i + (lane >> 5); scr[kk * 33 + (lane & 31)] = tv[i] * wscale; }
        LDS_WAIT(); asm volatile("" ::: "memory");
        const int c = lane & 3;
#pragma unroll
        for (int j = 0; j < 2; ++j) { const int n = (lane >> 2) + 16 * j; const LAS float* s = scr + (16 * c) * 33 + n;
            u32x4 o; o.x = pk4_fp8(s[0 * 33], s[1 * 33], s[2 * 33], s[3 * 33]); o.y = pk4_fp8(s[4 * 33], s[5 * 33], s[6 * 33], s[7 * 33]);
            o.z = pk4_fp8(s[8 * 33], s[9 * 33], s[10 * 33], s[11 * 33]); o.w = pk4_fp8(s[12 * 33], s[13 * 33], s[14 * 33], s[15 * 33]);
            *(u32x4*)(WT + (size_t)dstrow(n0 + n) * Ktot + k0 + 16 * c) = o; }
        LDS_WAIT(); asm volatile("" ::: "memory");
    }
}
__device__ __forceinline__ unsigned pk4_i8(float a, float b, float c, float d) {
    const int q0 = __float2int_rn(a), q1 = __float2int_rn(b), q2 = __float2int_rn(c), q3 = __float2int_rn(d);
    return (unsigned)(q0 & 255) | ((unsigned)(q1 & 255) << 8) | ((unsigned)(q2 & 255) << 16) | ((unsigned)q3 << 24); }
template <class Src, class Dst>
__device__ __forceinline__ void transpose_items_i8(const Frame& F, int Ktot, int Ntot, unsigned char* WT, Src src, Dst dstrow, const float* cmaxp, float* colsc) {
    LAS float* scr = (LAS float*)(F.lds + F.wave * 16384);
    const int nblk = Ntot / 32, nitems = (Ktot / 64) * nblk, lane = F.lane;
    for (int it = F.gw; it < nitems; it += F.NGW) {
        const int kb = it / nblk, nb = it - kb * nblk, k0 = 64 * kb, n0 = 32 * nb;
        float tv[32];
#pragma unroll
        for (int i = 0; i < 32; ++i) tv[i] = src(k0 + 2 * i + (lane >> 5), n0 + (lane & 31));
        float am = 1e-30f;
#pragma unroll
        for (int c = 0; c < 16; ++c) am = fmaxf(am, cmaxp[c * 12800 + n0 + (lane & 31)]);
        const float qscale = 127.f / am;
        if (kb == 0 && lane < 32) colsc[dstrow(n0 + lane)] = am * (1.f / 127.f);
#pragma unroll
        for (int i = 0; i < 32; ++i) { const int kk = 2 * i + (lane >> 5); scr[kk * 33 + (lane & 31)] = tv[i] * qscale; }
        LDS_WAIT(); asm volatile("" ::: "memory");
        const int c = lane & 3;
#pragma unroll
        for (int j = 0; j < 2; ++j) { const int n = (lane >> 2) + 16 * j; const LAS float* s = scr + (16 * c) * 33 + n;
            u32x4 o; o.x = pk4_i8(s[0 * 33], s[1 * 33], s[2 * 33], s[3 * 33]); o.y = pk4_i8(s[4 * 33], s[5 * 33], s[6 * 33], s[7 * 33]);
            o.z = pk4_i8(s[8 * 33], s[9 * 33], s[10 * 33], s[11 * 33]); o.w = pk4_i8(s[12 * 33], s[13 * 33], s[14 * 33], s[15 * 33]);
            *(u32x4*)(WT + (size_t)dstrow(n0 + n) * Ktot + k0 + 16 * c) = o; }
        LDS_WAIT(); asm volatile("" ::: "memory");
    }
}
__device__ __forceinline__ float wave_max(float v) {
#pragma unroll
    for (int off = 32; off > 0; off >>= 1) v = fmaxf(v, __shfl_xor(v, off));
    return v; }
__device__ __forceinline__ void absmax_cols(const Frame& F, const float* W, int K, int N, float* cmaxp, int wave0) {
    const int nblk = (N + 255) / 256, nitems = nblk * (K / 64);
    for (int it = F.gw >= wave0 ? F.gw - wave0 : F.gw - wave0 + F.NGW; it < nitems; it += F.NGW) { const int nb = it % nblk, kc = it / nblk, n = nb * 256 + 4 * F.lane;
        if (n < N) { const float* p = W + (size_t)(kc * 64) * N + n; f32x4 m = {0.f, 0.f, 0.f, 0.f};
#pragma unroll 32
            for (int k = 0; k < 64; ++k) { const f32x4 v = *(const f32x4*)(p + (size_t)k * N); m.x = fmaxf(m.x, fabsf(v.x)); m.y = fmaxf(m.y, fabsf(v.y)); m.z = fmaxf(m.z, fabsf(v.z)); m.w = fmaxf(m.w, fabsf(v.w)); }
            *(f32x4*)(cmaxp + kc * 12800 + n) = m; } }
}
struct SrcPlain { const float* W; int N, Nvalid; __device__ __forceinline__ float operator()(int k, int n) const { return n < Nvalid ? W[(size_t)k * N + n] : 0.f; } };
struct SrcUp { const float* Wq; const float* Wkv;
    __device__ __forceinline__ float operator()(int k, int n) const { if (k < 256) return n < 768 ? Wq[(size_t)k * 768 + n] : 0.f; return n >= 768 ? Wkv[(size_t)(k - 256) * 1024 + (n - 768)] : 0.f; } };
struct DstPlain { __device__ __forceinline__ int operator()(int n) const { return n; } };
struct DstGU { __device__ __forceinline__ int operator()(int n) const { const int u = n >= DFF ? 1 : 0, m = n - u * DFF; return 8 * (m >> 2) + 4 * u + (m & 3); } };

__device__ __forceinline__ void p0_prologue(const Frame& F) {
    absmax_cols(F, F.in[I_WINAB], 1024, 2000, (float*)(F.ws + WS_CMAXP) + 10752, 1400);
    transpose_items(F, 384, 1792, (bf16*)(F.ws + WS_W_UP), SrcUp{F.in[I_WUQ], F.in[I_WUKV]}, DstPlain{});
    transpose_items(F, 1024, 1024, (bf16*)(F.ws + WS_W_OUTAB), SrcPlain{F.in[I_WOUTAB], 1024, 1024}, DstPlain{});
    absmax_cols(F, F.in[I_FFNGU], 1024, 2 * DFF, (float*)(F.ws + WS_CMAXP) + 0, 0);
    absmax_cols(F, F.in[I_WINC], 1024, 5120, (float*)(F.ws + WS_CMAXP) + 5632, 700);
    __syncthreads();
    LAS float* sil = (LAS float*)F.lds;
    LAS float* red = (LAS float*)(F.lds + 16384);
    for (int i = F.tid; i < 3 * 1024; i += NTHREADS) { const int who = i >> 10, k = i & 1023; const float c = who < 2 ? F.in[I_C][who * 1024 + k] : F.in[I_CCTX][k]; sil[i] = siluf(c); }
    __syncthreads();
    for (int it = blockIdx.x; it < 2 * 96; it += F.G) {
        const int l = it / 96, col = (it % 96) * 64 + F.lane; const float* W = F.in[I_WMOD] + (size_t)l * 1024 * 6144 + col;
        float a0 = 0.f, a1 = 0.f, a2 = 0.f; const int kb = F.wave * 128;
#pragma unroll 1
        for (int k0 = 0; k0 < 128; k0 += 32) { float wv[32];
#pragma unroll
            for (int k = 0; k < 32; ++k) wv[k] = W[(size_t)(kb + k0 + k) * 6144];
#pragma unroll
            for (int k = 0; k < 32; ++k) { a0 += sil[kb + k0 + k] * wv[k]; a1 += sil[1024 + kb + k0 + k] * wv[k]; a2 += sil[2048 + kb + k0 + k] * wv[k]; } }
        red[(F.wave * 3 + 0) * 64 + F.lane] = a0; red[(F.wave * 3 + 1) * 64 + F.lane] = a1; red[(F.wave * 3 + 2) * 64 + F.lane] = a2;
        __syncthreads();
        if (F.wave < 3) { float s = 0.f;
#pragma unroll
            for (int w = 0; w < 8; ++w) s += red[(w * 3 + F.wave) * 64 + F.lane];
            ((float*)(F.ws + WS_MOD))[(size_t)(l * 3 + F.wave) * 6144 + col] = s + F.in[I_BMOD][l * 6144 + col]; }
        __syncthreads();
    }
    if (blockIdx.x == F.G - 1) for (int i = F.tid; i < 1024; i += NTHREADS) { const float l0 = F.in[I_LBLOG][i], l1 = F.in[I_LBLOG][1024 + i]; ((float*)(F.ws + WS_LB))[i] = 1.f / (1.f + expf(l0 - l1)); }
    if (blockIdx.x == F.G - 2) for (int i = F.tid; i < 256 * 16; i += NTHREADS) { const int pos = i >> 4, f = i & 15; const float inv = powf(10000.f, -(float)f / 16.f), a = (float)pos * inv;
        ((float*)(F.ws + WS_ROPE))[pos * 32 + f] = cosf(a); ((float*)(F.ws + WS_ROPE))[pos * 32 + 16 + f] = sinf(a); }
}

__device__ __forceinline__ void load_row_f32(const float* p, int lane, f32x4 (&v)[4]) {
#pragma unroll
    for (int j = 0; j < 4; ++j) v[j] = *((const f32x4*)p + lane + 64 * j);
}
__device__ __forceinline__ void load_row_bf16(const bf16* p, int lane, f32x4 (&v)[4]) {
#pragma unroll
    for (int j = 0; j < 4; ++j) { const u32x2 w = *((const u32x2*)p + lane + 64 * j); v[j] = (f32x4){bf2f(w.x & 0xffffu), bf2f(w.x >> 16), bf2f(w.y & 0xffffu), bf2f(w.y >> 16)}; }
}
__device__ __forceinline__ void load_row_raw(const bf16* p, int lane, u32x2 (&w)[4]) {
#pragma unroll
    for (int j = 0; j < 4; ++j) w[j] = *((const u32x2*)p + lane + 64 * j);
}
__device__ __forceinline__ void cvt_row(const u32x2 (&w)[4], f32x4 (&v)[4]) {
#pragma unroll
    for (int j = 0; j < 4; ++j) v[j] = (f32x4){bf2f(w[j].x & 0xffffu), bf2f(w[j].x >> 16), bf2f(w[j].y & 0xffffu), bf2f(w[j].y >> 16)};
}
__device__ __forceinline__ void store_res(bf16* xr, int idx, const f32x4 v) { u32x2 w; w.x = pk2(v.x, v.y); w.y = pk2(v.z, v.w); *((u32x2*)xr + idx) = w; }
__device__ __forceinline__ float row_rstd(const f32x4 (&v)[4]) { float s = 0.f;
#pragma unroll
    for (int j = 0; j < 4; ++j) s += (v[j].x * v[j].x + v[j].y * v[j].y) + (v[j].z * v[j].z + v[j].w * v[j].w);
    return rsqrtf(wave_sum(s) * (1.f / DM) + RMS_EPS); }
__device__ __forceinline__ void norm_mod_store(const f32x4 (&v)[4], const float* gain, const float* sh, const float* sc, bf16* orow, int lane) {
    const float rstd = row_rstd(v);
#pragma unroll
    for (int j = 0; j < 4; ++j) { const int idx = lane + 64 * j; const f32x4 g = ((const f32x4*)gain)[idx], a = ((const f32x4*)sh)[idx], c = ((const f32x4*)sc)[idx];
        const f32x4 h = (v[j] * rstd * g) * (1.f + c) + a;
        u32x2 w; w.x = pk2(h.x, h.y); w.y = pk2(h.z, h.w); *((u32x2*)orow + idx) = w; }
}
__device__ __forceinline__ void load_vec(const float* p, int lane, f32x4 (&v)[4]) {
#pragma unroll
    for (int j = 0; j < 4; ++j) v[j] = ((const f32x4*)p)[lane + 64 * j];
}
__device__ __forceinline__ int row_who(int row) { int b, j; row_decode(row, b, j); return j < CTXL ? 2 : b; }
template <bool I8OUT = false>
__device__ __forceinline__ void norm_mod_store_r(const f32x4 (&v)[4], const f32x4 (&g)[4], const f32x4 (&sh)[4], const f32x4 (&sc)[4], bf16* orow, int lane, float* sa = nullptr) {
    const float rstd = row_rstd(v);
    if (I8OUT) {
        f32x4 h[4]; float am = 0.f;
#pragma unroll
        for (int j = 0; j < 4; ++j) { h[j] = (v[j] * rstd * g[j]) * (1.f + sc[j]) + sh[j]; am = fmaxf(fmaxf(am, fmaxf(fabsf(h[j].x), fabsf(h[j].y))), fmaxf(fabsf(h[j].z), fabsf(h[j].w))); }
        am = fmaxf(wave_max(am), 1e-20f); const float qs = 127.f / am;
#pragma unroll
        for (int j = 0; j < 4; ++j) *((unsigned*)orow + lane + 64 * j) = pk4_i8(h[j].x * qs, h[j].y * qs, h[j].z * qs, h[j].w * qs);
        if (lane == 0) *sa = am * (1.f / 127.f);
    } else {
#pragma unroll
    for (int j = 0; j < 4; ++j) { const f32x4 h = (v[j] * rstd * g[j]) * (1.f + sc[j]) + sh[j];
        u32x2 w; w.x = pk2(h.x, h.y); w.y = pk2(h.z, h.w); *((u32x2*)orow + lane + 64 * j) = w; }
    }
}
__device__ __forceinline__ void p1_norm0(const Frame& F) {
    const float* gain = F.in[I_GAINS] + 0;
    f32x4 v[4], vn[4], vg[4], vsh[4], vsc[4]; int cur = -1; load_vec(gain, F.lane, vg); int row = F.gw; if (row < NR) load_row_f32(in_row(F, row), F.lane, v);
    while (row < NR) { const int nrow = row + F.NGW; if (nrow < NR) load_row_f32(in_row(F, nrow), F.lane, vn);
        { const int who = row_who(row); if (who != cur) { cur = who; load_vec(mod_vec(F, 0, row, 0), F.lane, vsh); load_vec(mod_vec(F, 0, row, 1), F.lane, vsc); } }
        norm_mod_store_r<true>(v, vg, vsh, vsc, (bf16*)(F.ws + WS_H + (size_t)row * DM), F.lane, (float*)(F.ws + WS_SA) + row);
#pragma unroll
        for (int j = 0; j < 4; ++j) v[j] = vn[j];
        row = nrow; }
    __syncthreads(); transpose_items_i8(F, 1024, 2048, F.ws + WS_W_INAB, SrcPlain{F.in[I_WINAB], 2000, 2000}, DstPlain{}, (const float*)(F.ws + WS_CMAXP) + 10752, (float*)(F.ws + WS_CTL) + CW_COLSC + 10752); __syncthreads();
}
template <bool FIRST, bool I8OUT = false>
__device__ __forceinline__ void resnorm_rows(const Frame& F, const bf16* Y, int layer_a, int gate_chunk, const float* gain_a, int layer_b, int sh_chunk, const float* gain_b, bf16* H, int mode  , int gw, int ngw) {
    u32x2 yw[4], ywn[4], xw[4], xwn[4]; f32x4 x[4], xn[4], vga[4], vgb[4], vgt[4], vsh[4], vsc[4]; int cur = -1;
    load_vec(gain_a, F.lane, vga); load_vec(gain_b, F.lane, vgb);
    int row = gw;
#define RN_SKIP(r) do { if (mode) { while ((r) < NR) { int b_, j_; row_decode((r), b_, j_); if ((mode == 1) == (j_ >= CTXL)) break; (r) += ngw; } } } while (0)
    RN_SKIP(row);
    if (row < NR) { load_row_raw(Y + (size_t)row * DM, F.lane, yw); if (FIRST) load_row_f32(in_row(F, row), F.lane, x); else load_row_raw(res_row(F, row), F.lane, xw); }
    while (row < NR) {
        int nrow = row + ngw;
        RN_SKIP(nrow);
        if (nrow < NR) { load_row_raw(Y + (size_t)nrow * DM, F.lane, ywn); if (FIRST) load_row_f32(in_row(F, nrow), F.lane, xn); else load_row_raw(res_row(F, nrow), F.lane, xwn); }
        f32x4 y[4]; cvt_row(yw, y); if (!FIRST) cvt_row(xw, x); bf16* xr = res_row(F, row);
        { const int who = row_who(row); if (who != cur) { cur = who; load_vec(mod_vec(F, layer_a, row, gate_chunk), F.lane, vgt); load_vec(mod_vec(F, layer_b, row, sh_chunk), F.lane, vsh); load_vec(mod_vec(F, layer_b, row, sh_chunk + 1), F.lane, vsc); } }
        const float rstd = row_rstd(y);
#pragma unroll
        for (int q = 0; q < 4; ++q) { const int idx = F.lane + 64 * q; x[q] = x[q] + vgt[q] * (y[q] * rstd * vga[q]); store_res(xr, idx, x[q]); }
        norm_mod_store_r<I8OUT>(x, vgb, vsh, vsc, I8OUT ? (bf16*)((unsigned char*)H + (size_t)row * DM) : H + (size_t)row * DM, F.lane, (float*)(F.ws + WS_SA) + row);
#pragma unroll
        for (int q = 0; q < 4; ++q) { yw[q] = ywn[q]; if (FIRST) x[q] = xn[q]; else xw[q] = xwn[q]; }
        row = nrow;
    }
#undef RN_SKIP
}
__device__ __forceinline__ void p3_prep(const Frame& F) {
    const bf16* P = (const bf16*)(F.ws + WS_P); bf16* A2 = (bf16*)(F.ws + WS_A2); bf16* KR = (bf16*)(F.ws + WS_KR); bf16* QKP = (bf16*)(F.ws + WS_QKP); float* GT = (float*)(F.ws + WS_GATES);
    const float* rope = (const float*)(F.ws + WS_ROPE); const int lane = F.lane;
    for (int row = F.gw; row < NR; row += F.NGW) {
        int b, j; row_decode(row, b, j); const bf16* pr = P + (size_t)row * P_LD;
        {
            const u32x2 w = *((const u32x2*)pr + lane); const f32x4 v = (f32x4){bf2f(w.x & 0xffffu), bf2f(w.x >> 16), bf2f(w.y & 0xffffu), bf2f(w.y >> 16)};
            const float rstd = rsqrtf(wave_sum(v.x * v.x + v.y * v.y + v.z * v.z + v.w * v.w) * (1.f / 256.f) + RMS_EPS); const f32x4 g = ((const f32x4*)F.in[I_QGAIN])[lane]; const f32x4 h = v * rstd * g;
            u32x2 o; o.x = pk2(h.x, h.y); o.y = pk2(h.z, h.w); *((u32x2*)(A2 + (size_t)row * 384) + lane) = o; }
        {
            const unsigned w = *((const unsigned*)(pr + 256) + lane); const float v0 = bf2f(w & 0xffffu), v1 = bf2f(w >> 16);
            const float rstd = rsqrtf(wave_sum(v0 * v0 + v1 * v1) * (1.f / 128.f) + RMS_EPS); const float g0 = F.in[I_KVGAIN][2 * lane], g1 = F.in[I_KVGAIN][2 * lane + 1];
            *((unsigned*)(A2 + (size_t)row * 384 + 256) + lane) = pk2(v0 * rstd * g0, v1 * rstd * g1); }
        {
            if (lane < 32) { float x1 = bf2f(pr[384 + lane]), x2 = bf2f(pr[384 + 32 + lane]);
                if (j >= CTXL) { const int t = j - CTXL; const int pos = lane < 16 ? (t >> 6) : (t & 63), f = lane & 15; const float c = rope[pos * 32 + f], s = rope[pos * 32 + 16 + f];
                    const float o1 = x1 * c - x2 * s, o2 = x2 * c + x1 * s; x1 = o1; x2 = o2; }
                bf16* kr = KR + (size_t)row * 64; kr[lane] = (bf16)f2bf(x1); kr[32 + lane] = (bf16)f2bf(x2); } }
        {
            const bool hasp = (j != 0) && (j != CTXL), hasn = (j != CTXL - 1) && (j != NT - 1);
            const bf16x8 xc = *((const bf16x8*)(pr + 448) + lane); bf16x8 xp = {}, xn = {};
            if (hasp) xp = *((const bf16x8*)(pr - P_LD + 448) + lane);
            if (hasn) xn = *((const bf16x8*)(pr + P_LD + 448) + lane);
            const float* cw = F.in[I_CONVW]; const float* cb = F.in[I_CONVB]; const float ksc = lane >= 32 ? 0.125f : 1.f; unsigned o[4];
#pragma unroll
            for (int e = 0; e < 8; e += 2) { float r[2];
#pragma unroll
                for (int q = 0; q < 2; ++q) { const int ch = lane * 8 + e + q;
                    const float a = cw[ch] * bf2f((unsigned short)xp[e + q]) + cw[512 + ch] * bf2f((unsigned short)xc[e + q]) + cw[1024 + ch] * bf2f((unsigned short)xn[e + q]) + cb[ch];
                    r[q] = siluf(a) * ksc; }
                o[e >> 1] = pk2(r[0], r[1]); }
            *((u32x4*)(QKP + (size_t)row * 512) + lane) = (u32x4){o[0], o[1], o[2], o[3]}; }
        {
            if (lane < 16) { float g = GT[(size_t)row * 16 + lane] + F.in[I_GATEB][lane]; const int gi = lane >> 2; if (gi & 1) g = logsig(g); ((float*)(F.ws + WS_GL))[(size_t)row * 16 + lane] = g; } }
    }
}

namespace lin {
using att::crow; using att::cvtpk;
__device__ __forceinline__ float wave_prefix_add(float v, int lane) {
#pragma unroll
    for (int o = 1; o < 64; o <<= 1) { const float t = __shfl_up(v, o); if (lane >= o) v += t; }
    return v; }
__device__ __forceinline__ float wave_suffix_add(float v, int lane) {
#pragma unroll
    for (int o = 1; o < 64; o <<= 1) { const float t = __shfl_down(v, o); if (lane + o < 64) v += t; }
    return v; }
__device__ __forceinline__ float wave_prefix_max(float v, int lane) {
#pragma unroll
    for (int o = 1; o < 64; o <<= 1) { const float t = __shfl_up(v, o); if (lane >= o) v = fmaxf(v, t); }
    return v; }
__device__ __forceinline__ float wave_suffix_max(float v, int lane) {
#pragma unroll
    for (int o = 1; o < 64; o <<= 1) { const float t = __shfl_down(v, o); if (lane + o < 64) v = fmaxf(v, t); }
    return v; }
__device__ __forceinline__ float wave_max(float v) {
#pragma unroll
    for (int o = 1; o < 64; o <<= 1) v = fmaxf(v, __shfl_xor(v, o));
    return v; }
__device__ __forceinline__ unsigned voff(unsigned row, unsigned ch) { return 256u * row + 16u * (ch ^ (((row & 3u) << 2) | ((row >> 2) & 3u))); }
__device__ __forceinline__ unsigned v_tr_addr(unsigned lane, unsigned row0, unsigned c, unsigned t) {
    const unsigned h = lane >> 5, blk = (lane >> 4) & 1u, q = (lane & 15u) >> 2, p = lane & 3u;
    return voff(row0 + 8u * h + 4u * t + q, 4u * c + 2u * blk + (p >> 1)) + 8u * (p & 1u); }
__device__ __forceinline__ unsigned p_tr_addr(unsigned lane, unsigned pitchB, unsigned row0, unsigned c, unsigned t) {
    const unsigned h = lane >> 5, blk = (lane >> 4) & 1u, q = (lane & 15u) >> 2, p = lane & 3u;
    return (row0 + 8u * h + 4u * t + q) * pitchB + c * 64u + blk * 32u + p * 8u; }
__device__ __forceinline__ bf16x8 tr_frag(LAS unsigned char* base, unsigned a0, unsigned a1) {
    const s16x4 lo = __builtin_amdgcn_ds_read_tr16_b64_v4i16((LAS s16x4*)(base + a0)), hi = __builtin_amdgcn_ds_read_tr16_b64_v4i16((LAS s16x4*)(base + a1));
    return (bf16x8){lo[0], lo[1], lo[2], lo[3], hi[0], hi[1], hi[2], hi[3]}; }
#define LPK4(P, BASE, OUT) do { unsigned a0 = cvtpk(P[BASE + 0], P[BASE + 1]), a1 = cvtpk(P[BASE + 2], P[BASE + 3]);   \
    unsigned b0 = cvtpk(P[BASE + 4], P[BASE + 5]), b1 = cvtpk(P[BASE + 6], P[BASE + 7]);                              \
    auto r0 = __builtin_amdgcn_permlane32_swap(a0, b0, false, false); auto r1 = __builtin_amdgcn_permlane32_swap(a1, b1, false, false); \
    u32x4 w = {r0[0], r1[0], r0[1], r1[1]}; OUT = *reinterpret_cast<bf16x8*>(&w); } while (0)
__device__ __forceinline__ float half_sum32(float v) {
#pragma unroll
    for (int o = 1; o < 32; o <<= 1) v += __shfl_xor(v, o);
    return v; }
__device__ __forceinline__ float swap_add(float v) { auto rr = __builtin_amdgcn_permlane32_swap(__float_as_uint(v), __float_as_uint(v), false, false); return __uint_as_float(rr[0]) + __uint_as_float(rr[1]); }
}

namespace ml {
using att::cvtpk;
constexpr int ITEM_U = 8448;
constexpr int ITEM_S = 16896;
constexpr int L_V = 0, L_K = 65536, L_SC = 98304, L_WS = 98304 + 8192, L_CT = 98304 + 8192 + 1024;

__device__ __forceinline__ void load_gates(const float* GT, int row0, int h, int dir, int lane, float (&li)[4], float (&lf)[4]) {
#pragma unroll
    for (int i = 0; i < 4; ++i) { const float* g = GT + (size_t)(row0 + 4 * lane + i) * 16; li[i] = g[(2 * dir) * 4 + h]; lf[i] = g[(2 * dir + 1) * 4 + h]; }
}
__device__ __forceinline__ float cum_gates(const float (&lf)[4], int dir, int lane, float (&G)[4]) {
    float tot;
    if (dir == 0) { G[0] = lf[0]; G[1] = G[0] + lf[1]; G[2] = G[1] + lf[2]; G[3] = G[2] + lf[3]; const float inc = lin::wave_prefix_add(G[3], lane), ex = inc - G[3];
#pragma unroll
        for (int i = 0; i < 4; ++i) G[i] += ex;
        tot = __shfl(inc, 63); }
    else { G[3] = lf[3]; G[2] = G[3] + lf[2]; G[1] = G[2] + lf[1]; G[0] = G[1] + lf[0]; const float inc = lin::wave_suffix_add(G[0], lane), ex = inc - G[0];
#pragma unroll
        for (int i = 0; i < 4; ++i) G[i] += ex;
        tot = __shfl(inc, 0); }
    return tot;
}

__device__ __forceinline__ void pass_b(const Frame& F) {
    const bf16* P = (const bf16*)(F.ws + WS_P); const bf16* QKP = (const bf16*)(F.ws + WS_QKP); const float* GT = (const float*)(F.ws + WS_GL); float* MLU = (float*)(F.ws + WS_MLU);
    LAS unsigned char* Vl = F.lds + L_V; LAS unsigned char* Kl = F.lds + L_K; LAS float* wts = (LAS float*)(F.lds + L_SC); LAS float* part = (LAS float*)(F.lds + L_SC + 2048);
    const int tid = F.tid, lane = F.lane, wave = F.wave;
    for (int it = blockIdx.x; it < 16 * NGRP; it += F.G) {
        const int seq = it / NGRP, g = it - seq * NGRP, dir = seq & 1, h = (seq >> 1) & 3, b = seq >> 3, row0 = b * NT + g * 256;
        float* rec = MLU + (size_t)it * ITEM_U;
        __syncthreads();
        if (wave == 0) { float li[4], lf[4], G[4]; load_gates(GT, row0, h, dir, lane, li, lf); const float tot = cum_gates(lf, dir, lane, G);
            float e[4], mx = -3.0e38f;
#pragma unroll
            for (int i = 0; i < 4; ++i) { e[i] = li[i] + tot - G[i]; mx = fmaxf(mx, e[i]); }
            mx = lin::wave_max(mx);
#pragma unroll
            for (int i = 0; i < 4; ++i) wts[4 * lane + i] = __expf(e[i] - mx);
            if (lane == 0) { rec[8192 + 64] = mx; rec[8192 + 65] = tot; } }
        { const bf16* vb_ = P + (size_t)row0 * P_LD + 960 + h * 128;
#pragma unroll
            for (int c = 0; c < 8; ++c) { const int idx = c * 512 + tid, r = idx >> 4, ch = idx & 15; *(LAS bf16x8*)(Vl + (r >> 6) * 16384 + att::v_st(r & 63, ch * 8)) = *((const bf16x8*)(vb_ + (size_t)r * P_LD) + ch); } }
        __syncthreads();
        { const bf16* kb_ = QKP + (size_t)row0 * 512 + 256 + h * 64;
#pragma unroll
            for (int c = 0; c < 4; ++c) { const int idx = c * 512 + tid, r = idx >> 3, c0 = (idx & 7) * 8; const float w = wts[r]; const bf16x8 kv = *(const bf16x8*)(kb_ + (size_t)r * 512 + c0); u32x4 o;
                o.x = pk2(bf2f((unsigned short)kv[0]) * w, bf2f((unsigned short)kv[1]) * w); o.y = pk2(bf2f((unsigned short)kv[2]) * w, bf2f((unsigned short)kv[3]) * w);
                o.z = pk2(bf2f((unsigned short)kv[4]) * w, bf2f((unsigned short)kv[5]) * w); o.w = pk2(bf2f((unsigned short)kv[6]) * w, bf2f((unsigned short)kv[7]) * w);
                *(LAS u32x4*)(Kl + r * 128 + c0 * 2) = o; } }
        __syncthreads();
        { const int ei = wave >> 1, di = wave & 1; f32x16 acc = {}; const int vbase = att::v_rd_base(lane);
#pragma unroll
            for (int ks = 0; ks < 16; ++ks) {
                const bf16x8 a = lin::tr_frag(Vl + vbase + (ks >> 2) * 16384, ei * 512 + (ks & 3) * 4096, ei * 512 + (ks & 3) * 4096 + 2048);
                const bf16x8 bb = lin::tr_frag(Kl, lin::p_tr_addr(lane, 128, 16 * ks, di, 0), lin::p_tr_addr(lane, 128, 16 * ks, di, 1));
                acc = __builtin_amdgcn_mfma_f32_32x32x16_bf16(a, bb, acc, 0, 0, 0); }
            const int hi = lane >> 5;
#pragma unroll
            for (int r = 0; r < 16; ++r) rec[(32 * ei + lin::crow(r, hi)) * 64 + 32 * di + (lane & 31)] = acc[r]; }
        { const int d = tid & 63, sg = tid >> 6; float s = 0.f;
#pragma unroll 8
            for (int r = 0; r < 32; ++r) s += bf2f(*(LAS unsigned short*)(Kl + (sg * 32 + r) * 128 + d * 2));
            part[sg * 64 + d] = s; }
        __syncthreads();
        if (tid < 64) { float s = 0.f;
#pragma unroll
            for (int sg = 0; sg < 8; ++sg) s += part[sg * 64 + tid];
            rec[8192 + tid] = s; }
    }
}

__device__ __forceinline__ void pass_c(const Frame& F) {
    const float* __restrict__ MLU = (const float*)(F.ws + WS_MLU); unsigned char* __restrict__ MLS = F.ws + WS_MLS;
    for (int wgi = blockIdx.x; wgi < 16 * 16; wgi += F.G) {
        const int seq = wgi >> 4, part = wgi & 15, dir = seq & 1, el = part * 512 + F.tid;
        const bool do_n = (part == 0) && (F.tid < 64);
        float c = 0.f, n = 0.f, m = -1.0e30f;
#pragma unroll 1
        for (int blk = 0; blk < 5; ++blk) {
            float u[13], nu[13], mU[13], D[13];
#pragma unroll
            for (int i = 0; i < 13; ++i) { const int st = blk * 13 + i, g = dir == 0 ? st : (st == 0 ? 0 : NGRP - st); const float* rec = MLU + (size_t)(seq * NGRP + g) * ITEM_U;
                mU[i] = rec[8192 + 64]; D[i] = rec[8192 + 65]; u[i] = rec[el]; nu[i] = do_n ? rec[8192 + F.tid] : 0.f; }
#pragma unroll
            for (int i = 0; i < 13; ++i) { const int st = blk * 13 + i, g = dir == 0 ? st : (st == 0 ? 0 : NGRP - st); unsigned char* srec = MLS + (size_t)(seq * NGRP + g) * ITEM_S;
                ((bf16*)srec)[el] = (bf16)f2bf(c);
                if (do_n) ((float*)(srec + 16384))[F.tid] = n;
                if (part == 0 && F.tid == 0) *(float*)(srec + 16384 + 256) = m;
                const float mn = fmaxf(m + D[i], mU[i]), f1 = __expf(m + D[i] - mn), f2 = __expf(mU[i] - mn);
                c = f1 * c + f2 * u[i]; n = f1 * n + f2 * nu[i]; m = mn; }
        }
    }
}

__device__ __forceinline__ void pass_d(const Frame& F) {
    const bf16* P = (const bf16*)(F.ws + WS_P); const bf16* QKP = (const bf16*)(F.ws + WS_QKP); const float* GT = (const float*)(F.ws + WS_GL);
    const unsigned char* MLS = F.ws + WS_MLS; bf16* CAT = (bf16*)(F.ws + WS_CAT);
    LAS unsigned char* Vl = F.lds + L_V; LAS unsigned char* Kl = F.lds + L_K; LAS float* sc = (LAS float*)(F.lds + L_SC);
    const int tid = F.tid, lane = F.lane, wave = F.wave, t32 = lane & 31, hi = lane >> 5;
    LAS float* wsc = (LAS float*)(F.lds + L_WS) + wave * 32;
    for (int it = blockIdx.x; it < 8 * NGRP; it += F.G) {
        const int bh = it / NGRP, g = it - bh * NGRP, b = bh >> 2, h = bh & 3, row0 = b * NT + g * 256;
        __syncthreads();
        if (wave < 2) { const int dir = wave; const unsigned char* srec = MLS + (size_t)((bh * 2 + dir) * NGRP + g) * ITEM_S; const float mg = *(const float*)(srec + 16384 + 256);
            float li[4], lf[4], G[4]; load_gates(GT, row0, h, dir, lane, li, lf); (void)cum_gates(lf, dir, lane, G);
            float a[4], M[4];
#pragma unroll
            for (int i = 0; i < 4; ++i) a[i] = li[i] - G[i];
            if (dir == 0) { M[0] = a[0]; M[1] = fmaxf(M[0], a[1]); M[2] = fmaxf(M[1], a[2]); M[3] = fmaxf(M[2], a[3]);
                const float inc = lin::wave_prefix_max(M[3], lane); float ex = __shfl_up(inc, 1); if (lane == 0) ex = -3.0e38f; ex = fmaxf(ex, mg);
#pragma unroll
                for (int i = 0; i < 4; ++i) M[i] = fmaxf(M[i], ex); }
            else { M[3] = a[3]; M[2] = fmaxf(M[3], a[2]); M[1] = fmaxf(M[2], a[1]); M[0] = fmaxf(M[1], a[0]);
                const float inc = lin::wave_suffix_max(M[0], lane); float ex = __shfl_down(inc, 1); if (lane == 63) ex = -3.0e38f; ex = fmaxf(ex, mg);
#pragma unroll
                for (int i = 0; i < 4; ++i) M[i] = fmaxf(M[i], ex); }
            LAS float* s = sc + dir * 1024;
#pragma unroll
            for (int i = 0; i < 4; ++i) { const int r = 4 * lane + i; s[r] = a[i]; s[256 + r] = M[i]; s[512 + r] = __expf(-G[i] - M[i]); s[768 + r] = __expf(mg - M[i]); } }
        {
#pragma unroll 1
            for (int dd = 0; dd < 2; ++dd) { const bf16x8* src = (const bf16x8*)(MLS + (size_t)((bh * 2 + dd) * NGRP + g) * ITEM_S);
#pragma unroll
                for (int c = 0; c < 2; ++c) *(LAS bf16x8*)(F.lds + L_CT + dd * 16384 + tid * 32 + c * 16) = src[tid * 2 + c]; } }
        __builtin_amdgcn_sched_barrier(0);
        { const int r = tid >> 1, c0 = (tid & 1) * 8; const bf16* vp = P + (size_t)(row0 + r) * P_LD + 960 + h * 128 + c0 * 8;
#pragma unroll
            for (int c = 0; c < 8; ++c) *(LAS bf16x8*)(Vl + (r >> 6) * 16384 + att::v_st(r & 63, (c0 + c) * 8)) = *((const bf16x8*)vp + c);
            const int k0 = (tid & 1) * 4; const bf16* kp = QKP + (size_t)(row0 + r) * 512 + 256 + h * 64 + k0 * 8;
#pragma unroll
            for (int c = 0; c < 4; ++c) *(LAS bf16x8*)(Kl + r * 128 + (((k0 + c) ^ (r & 7)) << 4)) = *((const bf16x8*)kp + c); }
        __syncthreads();
        const int I = wave < 4 ? wave : 11 - wave, trow = 32 * I + t32, vbase = att::v_rd_base(lane);
        bf16x8 qr[4];
        { const bf16* qp = QKP + (size_t)(row0 + trow) * 512 + h * 64 + hi * 8;
#pragma unroll
            for (int kk = 0; kk < 4; ++kk) qr[kk] = *(const bf16x8*)(qp + kk * 16); }
        u32x2 hpk[4][4];
        f32x16 o[4];
#pragma unroll 1
        for (int dir = 0; dir < 2; ++dir) {
            const LAS float* s = sc + dir * 1024; const float Mt = s[256 + trow];
#pragma unroll
            for (int c = 0; c < 4; ++c) o[c] = f32x16{};
            float den = 0.f;
            const int Jlo = dir == 0 ? 0 : I, Jhi = dir == 0 ? I : 7;
#pragma unroll 1
            for (int J = Jlo; J <= Jhi; ++J) {
                f32x16 p = {};
#pragma unroll
                for (int kk = 0; kk < 4; ++kk) { const int kr = 32 * J + t32; const bf16x8 kf = *(LAS bf16x8*)(Kl + kr * 128 + (((2 * kk + hi) ^ (kr & 7)) << 4));
                    p = __builtin_amdgcn_mfma_f32_32x32x16_bf16(kf, qr[kk], p, 0, 0, 0); }
                const bool diag = (J == I);
#pragma unroll
                for (int r = 0; r < 16; ++r) { const int sl = lin::crow(r, hi); const float w = __expf(s[32 * J + sl] - Mt);
                    const bool keep = !diag || (dir == 0 ? (sl <= t32) : (sl >= t32)); p[r] = keep ? p[r] * w : 0.f; den += p[r]; }
                bf16x8 pa0, pa1; LPK4(p, 0, pa0); LPK4(p, 8, pa1);
                LAS unsigned char* vj = Vl + vbase + (J >> 1) * 16384 + (J & 1) * 8192;
#pragma unroll
                for (int c = 0; c < 4; ++c) {
                    const bf16x8 v0 = lin::tr_frag(vj, c * 512, c * 512 + 2048);
                    const bf16x8 v1 = lin::tr_frag(vj, c * 512 + 4096, c * 512 + 4096 + 2048);
                    o[c] = __builtin_amdgcn_mfma_f32_32x32x16_bf16(pa0, v0, o[c], 0, 0, 0);
                    o[c] = __builtin_amdgcn_mfma_f32_32x32x16_bf16(pa1, v1, o[c], 0, 0, 0); }
            }
            { const unsigned char* srec = MLS + (size_t)((bh * 2 + dir) * NGRP + g) * ITEM_S; const float* nv = (const float*)(srec + 16384);
                const float wi = s[768 + trow]; float dn = 0.f;
#pragma unroll
                for (int kk = 0; kk < 4; ++kk) { float qf[8];
#pragma unroll
                    for (int e = 0; e < 8; ++e) { qf[e] = bf2f((unsigned short)qr[kk][e]); dn += qf[e] * nv[kk * 16 + hi * 8 + e]; qf[e] *= wi; }
                    u32x4 w = {cvtpk(qf[0], qf[1]), cvtpk(qf[2], qf[3]), cvtpk(qf[4], qf[5]), cvtpk(qf[6], qf[7])}; const bf16x8 aq = *reinterpret_cast<bf16x8*>(&w);
#pragma unroll
                    for (int c = 0; c < 4; ++c) { const int e_ = 32 * c + t32; const bf16x8 cf = *(LAS bf16x8*)(F.lds + L_CT + dir * 16384 + e_ * 128 + (2 * kk + hi) * 16);
                        o[c] = __builtin_amdgcn_mfma_f32_32x32x16_bf16(aq, cf, o[c], 0, 0, 0); } }
                den += wi * dn; }
            den = lin::swap_add(den);
            const float inv = 1.f / fmaxf(fabsf(den), s[512 + trow]);
            if (hi == 0) wsc[t32] = inv;
            LDS_WAIT(); asm volatile("" ::: "memory");
            if (dir == 0) {
#pragma unroll
                for (int r = 0; r < 16; r += 4) { const float i0 = wsc[lin::crow(r, hi)], i1 = wsc[lin::crow(r + 1, hi)], i2 = wsc[lin::crow(r + 2, hi)], i3 = wsc[lin::crow(r + 3, hi)];
#pragma unroll
                    for (int c = 0; c < 4; ++c) { hpk[c][r >> 2].x = cvtpk(o[c][r] * i0, o[c][r + 1] * i1); hpk[c][r >> 2].y = cvtpk(o[c][r + 2] * i2, o[c][r + 3] * i3); } }
            } else {
#pragma unroll
                for (int r = 0; r < 16; r += 4) { const float i0 = wsc[lin::crow(r, hi)], i1 = wsc[lin::crow(r + 1, hi)], i2 = wsc[lin::crow(r + 2, hi)], i3 = wsc[lin::crow(r + 3, hi)];
#pragma unroll
                    for (int c = 0; c < 4; ++c) { const u32x2 hp = hpk[c][r >> 2];
                        o[c][r] = o[c][r] * i0 + bf2f(hp.x & 0xffffu); o[c][r + 1] = o[c][r + 1] * i1 + bf2f(hp.x >> 16);
                        o[c][r + 2] = o[c][r + 2] * i2 + bf2f(hp.y & 0xffffu); o[c][r + 3] = o[c][r + 3] * i3 + bf2f(hp.y >> 16); } }
            }
            LDS_WAIT(); asm volatile("" ::: "memory");
        }
        const float* hg = F.in[I_MLGAIN] + h * 128;
        int lane_r = F.lane; asm volatile("" : "+v"(lane_r)); const int t32r = lane_r & 31, hir = lane_r >> 5;
#pragma unroll
        for (int r = 0; r < 16; ++r) { float ss = 0.f;
#pragma unroll
            for (int c = 0; c < 4; ++c) ss += o[c][r] * o[c][r];
            ss = lin::half_sum32(ss); const float rstd = rsqrtf(ss * (1.f / 128.f) + RMS_EPS); const int row = row0 + 32 * I + lin::crow(r, hir);
            const bf16* op = P + (size_t)row * P_LD + 1472 + h * 128; bf16* cp = CAT + (size_t)row * DM + 512 + h * 128;
#pragma unroll
            for (int c = 0; c < 4; ++c) { const int e = 32 * c + t32r; cp[e] = (bf16)f2bf(o[c][r] * rstd * hg[e] * sigm(bf2f(op[e]))); }
            __builtin_amdgcn_sched_barrier(0); }
    }
}
}

namespace hg {
using att::cvtpk;
constexpr size_t WS_HGD = 3 * MiB;
constexpr size_t WS_QT = WS_D;
constexpr int L_V = 0, L_K = 65536, L_ET = 131072, L_WS = 131072 + 4096;
#define K256(row, colB) ((row) * 256 + ((colB) ^ (((row) & 7) << 4)))

struct Cols { const bf16* pc; const float* lb; int h, dir; };
__device__ __forceinline__ void fk(float z, float lb, float& logf, float& k) { const float sg = __builtin_amdgcn_rcpf(1.f + __expf(-z)); logf = __logf(lb + (1.f - lb) * sg); k = (1.f - lb) * (1.f - sg); }
__device__ __forceinline__ void ffk(float z, float lb, float& f, float& k) { const float sg = __builtin_amdgcn_rcpf(1.f + __expf(-z)); f = lb + (1.f - lb) * sg; k = (1.f - lb) * (1.f - sg); }

__device__ __forceinline__ int vimg(int row, int c) { return (row >> 6) * 16384 + att::v_st(row & 63, c); }
__device__ __forceinline__ void pass_b(const Frame& F) {
    const bf16* PC = (const bf16*)(F.ws + WS1_PC); const float* LB = (const float*)(F.ws + WS_LB); bf16* U = (bf16*)(F.ws + WS1_U); float* HGD = (float*)(F.ws + WS_HGD);
    LAS unsigned char* Vl = F.lds + L_V; LAS unsigned char* Kl = F.lds + L_K; LAS float* tot = (LAS float*)(F.lds + L_ET);
    const int wave = F.wave;
    bf16x8 vv[8], zz[8];
#define HGB_FETCH(item) do { const int seq_ = (item) / NGRP, g_ = (item) - seq_ * NGRP, dir_ = seq_ & 1, h_ = (seq_ >> 1) & 7, b_ = seq_ >> 4, row0_ = b_ * NT + g_ * 256; \
        const bf16* vb_ = PC + (size_t)row0_ * 5120 + 3072 + h_ * 128; const bf16* zb_ = PC + (size_t)row0_ * 5120 + 1024 * (1 + dir_) + h_ * 128; \
        _Pragma("unroll") for (int c = 0; c < 8; ++c) { const unsigned off = (unsigned)(F.tid >> 4) * 10240u + (unsigned)(F.tid & 15) * 16u + (unsigned)c * 327680u; vv[c] = *(const bf16x8*)((const char*)vb_ + off); zz[c] = *(const bf16x8*)((const char*)zb_ + off); } } while (0)
    if ((int)blockIdx.x < 32 * NGRP) HGB_FETCH((int)blockIdx.x);
    for (int it = blockIdx.x; it < 32 * NGRP; it += F.G) {
        const int seq = it / NGRP, g = it - seq * NGRP, dir = seq & 1, h = (seq >> 1) & 7;
        int tid = F.tid, lane = F.lane; asm volatile("" : "+v"(tid), "+v"(lane));
        __syncthreads();
#pragma unroll
        for (int c = 0; c < 8; ++c) { const int idx = c * 512 + tid, r = idx >> 4, ch = idx & 15; const int o = vimg(r, ch * 8); *(LAS bf16x8*)(Vl + o) = vv[c]; *(LAS bf16x8*)(Kl + o) = zz[c]; }
        if (it + F.G < 32 * NGRP) HGB_FETCH(it + F.G);
        __syncthreads();
        const int d = tid & 127, sg = tid >> 7; const float lb = LB[h * 128 + d];
        { float acc = 1.f;
#pragma unroll 4
            for (int i = 0; i < 64; ++i) { const int row = sg * 64 + (dir == 0 ? 63 - i : i); LAS unsigned short* p = (LAS unsigned short*)(Kl + vimg(row, d));
                const float k = bf2f(*p); *p = (unsigned short)f2bf(k * acc); acc *= (1.f - k); }
            tot[sg * 128 + d] = acc; }
        __syncthreads();
        if (sg == 0) HGD[(size_t)it * 128 + d] = (tot[d] * tot[128 + d]) * (tot[256 + d] * tot[384 + d]);
        { const int ei = wave >> 1, dj = 2 * (wave & 1), vb = att::v_rd_base(lane), hi = lane >> 5, d0 = 32 * dj + (lane & 31), d1 = d0 + 32; f32x16 a0 = {}, a1 = {};
#pragma unroll
            for (int sgm = 0; sgm < 4; ++sgm) { f32x16 s0 = {}, s1 = {};
#pragma unroll
                for (int k4 = 0; k4 < 4; ++k4) { const int to = sgm * 16384 + k4 * 4096;
                    const bf16x8 a = lin::tr_frag(Vl + vb + to, ei * 512, ei * 512 + 2048);
                    const bf16x8 b0 = lin::tr_frag(Kl + vb + to, dj * 512, dj * 512 + 2048), b1 = lin::tr_frag(Kl + vb + to, (dj + 1) * 512, (dj + 1) * 512 + 2048);
                    s0 = __builtin_amdgcn_mfma_f32_32x32x16_bf16(a, b0, s0, 0, 0, 0); s1 = __builtin_amdgcn_mfma_f32_32x32x16_bf16(a, b1, s1, 0, 0, 0); }
                float f0 = 1.f, f1 = 1.f;
                if (dir == 0) { for (int s2 = sgm + 1; s2 < 4; ++s2) { f0 *= tot[s2 * 128 + d0]; f1 *= tot[s2 * 128 + d1]; } } else { for (int s2 = 0; s2 < sgm; ++s2) { f0 *= tot[s2 * 128 + d0]; f1 *= tot[s2 * 128 + d1]; } }
#pragma unroll
                for (int r = 0; r < 16; ++r) { a0[r] += s0[r] * f0; a1[r] += s1[r] * f1; } }
            bf16* rec = U + (size_t)it * 16384;
#pragma unroll
            for (int r = 0; r < 16; ++r) { bf16* p = rec + (32 * ei + lin::crow(r, hi)) * 128 + 32 * dj + (lane & 31); p[0] = (bf16)f2bf(a0[r]); p[32] = (bf16)f2bf(a1[r]); } }
    }
}

#undef HGB_FETCH
__device__ __forceinline__ void pass_c(const Frame& F) {
    const unsigned* __restrict__ U2 = (const unsigned*)(F.ws + WS1_U); const float* __restrict__ HGD = (const float*)(F.ws + WS_HGD); unsigned* __restrict__ S2 = (unsigned*)(F.ws + WS1_S);
    for (int wgi = blockIdx.x; wgi < 32 * 16; wgi += F.G) {
        const int seq = wgi >> 4, part = wgi & 15, dir = seq & 1, pr = part * 512 + F.tid, d = (2 * pr) & 127;
        float c0, c1; { const size_t ix = (size_t)(seq * NGRP); const unsigned u0 = U2[ix * 8192 + pr]; S2[ix * 8192 + pr] = 0u; c0 = bf2f(u0 & 0xffffu); c1 = bf2f(u0 >> 16); }
#pragma unroll 1
        for (int blk = 0; blk < 4; ++blk) {
            unsigned u[16]; float dg0[16], dg1[16];
#pragma unroll
            for (int i = 0; i < 16; ++i) { const int st = 1 + blk * 16 + i, g = dir == 0 ? st : NGRP - st; const size_t ix = (size_t)(seq * NGRP + g);
                u[i] = U2[ix * 8192 + pr]; const float* hp = HGD + ix * 128 + d; dg0[i] = hp[0]; dg1[i] = hp[1]; }
#pragma unroll
            for (int i = 0; i < 16; ++i) { const int st = 1 + blk * 16 + i, g = dir == 0 ? st : NGRP - st; const size_t ix = (size_t)(seq * NGRP + g);
                S2[ix * 8192 + pr] = pk2(c0, c1); c0 = dg0[i] * c0 + bf2f(u[i] & 0xffffu); c1 = dg1[i] * c1 + bf2f(u[i] >> 16); }
        }
    }
}

__device__ __forceinline__ void pass_d(const Frame& F) {
    const bf16* PC = (const bf16*)(F.ws + WS1_PC); const float* LB = (const float*)(F.ws + WS_LB); const bf16* S = (const bf16*)(F.ws + WS1_S); bf16* CAT = (bf16*)(F.ws + WS1_CAT);
    bf16* QT = (bf16*)(F.ws + WS_QT) + (size_t)blockIdx.x * 32768;
    LAS unsigned char* Vl = F.lds + L_V; LAS unsigned char* Kl = F.lds + L_K; LAS float* ET = (LAS float*)(F.lds + L_ET);
    const int tid = F.tid, lane = F.lane, wave = F.wave, t32 = lane & 31, hi = lane >> 5, vb = att::v_rd_base(lane);
    for (int it = blockIdx.x; it < 16 * 64; it += F.G) {
        const int bh = it >> 6, g = (it & 63) + 1, b = bh >> 3, h = bh & 7, row0 = b * NT + g * 256;
        const int I = wave < 4 ? wave : 11 - wave, trow = 32 * I + t32;
        f32x16 o[4] = {};
#pragma unroll 1
        for (int dir = 0; dir < 2; ++dir) {
            __syncthreads();
            {
                const bf16* zb_ = PC + (size_t)row0 * 5120 + 1024 * (1 + dir) + h * 128; const bf16* qb_ = PC + (size_t)row0 * 5120 + h * 128;
#pragma unroll 1
                for (int c0 = 0; c0 < 8; c0 += 4) {
                    bf16x8 zz[4], qq[4];
#pragma unroll
                    for (int c = 0; c < 4; ++c) { const unsigned off = (unsigned)(tid >> 4) * 10240u + (unsigned)(tid & 15) * 16u + (unsigned)(c0 + c) * 327680u;
                        zz[c] = *(const bf16x8*)((const char*)zb_ + off); qq[c] = *(const bf16x8*)((const char*)qb_ + off); }
#pragma unroll
                    for (int c = 0; c < 4; ++c) { const int idx = (c0 + c) * 512 + tid, r = idx >> 4, ch = idx & 15; *(LAS bf16x8*)(Kl + K256(r, ch * 16)) = zz[c]; *(LAS bf16x8*)(Vl + r * 256 + ch * 16) = qq[c]; } } }
            __syncthreads();
            {
                const int d = tid & 127; const float lb = LB[h * 128 + d];
#pragma unroll 1
                for (int q2 = 0; q2 < 2; ++q2) { const int B = (tid >> 7) + 4 * q2; float x = 1.f;
#pragma unroll 4
                    for (int i = 0; i < 32; ++i) { const int row = 32 * B + (dir == 0 ? i : 31 - i);
                        LAS unsigned short* zp = (LAS unsigned short*)(Kl + K256(row, d * 2)); LAS unsigned short* qp = (LAS unsigned short*)(Vl + row * 256 + d * 2);
                        const float k = bf2f(*zp); x *= (1.f - k);
                        *zp = (unsigned short)f2bf(k * __builtin_amdgcn_rcpf(fmaxf(x, 1.0e-30f))); *qp = (unsigned short)f2bf(bf2f(*qp) * x); }
                    ET[B * 128 + d] = x; } }
            __syncthreads();
            float qf[8][8];
            { const LAS unsigned char* qp = Vl + trow * 256 + hi * 16;
#pragma unroll
                for (int kk = 0; kk < 8; ++kk) { const bf16x8 v = *(const LAS bf16x8*)(qp + kk * 32);
#pragma unroll
                    for (int e = 0; e < 8; ++e) qf[kk][e] = bf2f((unsigned short)v[e]); } }
            __syncthreads();
            { const bf16* vb_ = PC + (size_t)row0 * 5120 + 3072 + h * 128; bf16x8 vv[8];
#pragma unroll
                for (int c = 0; c < 8; ++c) { const unsigned off = (unsigned)(tid >> 4) * 10240u + (unsigned)(tid & 15) * 16u + (unsigned)c * 327680u; vv[c] = *(const bf16x8*)((const char*)vb_ + off); }
#pragma unroll
                for (int c = 0; c < 8; ++c) { const int idx = c * 512 + tid, r = idx >> 4, ch = idx & 15; *(LAS bf16x8*)(Vl + vimg(r, ch * 8)) = vv[c]; } }
            __syncthreads();
            const bf16* ST = S + (size_t)((bh * 2 + dir) * NGRP + g) * 16384; bf16x8 sreg[4];
#pragma unroll
            for (int c = 0; c < 4; ++c) sreg[c] = *((const bf16x8*)ST + c * 512 + tid);
            const int nst = dir == 0 ? I + 1 : 8 - I;
#pragma unroll 1
            for (int st = 0; st < nst; ++st) {
                const int J = dir == 0 ? I - st : I + st;
                if (st != 0) {
#pragma unroll
                    for (int kk = 0; kk < 8; ++kk) { const f32x4 e0 = *(LAS f32x4*)(ET + J * 128 + kk * 16 + hi * 8), e1 = *(LAS f32x4*)(ET + J * 128 + kk * 16 + hi * 8 + 4);
                        qf[kk][0] *= e0[0]; qf[kk][1] *= e0[1]; qf[kk][2] *= e0[2]; qf[kk][3] *= e0[3]; qf[kk][4] *= e1[0]; qf[kk][5] *= e1[1]; qf[kk][6] *= e1[2]; qf[kk][7] *= e1[3]; } }
                f32x16 p = {};
#pragma unroll
                for (int kk = 0; kk < 8; ++kk) { const int kr = 32 * J + t32; const bf16x8 kf = *(LAS bf16x8*)(Kl + K256(kr, (2 * kk + hi) * 16));
                    u32x4 w = {cvtpk(qf[kk][0], qf[kk][1]), cvtpk(qf[kk][2], qf[kk][3]), cvtpk(qf[kk][4], qf[kk][5]), cvtpk(qf[kk][6], qf[kk][7])};
                    p = __builtin_amdgcn_mfma_f32_32x32x16_bf16(kf, *reinterpret_cast<bf16x8*>(&w), p, 0, 0, 0); }
                if (st == 0) {
#pragma unroll
                    for (int r = 0; r < 16; ++r) { const int sl = lin::crow(r, hi); const bool keep = dir == 0 ? (sl <= t32) : (sl >= t32); p[r] = keep ? p[r] : 0.f; } }
                asm volatile("s_nop 15\n\ts_nop 7" : "+v"(p));
                bf16x8 pa0, pa1; LPK4(p, 0, pa0); LPK4(p, 8, pa1);
                LAS unsigned char* vj = Vl + vb + (J >> 1) * 16384 + (J & 1) * 8192;
#pragma unroll
                for (int c = 0; c < 4; ++c) {
                    const bf16x8 v0 = lin::tr_frag(vj, c * 512, c * 512 + 2048);
                    const bf16x8 v1 = lin::tr_frag(vj, c * 512 + 4096, c * 512 + 4096 + 2048);
                    o[c] = __builtin_amdgcn_mfma_f32_32x32x16_bf16(pa0, v0, o[c], 0, 0, 0);
                    o[c] = __builtin_amdgcn_mfma_f32_32x32x16_bf16(pa1, v1, o[c], 0, 0, 0); }
            }
            __syncthreads();
#pragma unroll
            for (int c = 0; c < 4; ++c) { const int ch = c * 512 + tid, e = ch >> 4, cc = ch & 15; *(LAS bf16x8*)(Kl + K256(e, cc * 16)) = sreg[c]; }
            __syncthreads();
#pragma unroll
            for (int kk = 0; kk < 8; ++kk) { u32x4 w = {cvtpk(qf[kk][0], qf[kk][1]), cvtpk(qf[kk][2], qf[kk][3]), cvtpk(qf[kk][4], qf[kk][5]), cvtpk(qf[kk][6], qf[kk][7])};
                const bf16x8 aq = *reinterpret_cast<bf16x8*>(&w);
#pragma unroll
                for (int c = 0; c < 4; ++c) { const bf16x8 sf = *(LAS bf16x8*)(Kl + K256(32 * c + t32, (2 * kk + hi) * 16));
                    o[c] = __builtin_amdgcn_mfma_f32_32x32x16_bf16(aq, sf, o[c], 0, 0, 0); } }
        }
        __syncthreads();
        { const bf16* gb_ = PC + (size_t)row0 * 5120 + 4096 + h * 128;
#pragma unroll
            for (int c = 0; c < 8; ++c) { const unsigned off = (unsigned)(tid >> 4) * 10240u + (unsigned)(tid & 15) * 16u + (unsigned)c * 327680u;
                __builtin_amdgcn_global_load_lds((const unsigned*)((const char*)gb_ + off), (LAS unsigned*)(Kl + c * 8192 + wave * 1024), 16, 0, 0); }
            VM_WAIT(); }
        __syncthreads();
        const float* gn = F.in[I_HGGAIN] + h * 128; LAS unsigned char* gbase = Kl + (32 * I + 4 * hi) * 256 + t32 * 2;
#pragma unroll
        for (int r = 0; r < 16; ++r) { float ss = 0.f;
#pragma unroll
            for (int c = 0; c < 4; ++c) ss += o[c][r] * o[c][r];
            ss = lin::half_sum32(ss); const float rstd = rsqrtf(ss * (1.f / 128.f) + RMS_EPS); const int row = row0 + 32 * I + lin::crow(r, hi);
            const LAS unsigned short* gp = (const LAS unsigned short*)(gbase + ((r & 3) + 8 * (r >> 2)) * 256); bf16* cp = CAT + (size_t)row * DM + h * 128;
#pragma unroll
            for (int c = 0; c < 4; ++c) { const int e = 32 * c + t32; cp[e] = (bf16)f2bf(o[c][r] * rstd * gn[e] * siluf(bf2f(gp[32 * c]))); }
            __builtin_amdgcn_sched_barrier(0); }
    }
}
}


namespace moe {
constexpr size_t WS_TILEE = WS_WGBASE + 65536;
constexpr size_t GU_SLAB = (size_t)2 * DFF * 1024, DN_SLAB = (size_t)1024 * DFF;
constexpr float GU_WSCALE = 32.f, DN_WSCALE = 64.f;
constexpr size_t MWGU_OFF = 0, MWDN_OFF = 8 * GU_SLAB;
static_assert(MWDN_OFF + 8 * DN_SLAB <= (size_t)2 * SEQ * DM * 4, "MoE weights");
struct TokRec { int e0, e1, p0, p1; float g0, g1; int s0, s1; };

__device__ __forceinline__ void convert_expert_weights(const Frame& F) {
    __syncthreads();
    transpose_items_i8(F, 1024, 2 * DFF, F.ws + WS_W_GU, SrcPlain{F.in[I_FFNGU], 2 * DFF, 2 * DFF}, DstGU{}, (const float*)(F.ws + WS_CMAXP) + 0, (float*)(F.ws + WS_CTL) + CW_COLSC + 0);
    transpose_items_f8(F, DFF, 1024, F.ws + WS_W_DN, SrcPlain{F.in[I_FFNDN], 1024, 1024}, DstPlain{}, DN_WSCALE);
    transpose_items_i8(F, 1024, 5120, F.ws + WS_W_INC, SrcPlain{F.in[I_WINC], 5120, 5120}, DstPlain{}, (const float*)(F.ws + WS_CMAXP) + 5632, (float*)(F.ws + WS_CTL) + CW_COLSC + 5632);
    transpose_items(F, 1024, 1024, (bf16*)(F.ws + WS_W_OUTC), SrcPlain{F.in[I_WOUTC], 1024, 1024}, DstPlain{});
    for (int e = 0; e < NEXP; ++e) {
        transpose_items_f8(F, 1024, 2 * DFF, (unsigned char*)F.out + MWGU_OFF + e * GU_SLAB, SrcPlain{F.in[I_MOEGU] + (size_t)e * 1024 * 2 * DFF, 2 * DFF, 2 * DFF}, DstGU{}, GU_WSCALE);
        transpose_items_f8(F, DFF, 1024, (unsigned char*)F.out + MWDN_OFF + e * DN_SLAB, SrcPlain{F.in[I_MOEDN] + (size_t)e * DFF * 1024, 1024, 1024}, DstPlain{}, DN_WSCALE);
    }
    __syncthreads();
}
__device__ __forceinline__ void p19_route(const Frame& F) {
    LAS float* wr = (LAS float*)F.lds;
    LAS int* cntl = (LAS int*)(F.lds + 32768);
    for (int i = F.tid; i < 8192; i += NTHREADS) wr[i] = F.in[I_ROUTER][i];
    if (F.tid < 8) cntl[F.tid] = 0;
    __syncthreads();
    const bf16* Y = (const bf16*)(F.ws + WS1_Y); unsigned char* H2 = F.ws + WS1_H2; TokRec* TR = (TokRec*)(F.ws + WS_TOKREC);
    const float* gain_a = F.in[I_GAINS] + 5 * 1024; const float* gain_b = F.in[I_GAINS] + 6 * 1024; const int lane = F.lane;
    u32x2 yw[4], ywn[4], xw[4], xwn[4]; f32x4 x[4], vga[4], vgb[4], vgt[4], vsh[4], vsc[4]; int cur = -1; load_vec(gain_a, lane, vga); load_vec(gain_b, lane, vgb);
    int row = F.gw; { while (row < NR) { int b, j; row_decode(row, b, j); if (j >= CTXL) break; row += F.NGW; } }
    if (row < NR) { load_row_raw(Y + (size_t)row * DM, lane, yw); load_row_raw(res_row(F, row), lane, xw); }
    while (row < NR) {
        int nrow = row + F.NGW; { while (nrow < NR) { int b, j; row_decode(nrow, b, j); if (j >= CTXL) break; nrow += F.NGW; } }
        if (nrow < NR) { load_row_raw(Y + (size_t)nrow * DM, lane, ywn); load_row_raw(res_row(F, nrow), lane, xwn); }
        int b, j; row_decode(row, b, j);
        f32x4 y[4]; cvt_row(yw, y); cvt_row(xw, x); bf16* xr = res_row(F, row);
        if (b != cur) { cur = b; load_vec(mod_vec(F, 1, row, 2), lane, vgt); load_vec(mod_vec(F, 1, row, 3), lane, vsh); load_vec(mod_vec(F, 1, row, 4), lane, vsc); }
        const float rstd = row_rstd(y);
#pragma unroll
        for (int q = 0; q < 4; ++q) { const int idx = lane + 64 * q; x[q] = x[q] + vgt[q] * (y[q] * rstd * vga[q]); store_res(xr, idx, x[q]); }
        const float rs2 = row_rstd(x);
        float lg[8] = {0.f, 0.f, 0.f, 0.f, 0.f, 0.f, 0.f, 0.f};
#pragma unroll
        for (int q = 0; q < 4; ++q) { const int idx = lane + 64 * q;
            const f32x4 hv = (x[q] * rs2 * vgb[q]) * (1.f + vsc[q]) + vsh[q];
            *((unsigned*)(H2 + (size_t)row * DM) + idx) = pk4_fp8(hv.x, hv.y, hv.z, hv.w);
#pragma unroll
            for (int i = 0; i < 4; ++i) { const f32x4 w0 = *(LAS f32x4*)(wr + (4 * idx + i) * 8), w1 = *(LAS f32x4*)(wr + (4 * idx + i) * 8 + 4); const float hh = hv[i];
                lg[0] += hh * w0[0]; lg[1] += hh * w0[1]; lg[2] += hh * w0[2]; lg[3] += hh * w0[3]; lg[4] += hh * w1[0]; lg[5] += hh * w1[1]; lg[6] += hh * w1[2]; lg[7] += hh * w1[3]; } }
#pragma unroll
        for (int e = 0; e < 8; ++e) lg[e] = wave_sum(lg[e]);
        int e0 = 0; float v0 = lg[0];
#pragma unroll
        for (int e = 1; e < 8; ++e) if (lg[e] > v0) { v0 = lg[e]; e0 = e; }
        int e1 = -1; float v1 = -3.0e38f;
#pragma unroll
        for (int e = 0; e < 8; ++e) if (e != e0 && lg[e] > v1) { v1 = lg[e]; e1 = e; }
        if (lane == 0) { const float ga = 1.f / (1.f + __expf(v1 - v0)); const int p0 = atomicAdd((int*)&cntl[e0], 1), p1 = atomicAdd((int*)&cntl[e1], 1);
            TokRec t; t.e0 = e0; t.e1 = e1; t.p0 = p0; t.p1 = p1; t.g0 = ga; t.g1 = 1.f - ga; t.s0 = 0; t.s1 = 0; TR[b * SEQ + (j - CTXL)] = t; }
#pragma unroll
        for (int q = 0; q < 4; ++q) { yw[q] = ywn[q]; xw[q] = xwn[q]; }
        row = nrow;
    }
    __syncthreads();
    if (F.tid < 8) { unsigned* cnt = (unsigned*)(F.ws + WS_CTL) + CW_MOECNT + 64 * F.tid;
        ((unsigned*)(F.ws + WS_WGBASE))[blockIdx.x * 64 + F.tid] = __hip_atomic_fetch_add(cnt, (unsigned)cntl[F.tid], __ATOMIC_RELAXED, __HIP_MEMORY_SCOPE_AGENT); }
}
__device__ __forceinline__ int slot_layout(const Frame& F, int (&base)[8], int (&cnt)[8]) {
    int acc = 0;
#pragma unroll
    for (int e = 0; e < 8; ++e) { cnt[e] = (int)__hip_atomic_load((unsigned*)(F.ws + WS_CTL) + CW_MOECNT + 64 * e, __ATOMIC_RELAXED, __HIP_MEMORY_SCOPE_AGENT); base[e] = acc; acc += (cnt[e] + 255) & ~255; }
    return acc >> 8;
}
__device__ __forceinline__ void p20_gather(const Frame& F) {
    int base[8], cnt[8]; const int ntiles = slot_layout(F, base, cnt);
    if (blockIdx.x == 0) { int* te = (int*)(F.ws + WS_TILEE);
        for (int t = F.tid; t < 264; t += NTHREADS) { int e = 0;
#pragma unroll
            for (int q = 1; q < 8; ++q) if (t * 256 >= base[q]) e = q;
            te[t] = e; }
        if (F.tid == 0) te[264] = ntiles; }
    const unsigned char* H2 = F.ws + WS1_H2; unsigned char* XS = F.ws + WS1_XS; TokRec* TR = (TokRec*)(F.ws + WS_TOKREC);
    const unsigned* wgb = (const unsigned*)(F.ws + WS_WGBASE) + blockIdx.x * 64; const int lane = F.lane;
    for (int row = F.gw; row < NR; row += F.NGW) {
        int b, j; row_decode(row, b, j); if (j < CTXL) continue;
        TokRec* tr = TR + (b * SEQ + (j - CTXL)); const int e0 = tr->e0, e1 = tr->e1;
        int s0 = 0, s1 = 0;
#pragma unroll
        for (int e = 0; e < 8; ++e) { if (e == e0) s0 = base[e] + (int)wgb[e] + tr->p0; if (e == e1) s1 = base[e] + (int)wgb[e] + tr->p1; }
        const u32x4 a = ((const u32x4*)(H2 + (size_t)row * DM))[lane];
        ((u32x4*)(XS + (size_t)s0 * DM))[lane] = a; ((u32x4*)(XS + (size_t)s1 * DM))[lane] = a;
        if (lane == 0) { tr->s0 = s0; tr->s1 = s1; }
    }
    if (blockIdx.x < 8) { const int e = blockIdx.x, lo = base[e] + cnt[e], hi = base[e] + ((cnt[e] + 255) & ~255);
        for (int s = lo + F.wave; s < hi; s += NWAVES) { ((u32x4*)(XS + (size_t)s * DM))[lane] = (u32x4){0u, 0u, 0u, 0u}; } }
}
__device__ __forceinline__ void p23_combine(const Frame& F) {
    const bf16* YS = (const bf16*)(F.ws + WS1_YS); const TokRec* TR = (const TokRec*)(F.ws + WS_TOKREC); const float* gain = F.in[I_GAINS] + 7 * 1024; const int lane = F.lane;
    u32x2 w0[4], w1[4], w0n[4], w1n[4], xw[4], xwn[4]; f32x4 x[4], vg[4], vgt[4]; int cur = -1; load_vec(gain, lane, vg); float g0 = 0.f, g1 = 0.f, g0n = 0.f, g1n = 0.f;
    int row = F.gw; { while (row < NR) { int b, j; row_decode(row, b, j); if (j >= CTXL) break; row += F.NGW; } }
    if (row < NR) { int b, j; row_decode(row, b, j); const TokRec tr = TR[b * SEQ + (j - CTXL)]; g0 = tr.g0; g1 = tr.g1;
        load_row_raw(YS + (size_t)tr.s0 * DM, lane, w0); load_row_raw(YS + (size_t)tr.s1 * DM, lane, w1); load_row_raw(res_row(F, row), lane, xw); }
    while (row < NR) {
        int nrow = row + F.NGW; { while (nrow < NR) { int b, j; row_decode(nrow, b, j); if (j >= CTXL) break; nrow += F.NGW; } }
        if (nrow < NR) { int b, j; row_decode(nrow, b, j); const TokRec tr = TR[b * SEQ + (j - CTXL)]; g0n = tr.g0; g1n = tr.g1;
            load_row_raw(YS + (size_t)tr.s0 * DM, lane, w0n); load_row_raw(YS + (size_t)tr.s1 * DM, lane, w1n); load_row_raw(res_row(F, nrow), lane, xwn); }
        f32x4 y0[4], y1[4]; cvt_row(w0, y0); cvt_row(w1, y1); cvt_row(xw, x); float* xr = out_row(F, row);
#pragma unroll
        for (int q = 0; q < 4; ++q) y0[q] = y0[q] * g0 + y1[q] * g1;
        { const int who = row_who(row); if (who != cur) { cur = who; load_vec(mod_vec(F, 1, row, 5), lane, vgt); } }
        const float rstd = row_rstd(y0);
#pragma unroll
        for (int q = 0; q < 4; ++q) { const int idx = lane + 64 * q; *((f32x4*)xr + idx) = x[q] + vgt[q] * (y0[q] * rstd * vg[q]); }
#pragma unroll
        for (int q = 0; q < 4; ++q) { w0[q] = w0n[q]; w1[q] = w1n[q]; xw[q] = xwn[q]; }
        g0 = g0n; g1 = g1n; row = nrow;
    }
}
}

__device__ __forceinline__ int opaque(int v) { asm volatile("" : "+s"(v)); return v; }
__device__ __forceinline__ void convert_v(const Frame& F) {
    const bf16* V = (const bf16*)(F.ws + WS_V); char* VT = (char*)(F.ws + WS_KV8) + 64 * 208;
    for (int item = F.gw; item < 8 * (NT / 64); item += F.NGW) {
        const unsigned* src = (const unsigned*)(V + (size_t)item * 64 * 128) + F.lane;
        unsigned v[64];
#pragma unroll
        for (int k = 0; k < 64; ++k) v[k] = src[k * 64];
        u32x4 lo[4], hi4[4];
#pragma unroll
        for (int w = 0; w < 16; ++w) { const int k0 = 32 * ((w >> 2) & 1) + 8 * (w & 3) + 4 * (w >> 3);
            const unsigned a = att::pk4f8(__uint_as_float(v[k0] << 16), __uint_as_float(v[k0 + 1] << 16), __uint_as_float(v[k0 + 2] << 16), __uint_as_float(v[k0 + 3] << 16));
            const unsigned b = att::pk4f8(__uint_as_float(v[k0] & 0xffff0000u), __uint_as_float(v[k0 + 1] & 0xffff0000u), __uint_as_float(v[k0 + 2] & 0xffff0000u), __uint_as_float(v[k0 + 3] & 0xffff0000u));
            if ((w & 3) == 0) { lo[w >> 2].x = a; hi4[w >> 2].x = b; } else if ((w & 3) == 1) { lo[w >> 2].y = a; hi4[w >> 2].y = b; } else if ((w & 3) == 2) { lo[w >> 2].z = a; hi4[w >> 2].z = b; } else { lo[w >> 2].w = a; hi4[w >> 2].w = b; } }
        u32x4* dst = (u32x4*)(VT + (size_t)item * 23552 + F.lane * 160);
#pragma unroll
        for (int q = 0; q < 4; ++q) { dst[q] = lo[q]; dst[5 + q] = hi4[q]; }
    }
}
__device__ __forceinline__ void convert_k(const Frame& F) {
    const bf16* KN = (const bf16*)(F.ws + WS_KN); const bf16* KR = (const bf16*)(F.ws + WS_KR); char* K8 = (char*)(F.ws + WS_KV8);
    for (int item = F.gw; item < 8 * (NT / 64); item += F.NGW) {
        const int bh = item / (NT / 64), key = (item - bh * (NT / 64)) * 64 + F.lane;
        const bf16x8* sn = (const bf16x8*)(KN + ((size_t)bh * NT + key) * 128); const bf16x8* sr = (const bf16x8*)(KR + ((size_t)(bh >> 2) * NT + key) * 64);
        bf16x8 c[24];
#pragma unroll
        for (int i = 0; i < 16; ++i) c[i] = sn[i];
#pragma unroll
        for (int i = 0; i < 8; ++i) c[16 + i] = sr[i];
        u32x4* dst = (u32x4*)(K8 + (size_t)item * 23552 + F.lane * 208);
#pragma unroll
        for (int g = 0; g < 3; ++g)
#pragma unroll
            for (int u = 0; u < 4; ++u) {
                const int u0 = 2 * u, u1 = 2 * u + 1; const u32x2 x = att::bf8_to_f8(c[8 * g + 2 * (u0 & 3) + (u0 >> 2)]), y = att::bf8_to_f8(c[8 * g + 2 * (u1 & 3) + (u1 >> 2)]);
                dst[4 * g + u] = (u32x4){x.x, x.y, y.x, y.y}; }
    }
}
__global__ void __launch_bounds__(NTHREADS, 2) fwd_kernel(Args args) {
    extern __shared__ __attribute__((aligned(16))) unsigned char lds_raw[];
    Frame F;
    F.lds = (LAS unsigned char*)lds_raw; F.tid = threadIdx.x; asm volatile("" : "+v"(F.tid));     F.lane = F.tid & 63; F.wave = __builtin_amdgcn_readfirstlane(F.tid >> 6);
    F.G = gridDim.x; F.gw = blockIdx.x * NWAVES + F.wave; F.NGW = F.G * NWAVES; F.in = args.in; F.out = args.out; F.ws = args.ws;
    volatile LAS unsigned* MISC = (volatile LAS unsigned*)(F.lds + MISC_OFF);
    for (int u = F.tid; u < (LDS_BYTES - RING_BYTES) / 4; u += NTHREADS) ((LAS unsigned*)(F.lds + RING_BYTES))[u] = 0u;
    __syncthreads();
    unsigned* ctl = (unsigned*)(F.ws + WS_CTL);
    XcdBarrier bar = xcd_barrier_post(ctl + CW_BAR, MISC + 8, F.tid);
    const int lo = args.ph_lo, hi = args.ph_hi;
#define IN(k) (lo <= (k) && (k) < hi)
#ifndef DUP_MASK
#define DUP_MASK 0u
#endif
#define REP(k) (1 + (int)(((unsigned)(DUP_MASK) >> (k)) & 1u))
#define LAUNDER() do { asm volatile("" : "+v"(F.tid), "+v"(F.lane)); } while (0)
#define SEAM(k) do { if (IN(k) && IN((k) + 1)) xcd_barrier(bar, F.tid); } while (0)

#if BAR_PROBE
    for (int i_ = 0; i_ < BAR_PROBE; ++i_) xcd_barrier(bar, F.tid);
#endif
    if (IN(0)) for (int rep_ = 0; rep_ < REP(0); ++rep_) { LAUNDER(); p0_prologue(F); } SEAM(0);
    if (IN(1)) for (int rep_ = 0; rep_ < REP(1); ++rep_) { LAUNDER(); p1_norm0(F); } SEAM(1);
    if (IN(2)) for (int rep_ = 0; rep_ < REP(2); ++rep_) { LAUNDER();
        pg8::Gemm g{(const bf16*)(F.ws + WS_H), (const bf16*)(F.ws + WS_W_INAB), opaque(1024 / 2), 0, (const float*)(F.ws + WS_SA), (const float*)(F.ws + WS_CTL) + CW_COLSC + 10752}; pg8::StaticOrder S; S.init(NR / 256, 2048 / 256, F.G, (int)blockIdx.x, 0);
        epi::InAB E{(bf16*)(F.ws + WS_P), (float*)(F.ws + WS_GATES)};
        pg8::gemm_phase<epi::InAB, pg8::StaticOrder, true, true, 2>(F.lds, g, S, E, F.tid);
    } SEAM(2);
    if (IN(3)) for (int rep_ = 0; rep_ < REP(3); ++rep_) { LAUNDER(); p3_prep(F); } SEAM(3);
    if (IN(4)) for (int rep_ = 0; rep_ < REP(4); ++rep_) { LAUNDER();
        pg8::Gemm g{(const bf16*)(F.ws + WS_A2), (const bf16*)(F.ws + WS_W_UP), opaque(384), 0}; pg8::StaticOrder S; S.init(NR / 256, 1792 / 256, F.G, (int)blockIdx.x, 0);
        epi::UpProj E{F.ws};
        pg8::gemm_phase<epi::UpProj, pg8::StaticOrder, true, true>(F.lds, g, S, E, F.tid);
    } if (IN(4)) xcd_barrier(bar, F.tid);
    if (IN(4)) { LAUNDER(); convert_v(F); LAUNDER(); convert_k(F); } SEAM(4);
    if (IN(5)) for (int rep_ = 0; rep_ < REP(5); ++rep_) { LAUNDER();
        const bf16* Q = (const bf16*)(F.ws + WS_Q); const bf16* KN = (const bf16*)(F.ws + WS_KN); const bf16* KR = (const bf16*)(F.ws + WS_KR); const char* KV = (const char*)(F.ws + WS_KV8);
        bf16* CAT = (bf16*)(F.ws + WS_CAT); const float* rope = (const float*)(F.ws + WS_ROPE);
#if !MLSTM_STUB
        ml::pass_b(F);
#endif
        const int c = blockIdx.x, bh = c & 7, b = bh >> 2, h = bh & 3;
        const int cslot = (c >> 3) & 1;
        if (cslot == 0) moe::convert_expert_weights(F);
        for (int i = 0; i < 3; ++i) {
            int j0, seq, rt0;
            if (i < 2) { const int qb = (c >> 3) + 32 * i; if (qb >= 64) continue; j0 = CTXL + qb * 256; seq = NT; rt0 = qb * 256; }
            else { if ((c >> 3) != 0) continue; j0 = 0; seq = CTXL; rt0 = -1; }
            att::attn_unit(Q + ((size_t)bh * NT + j0) * 192, KV + (size_t)bh * (NT / 64) * 23552  ,
                           CAT + ((size_t)b * NT + j0) * DM + h * 128, seq, rt0, rope, (char*)lds_raw, F.tid);
        }
        if (cslot == 1) moe::convert_expert_weights(F);
        __syncthreads();
#if MLSTM_STUB
        for (int row = F.gw; row < NR; row += F.NGW) { *((u32x4*)((bf16*)CAT + (size_t)row * DM + 512) + F.lane) = (u32x4){0u, 0u, 0u, 0u}; }
#endif
    } SEAM(5);
#if !MLSTM_STUB
    if (IN(7)) for (int rep_ = 0; rep_ < REP(7); ++rep_) { LAUNDER(); ml::pass_c(F); } SEAM(7);
    if (IN(8)) for (int rep_ = 0; rep_ < REP(8); ++rep_) { LAUNDER(); ml::pass_d(F); } SEAM(8);
#endif
    if (IN(9)) for (int rep_ = 0; rep_ < REP(9); ++rep_) { LAUNDER();
        pg8::Gemm g{(const bf16*)(F.ws + WS_CAT), (const bf16*)(F.ws + WS_W_OUTAB), opaque(1024), 0}; pg8::StaticOrder S; S.init(128, 4, F.G, (int)blockIdx.x, 1);
        epi::Bf16 E{(bf16*)(F.ws + WS_Y), DM};
        pg8::gemm_phase<epi::Bf16, pg8::StaticOrder, true, true>(F.lds, g, S, E, F.tid);
    } SEAM(9);
    if (IN(10)) for (int rep_ = 0; rep_ < REP(10); ++rep_) { LAUNDER();
        if (blockIdx.x < 8) { pg8::Gemm g{(const bf16*)(F.ws + WS_CAT), (const bf16*)(F.ws + WS_W_OUTAB), opaque(1024), 0}; pg8::CtxOrder S{(int)blockIdx.x}; epi::Bf16 E{(bf16*)(F.ws + WS_Y), DM};
            pg8::gemm_phase<epi::Bf16, pg8::CtxOrder, true, true>(F.lds, g, S, E, F.tid); }
        else resnorm_rows<true, true>(F, (const bf16*)(F.ws + WS_Y), 0, 2, F.in[I_GAINS] + 1 * 1024, 0, 3, F.in[I_GAINS] + 2 * 1024, (bf16*)(F.ws + WS_H), 1, F.gw - 8 * NWAVES, F.NGW - 8 * NWAVES);
    } if (IN(10)) xcd_barrier(bar, F.tid);
    if (IN(10)) { LAUNDER(); resnorm_rows<true, true>(F, (const bf16*)(F.ws + WS_Y), 0, 2, F.in[I_GAINS] + 1 * 1024, 0, 3, F.in[I_GAINS] + 2 * 1024, (bf16*)(F.ws + WS_H), 2, F.gw, F.NGW); } SEAM(10);
    if (IN(11)) for (int rep_ = 0; rep_ < REP(11); ++rep_) { LAUNDER();
        pg8::Gemm g{(const bf16*)(F.ws + WS_H), (const bf16*)(F.ws + WS_W_GU), opaque(1024 / 2), 0, (const float*)(F.ws + WS_SA), (const float*)(F.ws + WS_CTL) + CW_COLSC + 0}; pg8::StaticOrder S; S.init(NR / 256, 2 * DFF / 256, F.G, (int)blockIdx.x, 0);
        epi::SwiGLUf8 E{F.ws + WS_HID, DFF, 1.f};
        pg8::gemm_phase<epi::SwiGLUf8, pg8::StaticOrder, true, true, 2>(F.lds, g, S, E, F.tid);
    } SEAM(11);
    if (IN(12)) for (int rep_ = 0; rep_ < REP(12); ++rep_) { LAUNDER();
        pg8::Gemm g{(const bf16*)(F.ws + WS_HID), (const bf16*)(F.ws + WS_W_DN), opaque(DFF / 2), 0}; pg8::StaticOrder S; S.init(128, 4, F.G, (int)blockIdx.x, 1);
        epi::Bf16 E{(bf16*)(F.ws + WS_Y), DM, 1.f / moe::DN_WSCALE};
        pg8::gemm_phase<epi::Bf16, pg8::StaticOrder, true, true, 1>(F.lds, g, S, E, F.tid);
    } SEAM(12);
    if (IN(13)) { LAUNDER();
        if (blockIdx.x < 8) { pg8::Gemm g{(const bf16*)(F.ws + WS_HID), (const bf16*)(F.ws + WS_W_DN), opaque(DFF / 2), 0}; pg8::CtxOrder S{(int)blockIdx.x}; epi::Bf16 E{(bf16*)(F.ws + WS_Y), DM, 1.f / moe::DN_WSCALE};
            pg8::gemm_phase<epi::Bf16, pg8::CtxOrder, true, true, 1>(F.lds, g, S, E, F.tid); }
        else resnorm_rows<false, true>(F, (const bf16*)(F.ws + WS_Y), 0, 5, F.in[I_GAINS] + 3 * 1024, 1, 0, F.in[I_GAINS] + 4 * 1024, (bf16*)(F.ws + WS1_H1), 1, F.gw - 8 * NWAVES, F.NGW - 8 * NWAVES);
    } if (IN(13)) xcd_barrier(bar, F.tid);
    if (IN(13)) { LAUNDER(); resnorm_rows<false, true>(F, (const bf16*)(F.ws + WS_Y), 0, 5, F.in[I_GAINS] + 3 * 1024, 1, 0, F.in[I_GAINS] + 4 * 1024, (bf16*)(F.ws + WS1_H1), 2, F.gw, F.NGW); } SEAM(13);
    if (IN(14)) for (int rep_ = 0; rep_ < REP(14); ++rep_) { LAUNDER();
        pg8::Gemm g{(const bf16*)(F.ws + WS1_H1), (const bf16*)(F.ws + WS_W_INC), opaque(1024 / 2), 0, (const float*)(F.ws + WS_SA), (const float*)(F.ws + WS_CTL) + CW_COLSC + 5632}; pg8::StaticOrder S; S.init(NR / 256, 5120 / 256, F.G, (int)blockIdx.x, 0);
        epi::InC E{(bf16*)(F.ws + WS1_PC), (const float*)(F.ws + WS_LB)};
        pg8::gemm_phase<epi::InC, pg8::StaticOrder, true, true, 2>(F.lds, g, S, E, F.tid);
    } SEAM(14);
    if (IN(15)) for (int rep_ = 0; rep_ < REP(15); ++rep_) { LAUNDER(); hg::pass_b(F); } SEAM(15);
    if (IN(16)) for (int rep_ = 0; rep_ < REP(16); ++rep_) { LAUNDER(); hg::pass_c(F); } SEAM(16);
    if (IN(17)) for (int rep_ = 0; rep_ < REP(17); ++rep_) { LAUNDER(); hg::pass_d(F); } SEAM(17);
    if (IN(18)) for (int rep_ = 0; rep_ < REP(18); ++rep_) { LAUNDER();
        pg8::Gemm g{(const bf16*)(F.ws + WS1_CAT), (const bf16*)(F.ws + WS_W_OUTC), opaque(1024), 0}; pg8::StaticOrder S; S.init(128, 4, F.G, (int)blockIdx.x, 1);
        epi::Bf16 E{(bf16*)(F.ws + WS1_Y), DM};
        pg8::gemm_phase<epi::Bf16, pg8::StaticOrder, true, true>(F.lds, g, S, E, F.tid);
    } SEAM(18);
    if (IN(19)) for (int rep_ = 0; rep_ < REP(19); ++rep_) { LAUNDER(); moe::p19_route(F); } SEAM(19);
    if (IN(20)) for (int rep_ = 0; rep_ < REP(20); ++rep_) { LAUNDER(); moe::p20_gather(F); } SEAM(20);
    if (IN(21)) for (int rep_ = 0; rep_ < REP(21); ++rep_) { LAUNDER();
        const int* te = (const int*)(F.ws + moe::WS_TILEE); const int ntiles = te[264];
        pg8::Gemm g{(const bf16*)(F.ws + WS1_XS), (const bf16*)((const unsigned char*)F.out + moe::MWGU_OFF), opaque(1024 / 2), moe::GU_SLAB}; pg8::GroupedOrder S; S.init(ntiles, 2 * DFF / 256, F.G, (int)blockIdx.x, te);
        epi::SwiGLUf8 E{F.ws + WS1_MHID, DFF, 1.f / moe::GU_WSCALE};
        pg8::gemm_phase<epi::SwiGLUf8, pg8::GroupedOrder, true, true, true>(F.lds, g, S, E, F.tid);
    } SEAM(21);
    if (IN(22)) for (int rep_ = 0; rep_ < REP(22); ++rep_) { LAUNDER();
        const int* te = (const int*)(F.ws + moe::WS_TILEE); const int ntiles = te[264];
        pg8::Gemm g{(const bf16*)(F.ws + WS1_MHID), (const bf16*)((const unsigned char*)F.out + moe::MWDN_OFF), opaque(DFF / 2), moe::DN_SLAB}; pg8::GroupedOrder S; S.init(ntiles, 4, F.G, (int)blockIdx.x, te);
        epi::Bf16 E{(bf16*)(F.ws + WS1_YS), DM, 1.f / moe::DN_WSCALE};
        pg8::gemm_phase<epi::Bf16, pg8::GroupedOrder, true, true, true>(F.lds, g, S, E, F.tid);
    } SEAM(22);
    if (IN(23)) for (int rep_ = 0; rep_ < REP(23); ++rep_) { LAUNDER(); moe::p23_combine(F); }
#undef IN
#undef SEAM
}

extern "C" void kernel_launch(void* const* d_in, const int* in_sizes, int n_in, void* d_out, int out_size, void* d_ws, size_t ws_size, hipStream_t stream) {
    static int grid = 0;
    if (grid == 0) {
        if (n_in != N_IN || out_size != NB * SEQ * DM || ws_size < WS_END) { fprintf(stderr, "kernel_launch: unexpected shapes: n_in %d out %d ws %zu (need %zu)\n", n_in, out_size, ws_size, (size_t)WS_END); grid = -1; return; }
        int dev = 0, cus = 0, per_cu = 0;
        if (hipGetDevice(&dev) != hipSuccess || hipDeviceGetAttribute(&cus, hipDeviceAttributeMultiprocessorCount, dev) != hipSuccess) { grid = -1; return; }
        if (hipFuncSetAttribute((const void*)fwd_kernel, hipFuncAttributeMaxDynamicSharedMemorySize, LDS_BYTES) != hipSuccess) { fprintf(stderr, "kernel_launch: hipFuncSetAttribute failed\n"); grid = -1; return; }
        if (hipOccupancyMaxActiveBlocksPerMultiprocessor(&per_cu, (const void*)fwd_kernel, NTHREADS, LDS_BYTES) != hipSuccess || per_cu < 1) { fprintf(stderr, "kernel_launch: occupancy query reports %d\n", per_cu); }
        (void)hipGetLastError();
        grid = cus;
    }
    if (grid < 0) return;
    if (hipMemsetAsync((char*)d_ws + WS_CTL, 0, CTL_ZERO_BYTES, stream) != hipSuccess) return;
    Args a{};
    for (int i = 0; i < N_IN; ++i) a.in[i] = (const float*)d_in[i];
    a.out = (float*)d_out; a.ws = (unsigned char*)d_ws;
#if N_LAUNCHES == 1
    a.ph_lo = 0; a.ph_hi = 64;
    hipLaunchKernelGGL(fwd_kernel, dim3(grid), dim3(NTHREADS), LDS_BYTES, stream, a);
#else
    for (int p = 0; p < 64; ++p) { a.ph_lo = p; a.ph_hi = p + 1; hipLaunchKernelGGL(fwd_kernel, dim3(grid), dim3(NTHREADS), LDS_BYTES, stream, a); }
#endif
}
```

```cpp
#define MLSTM_STUB 0
#define N_LAUNCHES 1
#define BAR_PROBE 0
#include <hip/hip_runtime.h>
#include <cstdio>
#include <cstdint>

#define GAS __attribute__((address_space(1)))
#define LAS __attribute__((address_space(3)))
typedef unsigned short bf16;
typedef short bf16x8 __attribute__((ext_vector_type(8)));
typedef short s16x4 __attribute__((ext_vector_type(4)));
typedef float f32x4 __attribute__((ext_vector_type(4)));
typedef float f32x16 __attribute__((ext_vector_type(16)));
typedef unsigned u32x4 __attribute__((ext_vector_type(4)));
typedef unsigned u32x2 __attribute__((ext_vector_type(2)));

constexpr int DM = 1024, NB = 2, SEQ = 16384, CTXL = 256, NT = SEQ + CTXL  , NR = NB * NT  ;
constexpr int NGRP = NT / 256;
constexpr int NH = 4;
constexpr int P_LD = 2048;
constexpr int DFF = 2816, NEXP = 8;
constexpr float RMS_EPS = 1e-6f;
constexpr int NWAVES = 8, NTHREADS = 512;

enum { I_X = 0, I_C, I_CTX, I_CCTX, I_WMOD, I_BMOD, I_GAINS, I_WINAB, I_QGAIN, I_WUQ, I_KVGAIN, I_WUKV, I_CONVW, I_CONVB, I_GATEB, I_MLGAIN, I_WOUTAB,
       I_FFNGU, I_FFNDN, I_WINC, I_LBLOG, I_HGGAIN, I_WOUTC, I_ROUTER, I_MOEGU, I_MOEDN, N_IN };

constexpr size_t MiB = 1u << 20;
constexpr size_t WS_CTL = 0, CTL_ZERO_BYTES = 1 * MiB;
constexpr size_t WS_MOD = 1 * MiB;
constexpr size_t WS_LB = WS_MOD + 160 * 1024;
constexpr size_t WS_ROPE = WS_MOD + 192 * 1024;
constexpr size_t WS_WGBASE = WS_MOD + 256 * 1024;
constexpr size_t WS_TOKREC = 2 * MiB;
constexpr size_t WS_SA = 5 * MiB;
constexpr size_t WS_W_INAB = 8 * MiB, WS_W_UP = 12 * MiB, WS_W_OUTAB = 14 * MiB, WS_W_GU = 16 * MiB, WS_W_DN = 27 * MiB, WS_W_INC = 33 * MiB, WS_W_OUTC = 43 * MiB;
constexpr size_t WS_D = 46 * MiB;
constexpr size_t WS_H = WS_D + 0 * MiB;
constexpr size_t WS_P = WS_D + 65 * MiB;
constexpr size_t WS_A2 = WS_D + 195 * MiB;
constexpr size_t WS_QKP = WS_D + 220 * MiB;
constexpr size_t WS_GATES = WS_D + 253 * MiB;
constexpr size_t WS_GL = WS_D + 255 * MiB + 512 * 1024;
constexpr size_t WS_Q = WS_D + 258 * MiB;
constexpr size_t WS_KN = WS_D + 307 * MiB;
constexpr size_t WS_KR = WS_D + 340 * MiB;
constexpr size_t WS_V = WS_D + 345 * MiB;
constexpr size_t WS_CAT = WS_D + 378 * MiB;
constexpr size_t WS_Y = WS_D + 443 * MiB;
constexpr size_t WS_VT8 = WS_D + 443 * MiB;
constexpr size_t WS_KV8 = WS_D + 443 * MiB;
constexpr size_t WS_K8 = WS_KV8;
constexpr size_t WS_MLU = WS_D + 508 * MiB;
constexpr size_t WS_MLS = WS_D + 542 * MiB;
constexpr size_t WS_HID = WS_D + 65 * MiB;
constexpr size_t WS1_Y = WS_D + 0 * MiB, WS1_H1 = WS_D + 0 * MiB, WS1_CAT = WS_D + 65 * MiB, WS1_H2 = WS_D + 65 * MiB, WS1_PC = WS_D + 130 * MiB, WS1_S = WS_D + 455 * MiB, WS1_U = WS_D + 0 * MiB  ;
constexpr size_t WS1_MHID = WS_D + 0 * MiB  , WS_RES = WS_D + 560 * MiB  , WS1_XS = WS_D + 430 * MiB  , WS1_YS = WS_D + 183 * MiB  ;
constexpr size_t WS_END = WS_D + 651 * MiB;
static_assert(WS_HID + (size_t)NR * DFF * 2 <= WS_Q, "HID overlay");
static_assert(WS1_YS + (size_t)67584 * 2048 <= WS1_XS && WS1_U + (size_t)32 * 65 * 65536 <= WS1_PC && WS1_XS + (size_t)67584 * 1024 <= WS_RES && WS_RES + 66 * MiB <= WS_END && WS1_MHID + (size_t)67584 * 2816 <= WS1_YS && WS_MLS + 18 * MiB <= WS_RES, "ws map");

constexpr int CW_BAR = 4096;
constexpr int CW_MOECNT = 8192;
constexpr size_t WS_CMAXP = 6 * MiB;
constexpr int CW_COLSC = 32768;

constexpr int RING_BYTES = 131072;
constexpr int MISC_OFF = 147456 - 256;
constexpr int LDS_BYTES = 147456;

#define LDS_WAIT() asm volatile("s_waitcnt lgkmcnt(0)" ::: "memory")
#define VM_WAIT() asm volatile("s_waitcnt vmcnt(0)" ::: "memory")
__device__ __forceinline__ float bf2f(unsigned h) { return __uint_as_float(h << 16); }
typedef __bf16 bf16x2_n __attribute__((ext_vector_type(2)));
typedef float f32x2_n __attribute__((ext_vector_type(2)));
__device__ __forceinline__ unsigned pk2(float lo, float hi) { const f32x2_n v = {lo, hi}; const bf16x2_n b = __builtin_convertvector(v, bf16x2_n); return __builtin_bit_cast(unsigned, b); }
__device__ __forceinline__ unsigned f2bf(float f) { return pk2(f, f) & 0xffffu; }
__device__ __forceinline__ float wave_sum(float v) {
#pragma unroll
    for (int o = 1; o < 64; o <<= 1) v += __shfl_xor(v, o);
    return v;
}
__device__ __forceinline__ float sigm(float x) { return __builtin_amdgcn_rcpf(1.f + __expf(-x)); }
__device__ __forceinline__ float siluf(float x) { return x * __builtin_amdgcn_rcpf(1.f + __expf(-x)); }
__device__ __forceinline__ float logsig(float x) { return fminf(x, 0.f) - log1pf(__expf(-fabsf(x))); }

#define XB_TMO      128
#define XB_XCNT(j)  (256  + 64 * (j))
#define XB_XSUB(j)  (1280 + 64 * (j))
#define XB_XGEN(j)  (2304 + 64 * (j))
#define XB_TOP      3328
#define XB_TOPGEN   3392
#define XCD_BAR_WORDS 3456
#define XB_SPIN_CAP (1u << 18)
__device__ __forceinline__ unsigned xb_ld(unsigned* p)              { return __hip_atomic_load(p, __ATOMIC_RELAXED, __HIP_MEMORY_SCOPE_AGENT); }
__device__ __forceinline__ unsigned xb_add(unsigned* p, unsigned v) { return __hip_atomic_fetch_add(p, v, __ATOMIC_RELAXED, __HIP_MEMORY_SCOPE_AGENT); }
__device__ __forceinline__ unsigned xb_xcc_id() { return (unsigned)__builtin_amdgcn_s_getreg((3 << 11) | 20) & 0xFu; }
#define XB_SPIN(cond, bar) do { unsigned _sp = 0; while (cond) { __builtin_amdgcn_s_sleep(1); \
    if ((++_sp & 255u) == 0u) { if (xb_ld(&(bar)[XB_TMO])) break; if (_sp > XB_SPIN_CAP) { atomicAdd(&(bar)[XB_TMO], 1u); break; } } } } while (0)
struct XcdBarrier { unsigned* bar; unsigned x; volatile LAS unsigned* st; };
__device__ __forceinline__ XcdBarrier xcd_barrier_post(unsigned* bar, volatile LAS unsigned* st, const int tid) {
    XcdBarrier b; b.bar = bar; b.x = xb_xcc_id(); b.st = st;
    if (tid == 0) (void)xb_add(&bar[XB_XCNT(b.x)], 1u);
    return b;
}
__device__ __forceinline__ void xcd_barrier_complete(unsigned* bar, unsigned x, unsigned& nloc, unsigned& nx) {
    const unsigned G = gridDim.x * gridDim.y * gridDim.z;
    unsigned sum, cnt, mine, sp = 0u;
    for (;;) {
        sum = 0u; cnt = 0u; mine = 0u;
#pragma unroll
        for (unsigned j = 0; j < 16; ++j) { const unsigned c = xb_ld(&bar[XB_XCNT(j)]); sum += c; cnt += (c > 0u) ? 1u : 0u; mine = (j == x) ? c : mine; }
        if (sum == G) break;
        __builtin_amdgcn_s_sleep(1);
        if ((++sp & 255u) == 0u) { if (xb_ld(&bar[XB_TMO])) break; if (sp > XB_SPIN_CAP) { atomicAdd(&bar[XB_TMO], 1u); break; } }
    }
    nloc = mine > 0u ? mine : 1u; nx = cnt > 0u ? cnt : 1u;
}
__device__ __forceinline__ void xcd_barrier(const XcdBarrier& b, const int tid) {
    asm volatile("s_waitcnt vmcnt(0)" ::: "memory");
    __syncthreads();
    if (tid == 0) {
        unsigned* bar = b.bar;
        __builtin_amdgcn_s_waitcnt(0);
        unsigned nloc = b.st[0], nx = b.st[1];
        if (nloc == 0u) { xcd_barrier_complete(bar, b.x, nloc, nx); b.st[0] = nloc; b.st[1] = nx; }
        const unsigned old = xb_add(&bar[XB_XSUB(b.x)], 1u);
        const unsigned gen = old / nloc;
        if (old + 1u == (gen + 1u) * nloc) {
            __builtin_amdgcn_fence(__ATOMIC_RELEASE, "agent");
            asm volatile("s_waitcnt vmcnt(0)" ::: "memory");
            const unsigned og = xb_add(&bar[XB_TOP], 1u);
            const unsigned tg = og / nx;
            if (og + 1u == (tg + 1u) * nx) xb_add(&bar[XB_TOPGEN], 1u);
            else XB_SPIN(xb_ld(&bar[XB_TOPGEN]) == tg, bar);
            __builtin_amdgcn_fence(__ATOMIC_ACQUIRE, "agent");
            xb_add(&bar[XB_XGEN(b.x)], 1u);
            asm volatile("s_waitcnt vmcnt(0)" ::: "memory");
        } else {
            XB_SPIN(xb_ld(&bar[XB_XGEN(b.x)]) == gen, bar);
            __builtin_amdgcn_fence(__ATOMIC_ACQUIRE, "agent");
            asm volatile("s_waitcnt vmcnt(0)" ::: "memory");
        }
    }
    __syncthreads();
}

namespace pg8 {
#define PG8_LAS __attribute__((address_space(3)))
typedef unsigned short bf16_t;
constexpr int BM = 256, BK = 64, HALF = 128, HTB = HALF * BK * 2, STAGE_BYTES = 8 * HTB, NXCD = 8, WGM = 8;
__host__ __device__ __forceinline__ int lds_byte(int r, int c) { const int st = (r >> 4) * 2 + (c >> 5), rr = r & 15, cc = c & 31, ob = rr * 64 + cc * 2; return st * 1024 + (ob ^ (((ob >> 9) & 1) << 5)); }
__host__ __device__ __forceinline__ void stage_rc(int b, int& R, int& C) { const int st = b / 1024, sb = b % 1024, swz = sb ^ (((sb >> 9) & 1) << 5); R = (st >> 1) * 16 + swz / 64; C = (st & 1) * 32 + (swz % 64) / 2; }
__host__ __device__ __forceinline__ int perm32(int rho) { const int n = rho >> 4, i = rho & 15; return 8 * (i >> 2) + 4 * n + (i & 3); }
struct Unit { int pm, pn, eb; };
struct Gemm { const bf16_t* A; const bf16_t* Bt; int K; size_t estride; const float* sa = nullptr; const float* sw = nullptr; };
__device__ __forceinline__ unsigned cvt_pk_bf16(float lo, float hi) { unsigned r; asm volatile("v_cvt_pk_bf16_f32 %0, %1, %2" : "=v"(r) : "v"(lo), "v"(hi)); return r; }

struct StaticOrder {
    int nM, nN, nwg, G, c, lat_only;
    __device__ void init(int nM_, int nN_, int G_, int c_, int lat_only_) { nM = nM_; nN = nN_; nwg = nM * nN; G = G_; c = c_; lat_only = lat_only_; }
    __device__ bool next(int i, Unit& u) const {
        const long L = (long)i * G + c; if (L >= nwg) return false;
        int wgid = (int)L; { const int q = nwg / NXCD, r = nwg % NXCD, xcd = wgid % NXCD, off = wgid / NXCD; wgid = (xcd < r ? xcd * (q + 1) : r * (q + 1) + (xcd - r) * q) + off; }
        const int nig = WGM * nN, gid = wgid / nig, fm = gid * WGM, gsz = (nM - fm) < WGM ? (nM - fm) : WGM;
        int pm = fm + ((wgid % nig) % gsz); u.pn = (wgid % nig) / gsz; u.eb = 0;
        if (lat_only) pm = pm + 1 + (pm >= 64 ? 1 : 0);
        u.pm = pm; return true;
    }
    __device__ __forceinline__ void a_ready(const Unit&) const {}
    __device__ __forceinline__ void done(const Unit&) const {}
};
struct CtxOrder {
    int c;
    __device__ bool next(int i, Unit& u) const { if (i != 0 || c >= 8) return false; u.pm = (c >> 2) ? 65 : 0; u.pn = c & 3; u.eb = 0; return true; }
    __device__ __forceinline__ void a_ready(const Unit&) const {}
    __device__ __forceinline__ void done(const Unit&) const {}
};
struct GroupedOrder {
    int nM, nN, nwg, G, c; const int* tile_e;
    __device__ void init(int nM_, int nN_, int G_, int c_, const int* te) { nM = nM_; nN = nN_; nwg = nM * nN; G = G_; c = c_; tile_e = te; }
    __device__ bool next(int i, Unit& u) const {
        const long L = (long)i * G + c; if (L >= nwg) return false;
        int wgid = (int)L; { const int q = nwg / NXCD, r = nwg % NXCD, xcd = wgid % NXCD, off = wgid / NXCD; wgid = (xcd < r ? xcd * (q + 1) : r * (q + 1) + (xcd - r) * q) + off; }
        const int nig = WGM * nN, gid = wgid / nig, fm = gid * WGM, gsz = (nM - fm) < WGM ? (nM - fm) : WGM;
        u.pm = fm + ((wgid % nig) % gsz); u.pn = (wgid % nig) / gsz; u.eb = tile_e[u.pm]; return true;
    }
    __device__ __forceinline__ void a_ready(const Unit&) const {}
    __device__ __forceinline__ void done(const Unit&) const {}
};
typedef int pg8_v4i __attribute__((ext_vector_type(4))); typedef int pg8_v8i __attribute__((ext_vector_type(8)));
template <bool F8> struct pg8_frag;
template <> struct pg8_frag<false> { ::bf16x8 v[2]; };
template <> struct pg8_frag<true> { pg8_v8i w; };
__device__ __forceinline__ void pg8_put(pg8_v8i& w, ::bf16x8 t, int k) { const pg8_v4i a = __builtin_bit_cast(pg8_v4i, t); if (k == 0) { w[0] = a[0]; w[1] = a[1]; w[2] = a[2]; w[3] = a[3]; } else { w[4] = a[0]; w[5] = a[1]; w[6] = a[2]; w[7] = a[3]; } }
template <class Epi, class Sched, bool ALIGN_EPI = false, bool SP2 = false, int FP8 = 0>
__device__ __forceinline__ void gemm_phase(PG8_LAS unsigned char* lds, const Gemm g, const Sched& S, const Epi& E, const int tid_in) {
    const int tid = tid_in, wid = __builtin_amdgcn_readfirstlane(tid >> 6), lane = tid & 63, wr = wid >> 2, wc = wid & 3, fr = lane & 15, fq = lane >> 4;
    const int K = g.K, nt = K / BK;
    unsigned voffA[2], voffB[2];
#pragma unroll
    for (int i = 0; i < 2; ++i) { int R, C; stage_rc(tid * 16 + i * 8192, R, C); const int Rb = Epi::PERM ? ((R & ~31) + perm32(R & 31)) : R;
        voffA[i] = (unsigned)(R * K + C) * 2u; voffB[i] = (unsigned)(Rb * K + C) * 2u; }
    const size_t kstep = (size_t)(BK * 2);
    const size_t hstep = (size_t)HALF * K * 2;
    const size_t tstep = 2 * hstep;
    const unsigned ldsw = (unsigned)wid * 1024u;
    const int aoff = lds_byte(wr * 64 + fr, fq * 8), boff = lds_byte(wc * 32 + fr, fq * 8);
#define PG8_SA(b, h) (((b) * 2 + (h)) * HTB)
#define PG8_SB(b, h) ((4 + (b) * 2 + (h)) * HTB)
#define PG8_STAGE(bufoff, gbase, voff) do { _Pragma("unroll") for (int _i = 0; _i < 2; ++_i) \
        __builtin_amdgcn_global_load_lds((const unsigned*)((const char*)(gbase) + (voff)[_i]), (PG8_LAS unsigned*)(lds + (bufoff) + ldsw + _i * 8192), 16, 0, 0); } while (0)
#define PG8_LDA(dst, b, h) do { _Pragma("unroll") for (int m = 0; m < 4; ++m) _Pragma("unroll") for (int k = 0; k < 2; ++k) { const ::bf16x8 t_ = *(const PG8_LAS ::bf16x8*)(lds + PG8_SA(b, h) + aoff + m * 2048 + k * 1024); if constexpr (FP8 == 1) pg8_put(dst[m].w, t_, k); else dst[m].v[k] = t_; } } while (0)
#define PG8_LDB(dst, b, h) do { _Pragma("unroll") for (int n = 0; n < 2; ++n) _Pragma("unroll") for (int k = 0; k < 2; ++k) { const ::bf16x8 t_ = *(const PG8_LAS ::bf16x8*)(lds + PG8_SB(b, h) + boff + n * 2048 + k * 1024); if constexpr (FP8 == 1) pg8_put(dst[n].w, t_, k); else dst[n].v[k] = t_; } } while (0)
#define PG8_MMA(ai, bj, At, Bt) do { __builtin_amdgcn_s_setprio(1); _Pragma("unroll") for (int m = 0; m < 4; ++m) _Pragma("unroll") for (int n = 0; n < 2; ++n) _Pragma("unroll") for (int k = 0; k < 2; ++k) \
        { if constexpr (FP8 == 1) { if (k == 0) asm volatile("v_mfma_f32_16x16x128_f8f6f4 %0, %1, %2, %0" : "+v"(acc[ai][bj][m][n]) : "v"(Bt[n].w), "v"(At[m].w)); }     \
          else if constexpr (FP8 == 2) asm volatile("v_mfma_i32_16x16x64_i8 %0, %1, %2, %0" : "+v"(acc[ai][bj][m][n]) : "v"(Bt[n].v[k]), "v"(At[m].v[k])); \
          else acc[ai][bj][m][n] = __builtin_amdgcn_mfma_f32_16x16x32_bf16(Bt[n].v[k], At[m].v[k], acc[ai][bj][m][n], 0, 0, 0); } __builtin_amdgcn_s_setprio(0); } while (0)
#define PG8_WAIT_V(n) asm volatile("s_waitcnt vmcnt(" #n ")" ::: "memory")
#define PG8_WAIT_L(n) asm volatile("s_waitcnt lgkmcnt(" #n ")" ::: "memory")
#define PG8_BAR __builtin_amdgcn_s_barrier()
#define PG8_SCHED __builtin_amdgcn_sched_barrier(0)
    Unit cur, nxt; int ui = 0;
    if (!S.next(0, cur)) return;
    ::f32x4 acc[2][2][4][2];
#pragma unroll
    for (int a = 0; a < 2; ++a)
#pragma unroll
        for (int b = 0; b < 2; ++b)
#pragma unroll
            for (int m = 0; m < 4; ++m)
#pragma unroll
                for (int n = 0; n < 2; ++n) acc[a][b][m][n] = (::f32x4){0.f, 0.f, 0.f, 0.f};
    pg8_frag<FP8 == 1> At[4], B0[2], B1[2];
    const char* cA = (const char*)g.A + (size_t)cur.pm * tstep; const char* cB = (const char*)g.Bt + (size_t)cur.eb * g.estride + (size_t)cur.pn * tstep;
    S.a_ready(cur);
    if constexpr (SP2) {
        PG8_STAGE(PG8_SB(0, 0), cB, voffB); PG8_STAGE(PG8_SB(0, 1), cB + hstep, voffB); PG8_STAGE(PG8_SA(0, 0), cA, voffA); PG8_STAGE(PG8_SA(0, 1), cA + hstep, voffA);
        if (wr == 1) PG8_BAR;
        PG8_WAIT_V(2); PG8_BAR;
        PG8_STAGE(PG8_SB(1, 0), cB + kstep, voffB); PG8_STAGE(PG8_SA(1, 0), cA + kstep, voffA); PG8_STAGE(PG8_SB(1, 1), cB + hstep + kstep, voffB);
        PG8_WAIT_V(6); PG8_BAR;
    } else {
        PG8_STAGE(PG8_SB(0, 0), cB, voffB); PG8_STAGE(PG8_SA(0, 0), cA, voffA); PG8_STAGE(PG8_SB(0, 1), cB + hstep, voffB); PG8_STAGE(PG8_SA(0, 1), cA + hstep, voffA);
        if (wr == 1) PG8_BAR;
        PG8_WAIT_V(4); PG8_BAR;
        PG8_STAGE(PG8_SB(1, 0), cB + kstep, voffB); PG8_STAGE(PG8_SA(1, 0), cA + kstep, voffA); PG8_STAGE(PG8_SB(1, 1), cB + hstep + kstep, voffB);
        PG8_WAIT_V(6); PG8_BAR;
    }
    for (;;) {
        const bool has_next = S.next(ui + 1, nxt);
        const char* nA = has_next ? (const char*)g.A + (size_t)nxt.pm * tstep : cA; const char* nB = has_next ? (const char*)g.Bt + (size_t)nxt.eb * g.estride + (size_t)nxt.pn * tstep : cB;
        for (int t = 0; t < nt; t += 2) {
            const bool last = (t == nt - 2);
            const char* a1 = cA + (size_t)(t + 1) * kstep;
            const char* a2 = last ? nA : cA + (size_t)(t + 2) * kstep; const char* b2 = last ? nB : cB + (size_t)(t + 2) * kstep;
            const char* a3 = a2 + kstep; const char* b3 = b2 + kstep;
            if (last && has_next) S.a_ready(nxt);
            if constexpr (SP2) {
            PG8_LDB(B0, 0, 0); PG8_LDB(B1, 0, 1); PG8_SCHED; PG8_LDA(At, 0, 0); PG8_STAGE(PG8_SA(1, 1), a1 + hstep, voffA);
            PG8_WAIT_V(8); PG8_WAIT_L(0); PG8_BAR; PG8_MMA(0, 0, At, B0); PG8_MMA(0, 1, At, B1); PG8_BAR; PG8_SCHED;
            PG8_LDA(At, 0, 1); PG8_STAGE(PG8_SB(0, 0), b2, voffB); PG8_STAGE(PG8_SB(0, 1), b2 + hstep, voffB); PG8_STAGE(PG8_SA(0, 0), a2, voffA);
            PG8_WAIT_V(8); PG8_WAIT_L(0); PG8_BAR; PG8_MMA(1, 0, At, B0); PG8_MMA(1, 1, At, B1); PG8_BAR; PG8_SCHED;
            PG8_LDB(B0, 1, 0); PG8_LDB(B1, 1, 1); PG8_SCHED; PG8_LDA(At, 1, 0); PG8_STAGE(PG8_SA(0, 1), a2 + hstep, voffA);
            PG8_WAIT_V(8); PG8_WAIT_L(0); PG8_BAR; PG8_MMA(0, 0, At, B0); PG8_MMA(0, 1, At, B1); PG8_BAR; PG8_SCHED;
            PG8_LDA(At, 1, 1); PG8_STAGE(PG8_SB(1, 0), b3, voffB); PG8_STAGE(PG8_SB(1, 1), b3 + hstep, voffB); PG8_STAGE(PG8_SA(1, 0), a3, voffA);
            PG8_WAIT_V(8); PG8_WAIT_L(0); PG8_BAR; PG8_MMA(1, 0, At, B0); PG8_MMA(1, 1, At, B1); PG8_BAR; PG8_SCHED;
            } else {
            PG8_LDB(B0, 0, 0); PG8_SCHED; PG8_LDA(At, 0, 0); PG8_STAGE(PG8_SA(1, 1), a1 + hstep, voffA);
            PG8_WAIT_L(8); PG8_BAR; PG8_WAIT_L(0); PG8_MMA(0, 0, At, B0); PG8_BAR; PG8_SCHED;
            PG8_LDB(B1, 0, 1); PG8_STAGE(PG8_SB(0, 0), b2, voffB);
            PG8_BAR; PG8_WAIT_L(0); PG8_MMA(0, 1, At, B1); PG8_BAR;
            PG8_LDA(At, 0, 1); PG8_STAGE(PG8_SA(0, 0), a2, voffA);
            PG8_BAR; PG8_WAIT_L(0); PG8_MMA(1, 0, At, B0); PG8_BAR; PG8_SCHED;
            PG8_STAGE(PG8_SB(0, 1), b2 + hstep, voffB);
            PG8_WAIT_V(6); PG8_BAR; PG8_MMA(1, 1, At, B1); PG8_BAR;
            PG8_LDB(B0, 1, 0); PG8_SCHED; PG8_LDA(At, 1, 0); PG8_STAGE(PG8_SA(0, 1), a2 + hstep, voffA);
            PG8_WAIT_L(8); PG8_BAR; PG8_WAIT_L(0); PG8_MMA(0, 0, At, B0); PG8_BAR; PG8_SCHED;
            PG8_LDB(B1, 1, 1); PG8_STAGE(PG8_SB(1, 0), b3, voffB);
            PG8_BAR; PG8_WAIT_L(0); PG8_MMA(0, 1, At, B1); PG8_BAR;
            PG8_LDA(At, 1, 1); PG8_STAGE(PG8_SA(1, 0), a3, voffA);
            PG8_BAR; PG8_WAIT_L(0); PG8_MMA(1, 0, At, B0); PG8_BAR; PG8_SCHED;
            PG8_STAGE(PG8_SB(1, 1), b3 + hstep, voffB);
            PG8_WAIT_V(6); PG8_BAR; PG8_MMA(1, 1, At, B1); PG8_BAR;
            }
        }
        if constexpr (ALIGN_EPI) { if (wr == 0) PG8_BAR; }
        asm volatile("s_nop 15\n\ts_nop 15" : "+v"(acc[1][1][0][0]), "+v"(acc[1][1][0][1]), "+v"(acc[1][1][1][0]), "+v"(acc[1][1][1][1]), "+v"(acc[1][1][2][0]), "+v"(acc[1][1][2][1]), "+v"(acc[1][1][3][0]), "+v"(acc[1][1][3][1]));
        if constexpr (FP8 == 2) {
            const int r0_ = cur.pm * BM + wr * 64 + fr; ::f32x4 sw_[2][2];
#pragma unroll
            for (int bj = 0; bj < 2; ++bj)
#pragma unroll
                for (int n = 0; n < 2; ++n) sw_[bj][n] = *(const ::f32x4*)(g.sw + cur.pn * BM + bj * HALF + wc * 32 + 8 * fq + 4 * n);
#pragma unroll
            for (int ai = 0; ai < 2; ++ai)
#pragma unroll
                for (int m = 0; m < 4; ++m) { const float s_ = g.sa[r0_ + ai * HALF + m * 16];
#pragma unroll
                    for (int bj = 0; bj < 2; ++bj)
#pragma unroll
                        for (int n = 0; n < 2; ++n)
#pragma unroll
                            for (int e = 0; e < 4; ++e) acc[ai][bj][m][n][e] = (float)__float_as_int(acc[ai][bj][m][n][e]) * (s_ * sw_[bj][n][e]); } }
        if constexpr (!Epi::AFTER_DRAIN) { E(acc, cur, wr, wc, fr, fq); S.done(cur); }
        if (!has_next) break;
#pragma unroll
        for (int a = 0; a < 2; ++a)
#pragma unroll
            for (int b = 0; b < 2; ++b)
#pragma unroll
                for (int m = 0; m < 4; ++m)
#pragma unroll
                    for (int n = 0; n < 2; ++n) acc[a][b][m][n] = (::f32x4){0.f, 0.f, 0.f, 0.f};
        cur = nxt; cA = nA; cB = nB; ++ui;
        if constexpr (ALIGN_EPI) { if (wr == 1) PG8_BAR; }
    }
    PG8_WAIT_V(0);
    if constexpr (!ALIGN_EPI) { if (wr == 0) PG8_BAR; }
    PG8_BAR;
    if constexpr (Epi::AFTER_DRAIN) { E.fused(acc, cur, wr, wc, fr, fq, lds, wid, lane); S.done(cur); }
#undef PG8_SA
#undef PG8_SB
#undef PG8_STAGE
#undef PG8_LDA
#undef PG8_LDB
#undef PG8_MMA
#undef PG8_WAIT_V
#undef PG8_WAIT_L
#undef PG8_BAR
#undef PG8_SCHED
}
}

namespace epi {
using pg8::Unit; using pg8::cvt_pk_bf16; using pg8::BM; using pg8::HALF;
struct Bf16 {
    static constexpr bool PERM = true, AFTER_DRAIN = false;
    bf16* O; int ldc; float scale = 1.f;
    __device__ __forceinline__ void operator()(const f32x4 (&acc)[2][2][4][2], const Unit& u, int wr, int wc, int fr, int fq) const {
        const int row0 = u.pm * BM + wr * 64 + fr, col0 = u.pn * BM + wc * 32 + 8 * fq;
#pragma unroll
        for (int ai = 0; ai < 2; ++ai)
#pragma unroll
            for (int m = 0; m < 4; ++m) { bf16* rowp = O + (size_t)(row0 + ai * HALF + m * 16) * ldc + col0;
#pragma unroll
                for (int bj = 0; bj < 2; ++bj) { const f32x4 v0 = acc[ai][bj][m][0] * scale, v1 = acc[ai][bj][m][1] * scale;
                    u32x4 w; w.x = cvt_pk_bf16(v0[0], v0[1]); w.y = cvt_pk_bf16(v0[2], v0[3]); w.z = cvt_pk_bf16(v1[0], v1[1]); w.w = cvt_pk_bf16(v1[2], v1[3]);
                    *(u32x4*)(rowp + bj * HALF) = w; } }
    }
};
struct InAB {
    static constexpr bool PERM = true, AFTER_DRAIN = false;
    bf16* O; float* G;
    __device__ __forceinline__ void operator()(const f32x4 (&acc)[2][2][4][2], const Unit& u, int wr, int wc, int fr, int fq) const {
        const int row0 = u.pm * BM + wr * 64 + fr, col0 = u.pn * BM + wc * 32 + 8 * fq;
        const bool gates = (u.pn == 7) && (wc == 2) && (fq < 2);
#pragma unroll
        for (int ai = 0; ai < 2; ++ai)
#pragma unroll
            for (int m = 0; m < 4; ++m) { const int row = row0 + ai * HALF + m * 16; bf16* rowp = O + (size_t)row * P_LD + col0;
#pragma unroll
                for (int bj = 0; bj < 2; ++bj) { const f32x4 v0 = acc[ai][bj][m][0], v1 = acc[ai][bj][m][1];
                    u32x4 w; w.x = cvt_pk_bf16(v0[0], v0[1]); w.y = cvt_pk_bf16(v0[2], v0[3]); w.z = cvt_pk_bf16(v1[0], v1[1]); w.w = cvt_pk_bf16(v1[2], v1[3]);
                    *(u32x4*)(rowp + bj * HALF) = w;
                    if (bj == 1 && gates) { float* gp = G + (size_t)row * 16 + 8 * fq; *(f32x4*)gp = v0; *(f32x4*)(gp + 4) = v1; } } }
    }
};
struct UpProj {
    static constexpr bool PERM = true, AFTER_DRAIN = false;
    unsigned char* ws;
    __device__ __forceinline__ void operator()(const f32x4 (&acc)[2][2][4][2], const Unit& u, int wr, int wc, int fr, int fq) const {
        const int b = u.pm >= NGRP ? 1 : 0, j0 = u.pm * BM - b * NT + wr * 64 + fr;
        unsigned off[2], ldb[2];
#pragma unroll
        for (int bj = 0; bj < 2; ++bj) {
            const int col = u.pn * BM + bj * HALF + wc * 32 + 8 * fq; int hd, w; unsigned base;
            if (col < 768) { hd = col / 192; w = col - hd * 192; base = (unsigned)WS_Q; ldb[bj] = 384u; }
            else { const int c2 = col - 768; hd = c2 >> 8; w = c2 & 255; if (w < 128) base = (unsigned)WS_KN; else { base = (unsigned)WS_V; w -= 128; } ldb[bj] = 256u; }
            off[bj] = base + ((unsigned)(b * NH + hd) * NT + (unsigned)j0) * ldb[bj] + 2u * w;
        }
#pragma unroll
        for (int ai = 0; ai < 2; ++ai)
#pragma unroll
            for (int m = 0; m < 4; ++m) {
#pragma unroll
                for (int bj = 0; bj < 2; ++bj) { const f32x4 v0 = acc[ai][bj][m][0], v1 = acc[ai][bj][m][1];
                    u32x4 wv; wv.x = cvt_pk_bf16(v0[0], v0[1]); wv.y = cvt_pk_bf16(v0[2], v0[3]); wv.z = cvt_pk_bf16(v1[0], v1[1]); wv.w = cvt_pk_bf16(v1[2], v1[3]);
                    *(u32x4*)(ws + (off[bj] + (unsigned)(ai * HALF + m * 16) * ldb[bj])) = wv; }
                asm volatile("" ::: "memory"); }
    }
};
struct SwiGLU {
    static constexpr bool PERM = true, AFTER_DRAIN = false;
    bf16* Hd; int ldh;
    __device__ __forceinline__ void operator()(const f32x4 (&acc)[2][2][4][2], const Unit& u, int wr, int wc, int fr, int fq) const {
        const int row0 = u.pm * BM + wr * 64 + fr, hc0 = u.pn * 128 + wc * 16 + 4 * fq;
#pragma unroll
        for (int ai = 0; ai < 2; ++ai)
#pragma unroll
            for (int m = 0; m < 4; ++m) { bf16* rowp = Hd + (size_t)(row0 + ai * HALF + m * 16) * ldh + hc0;
#pragma unroll
                for (int bj = 0; bj < 2; ++bj) { const f32x4 g = acc[ai][bj][m][0], uu = acc[ai][bj][m][1];
                    u32x2 w; w.x = cvt_pk_bf16(siluf(g[0]) * uu[0], siluf(g[1]) * uu[1]); w.y = cvt_pk_bf16(siluf(g[2]) * uu[2], siluf(g[3]) * uu[3]);
                    *(u32x2*)(rowp + bj * 64) = w; } }
    }
};
struct InC {
    static constexpr bool PERM = true, AFTER_DRAIN = false;
    bf16* O; const float* lb;
    __device__ __forceinline__ void operator()(const f32x4 (&acc)[2][2][4][2], const Unit& u, int wr, int wc, int fr, int fq) const {
        const int row0 = u.pm * BM + wr * 64 + fr, col0 = u.pn * BM + wc * 32 + 8 * fq; const int mode = u.pn < 4 ? 1 : (u.pn < 12 ? 2 : 0);
        f32x4 om[2][2];
#pragma unroll
        for (int bj = 0; bj < 2; ++bj) { const float* lp = lb + ((col0 + bj * HALF) & 1023); const f32x4 l0 = mode == 2 ? *(const f32x4*)lp : (f32x4){0.f, 0.f, 0.f, 0.f}, l1 = mode == 2 ? *(const f32x4*)(lp + 4) : (f32x4){0.f, 0.f, 0.f, 0.f};
            om[bj][0] = 1.f - l0; om[bj][1] = 1.f - l1; }
#pragma unroll
        for (int ai = 0; ai < 2; ++ai)
#pragma unroll
            for (int m = 0; m < 4; ++m) { bf16* rowp = O + (size_t)(row0 + ai * HALF + m * 16) * 5120 + col0;
#pragma unroll
                for (int bj = 0; bj < 2; ++bj) { f32x4 v0 = acc[ai][bj][m][0], v1 = acc[ai][bj][m][1];
                    if (mode == 1) {
#pragma unroll
                        for (int j = 0; j < 4; ++j) { v0[j] = siluf(v0[j]); v1[j] = siluf(v1[j]); } }
                    else if (mode == 2) {
#pragma unroll
                        for (int j = 0; j < 4; ++j) { v0[j] = om[bj][0][j] * __builtin_amdgcn_rcpf(1.f + __expf(v0[j])); v1[j] = om[bj][1][j] * __builtin_amdgcn_rcpf(1.f + __expf(v1[j])); } }
                    u32x4 w; w.x = cvt_pk_bf16(v0[0], v0[1]); w.y = cvt_pk_bf16(v0[2], v0[3]); w.z = cvt_pk_bf16(v1[0], v1[1]); w.w = cvt_pk_bf16(v1[2], v1[3]);
                    *(u32x4*)(rowp + bj * HALF) = w; } }
    }
};
struct SwiGLUf8 {
    static constexpr bool PERM = true, AFTER_DRAIN = false;
    unsigned char* Hd; int ldh; float scale;
    __device__ __forceinline__ void operator()(const f32x4 (&acc)[2][2][4][2], const Unit& u, int wr, int wc, int fr, int fq) const {
        const int row0 = u.pm * BM + wr * 64 + fr, hc0 = u.pn * 128 + wc * 16 + 4 * fq;
#pragma unroll
        for (int ai = 0; ai < 2; ++ai)
#pragma unroll
            for (int m = 0; m < 4; ++m) { unsigned char* rowp = Hd + (size_t)(row0 + ai * HALF + m * 16) * ldh + hc0;
#pragma unroll
                for (int bj = 0; bj < 2; ++bj) { const f32x4 g = acc[ai][bj][m][0] * scale, uu = acc[ai][bj][m][1] * scale;
                    int w = __builtin_amdgcn_cvt_pk_fp8_f32(siluf(g[0]) * uu[0], siluf(g[1]) * uu[1], 0, false); w = __builtin_amdgcn_cvt_pk_fp8_f32(siluf(g[2]) * uu[2], siluf(g[3]) * uu[3], w, true);
                    *(int*)(rowp + bj * 64) = w; } }
    }
};
}

#ifndef ATT_PROBE
#define ATT_PROBE 0
#endif
namespace att {
constexpr int NW = 8, QBLK = 32, KVBLK = 64;
constexpr float SCALE = 0.07216878364870322f;
constexpr float THR = 2.f;
constexpr float PSH = 5.f;
constexpr int KP = 208;
constexpr int VP = 80;
constexpr int SHM_V = 128 * VP, SHM_K = 64 * KP;
constexpr int NBUF = 3;
constexpr int SLOT = SHM_K + SHM_V;
constexpr int OFF_K = 0, OFF_V = SHM_K, OFF_W = NBUF * SLOT, LDS_TOTAL = OFF_W + NW * 64 * 4;
static_assert(LDS_TOTAL <= RING_BYTES, "attention LDS");
#define KSWZ(row, colB) ((row) * 384 + ((colB) ^ (((row) & 7) << 4)))
#define SBAR() __builtin_amdgcn_sched_barrier(0)
__device__ __forceinline__ int crow(int r, int hi) { return (r & 3) + 8 * (r >> 2) + 4 * hi; }
__device__ __forceinline__ unsigned cvtpk(float lo, float hi) { unsigned r; asm volatile("v_cvt_pk_bf16_f32 %0, %1, %2" : "=v"(r) : "v"(lo), "v"(hi)); return r; }

__device__ __forceinline__ void partialSM(f32x16& p0, f32x16& p1, float& m_reg, float& mn, float& alpha) {
  constexpr float C = SCALE * 1.4426950408889634f;
  float pmax = p0[0];
#pragma unroll
  for (int r = 1; r < 16; ++r) pmax = fmaxf(pmax, p0[r]);
#pragma unroll
  for (int r = 0; r < 16; ++r) pmax = fmaxf(pmax, p1[r]);
  { auto rr = __builtin_amdgcn_permlane32_swap(__float_as_uint(pmax), __float_as_uint(pmax), false, false);
    pmax = fmaxf(__uint_as_float(rr[0]), __uint_as_float(rr[1])); }
  if (__builtin_expect(__all(pmax - m_reg <= THR / SCALE), 1)) { mn = m_reg; alpha = 1.f; }
  else { mn = fmaxf(m_reg, pmax); alpha = __builtin_amdgcn_exp2f((m_reg - mn) * C); m_reg = mn; }
  float mnC = PSH - mn * C;
#pragma unroll
  for (int r = 0; r < 16; ++r) p0[r] = fmaf(p0[r], C, mnC);
#pragma unroll
  for (int r = 0; r < 16; ++r) p1[r] = fmaf(p1[r], C, mnC);
#pragma unroll
  for (int r = 0; r < 16; ++r) p0[r] = __builtin_amdgcn_exp2f(p0[r]);
}
#define PK4(P, BASE, OUT) do { unsigned a0 = cvtpk(P[BASE + 0], P[BASE + 1]), a1 = cvtpk(P[BASE + 2], P[BASE + 3]);   \
    unsigned b0 = cvtpk(P[BASE + 4], P[BASE + 5]), b1 = cvtpk(P[BASE + 6], P[BASE + 7]);                              \
    auto r0 = __builtin_amdgcn_permlane32_swap(a0, b0, false, false); auto r1 = __builtin_amdgcn_permlane32_swap(a1, b1, false, false); \
    u32x4 w = {r0[0], r1[0], r0[1], r1[1]}; OUT = *reinterpret_cast<bf16x8*>(&w); } while (0)
typedef int v8i __attribute__((ext_vector_type(8)));
typedef int v4i __attribute__((ext_vector_type(4)));
__device__ __forceinline__ unsigned pk4f8(float a, float b, float c, float d) { int w = __builtin_amdgcn_cvt_pk_fp8_f32(a, b, 0, false); w = __builtin_amdgcn_cvt_pk_fp8_f32(c, d, w, true); return (unsigned)w; }
__device__ __forceinline__ unsigned pk4f8o(float a, float b, float c, float d, int old) { int w = __builtin_amdgcn_cvt_pk_fp8_f32(a, b, old, false); w = __builtin_amdgcn_cvt_pk_fp8_f32(c, d, w, true); return (unsigned)w; }
__device__ __forceinline__ void finishSM(f32x16& p0, f32x16& p1, float alpha, float& l_reg, v8i& p8) {
#pragma unroll
  for (int r = 0; r < 16; ++r) p1[r] = __builtin_amdgcn_exp2f(p1[r]);
#if ATT_PROBE == 2
#pragma unroll
  for (int r = 0; r < 16; ++r) { float t; asm volatile("v_exp_f32 %0, %1" : "=v"(t) : "v"(p0[r])); asm volatile("v_exp_f32 %0, %1" : "=v"(t) : "v"(p1[r])); }
#endif
  float ps = 0;
#pragma unroll
  for (int r = 0; r < 16; ++r) ps += p0[r];
#pragma unroll
  for (int r = 0; r < 16; ++r) ps += p1[r];
  { auto rr = __builtin_amdgcn_permlane32_swap(__float_as_uint(ps), __float_as_uint(ps), false, false);
    ps = __uint_as_float(rr[0]) + __uint_as_float(rr[1]); }
  l_reg = l_reg * alpha + ps;
#pragma unroll
  for (int w = 0; w < 4; ++w) { p8[w] = (int)pk4f8(p0[4 * w], p0[4 * w + 1], p0[4 * w + 2], p0[4 * w + 3]); p8[4 + w] = (int)pk4f8(p1[4 * w], p1[4 * w + 1], p1[4 * w + 2], p1[4 * w + 3]); }
}
__device__ __forceinline__ v8i ld32(const char* p) { const v4i a = *reinterpret_cast<const v4i*>(p), b = *reinterpret_cast<const v4i*>(p + 16); return __builtin_shufflevector(a, b, 0, 1, 2, 3, 4, 5, 6, 7); }
__device__ __forceinline__ void qkt1(f32x16& p0, f32x16& p1, const char* Ks, int kb, const v8i (&qf8)[3]) {
  v8i a0 = ld32(Ks + kb), a1 = ld32(Ks + kb + 32 * KP); const v8i c0 = ld32(Ks + kb + 64), c1 = ld32(Ks + kb + 64 + 32 * KP);
  asm volatile("v_mfma_f32_32x32x64_f8f6f4 %0, %1, %2, 0" : "=&v"(p0) : "v"(a0), "v"(qf8[0]));
  asm volatile("v_mfma_f32_32x32x64_f8f6f4 %0, %1, %2, 0" : "=&v"(p1) : "v"(a1), "v"(qf8[0]));
  a0 = ld32(Ks + kb + 128); a1 = ld32(Ks + kb + 128 + 32 * KP);
  asm volatile("v_mfma_f32_32x32x64_f8f6f4 %0, %1, %2, %0" : "+v"(p0) : "v"(c0), "v"(qf8[1]));
  asm volatile("v_mfma_f32_32x32x64_f8f6f4 %0, %1, %2, %0" : "+v"(p1) : "v"(c1), "v"(qf8[1]));
  asm volatile("v_mfma_f32_32x32x64_f8f6f4 %0, %1, %2, %0" : "+v"(p0) : "v"(a0), "v"(qf8[2]));
  asm volatile("v_mfma_f32_32x32x64_f8f6f4 %0, %1, %2, %0" : "+v"(p1) : "v"(a1), "v"(qf8[2]));
  asm volatile("s_nop 15\n\ts_nop 7" : "+v"(p0), "+v"(p1));
}

__device__ __forceinline__ void qkt(f32x16& p0, f32x16& p1, const char* Ks, int kb, const v8i (&qf8)[3]) {
  qkt1(p0, p1, Ks, kb, qf8);
#if ATT_PROBE == 1
  asm volatile("" : "+v"(kb)); qkt1(p0, p1, Ks, kb, qf8);
#endif
}
__device__ __forceinline__ u32x2 bf8_to_f8(bf16x8 v) { u32x2 o; o.x = pk4f8(bf2f((unsigned short)v[0]), bf2f((unsigned short)v[1]), bf2f((unsigned short)v[2]), bf2f((unsigned short)v[3]));
  o.y = pk4f8(bf2f((unsigned short)v[4]), bf2f((unsigned short)v[5]), bf2f((unsigned short)v[6]), bf2f((unsigned short)v[7])); return o; }
__device__ __forceinline__ int v_st(int k, int c) { const int kk = (k & ~0xC) | ((k & 4) << 1) | ((k & 8) >> 1); return ((kk >> 3) * 4 + (c >> 5)) * 512 + ((kk & 7) * 32 + (c & 31)) * 2; }
__device__ __forceinline__ int v_rd_base(int lane) { return ((lane & 3) << 3) | (((lane >> 2) & 3) << 6) | (((lane >> 4) & 1) << 5) | (((lane >> 5) & 1) << 8); }
constexpr int v_rd_off(int d0, int ks, int half) { return d0 * 512 + ks * 4096 + half * 2048; }
template <int OFF> __device__ __forceinline__ s16x4 tr_read(int vb) {
  s16x4 r; asm volatile("ds_read_b64_tr_b16 %0, %1 offset:%2" : "=&v"(r) : "v"(vb), "i"(OFF) : "memory"); return r;
}
__device__ __forceinline__ void pv_d0(f32x16* o, const char* Vs, int vrd, v8i p8) {
  asm volatile("s_nop 1" : "+v"(p8));
  const v8i v0 = ld32(Vs + vrd), v1 = ld32(Vs + vrd + 32 * VP), v2 = ld32(Vs + vrd + 64 * VP), v3 = ld32(Vs + vrd + 96 * VP);
  asm volatile("v_mfma_f32_32x32x64_f8f6f4 %0, %1, %2, %0" : "+v"(o[0]) : "v"(p8), "v"(v0));
  asm volatile("v_mfma_f32_32x32x64_f8f6f4 %0, %1, %2, %0" : "+v"(o[1]) : "v"(p8), "v"(v1));
  asm volatile("v_mfma_f32_32x32x64_f8f6f4 %0, %1, %2, %0" : "+v"(o[2]) : "v"(p8), "v"(v2));
  asm volatile("v_mfma_f32_32x32x64_f8f6f4 %0, %1, %2, %0" : "+v"(o[3]) : "v"(p8), "v"(v3));
}

#define MF8(ACC, A, B) asm volatile("v_mfma_f32_32x32x64_f8f6f4 %0, %1, %2, %0" : "+v"(ACC) : "v"(A), "v"(B))
#define MF8Z(ACC, A, B) asm volatile("v_mfma_f32_32x32x64_f8f6f4 %0, %1, %2, 0" : "=&v"(ACC) : "v"(A), "v"(B))
__device__ __forceinline__ void qkt_fin(f32x16& n0, f32x16& n1, const char* Ks, int kb, const v8i (&qf8)[3], f32x16& p0, f32x16& p1, float alpha, float& l_reg, v8i& p8) {
  v8i a0 = ld32(Ks + kb), a1 = ld32(Ks + kb + 32 * KP); const v8i c0 = ld32(Ks + kb + 64), c1 = ld32(Ks + kb + 64 + 32 * KP);
  float ps = 0.f, pt = 0.f;
  MF8Z(n0, a0, qf8[0]); SBAR();
#pragma unroll
  for (int r = 0; r < 4; ++r) p1[r] = __builtin_amdgcn_exp2f(p1[r]);
  ps += p0[0]; pt += p0[1]; ps += p0[2]; pt += p0[3]; ps += p0[4]; pt += p0[5]; SBAR();
  MF8Z(n1, a1, qf8[0]); SBAR();
  a0 = ld32(Ks + kb + 128); a1 = ld32(Ks + kb + 128 + 32 * KP);
#pragma unroll
  for (int r = 4; r < 8; ++r) p1[r] = __builtin_amdgcn_exp2f(p1[r]);
  ps += p0[6]; pt += p0[7]; ps += p0[8]; pt += p0[9]; ps += p0[10]; pt += p0[11]; SBAR();
  MF8(n0, c0, qf8[1]); SBAR();
#pragma unroll
  for (int r = 8; r < 12; ++r) p1[r] = __builtin_amdgcn_exp2f(p1[r]);
  ps += p0[12]; pt += p0[13]; ps += p0[14]; pt += p0[15]; ps += p1[0]; pt += p1[1]; SBAR();
  MF8(n1, c1, qf8[1]); SBAR();
#pragma unroll
  for (int r = 12; r < 16; ++r) p1[r] = __builtin_amdgcn_exp2f(p1[r]);
  ps += p1[2]; pt += p1[3]; ps += p1[4]; pt += p1[5]; ps += p1[6]; pt += p1[7]; SBAR();
  MF8(n0, a0, qf8[2]); SBAR();
  ps += p1[8]; pt += p1[9]; ps += p1[10]; pt += p1[11]; ps += p1[12]; pt += p1[13]; ps += p1[14]; pt += p1[15];
  p8[0] = (int)pk4f8(p0[0], p0[1], p0[2], p0[3]); p8[1] = (int)pk4f8(p0[4], p0[5], p0[6], p0[7]); p8[2] = (int)pk4f8(p0[8], p0[9], p0[10], p0[11]); SBAR();
  MF8(n1, a1, qf8[2]); SBAR();
  p8[3] = (int)pk4f8(p0[12], p0[13], p0[14], p0[15]);
#pragma unroll
  for (int w = 0; w < 4; ++w) p8[4 + w] = (int)pk4f8(p1[4 * w], p1[4 * w + 1], p1[4 * w + 2], p1[4 * w + 3]);
  ps += pt;
  { auto rr = __builtin_amdgcn_permlane32_swap(__float_as_uint(ps), __float_as_uint(ps), false, false); ps = __uint_as_float(rr[0]) + __uint_as_float(rr[1]); }
  l_reg = l_reg * alpha + ps;
  asm volatile("s_nop 15\n\ts_nop 7" : "+v"(n0), "+v"(n1));
}
__device__ __forceinline__ void pv_part(f32x16* o, const char* Vs, int vrd, v8i p8, f32x16& p0, f32x16& p1, float& m_reg, float& alpha) {
  constexpr float C = SCALE * 1.4426950408889634f;
  asm volatile("s_nop 1" : "+v"(p8));
  const v8i v0 = ld32(Vs + vrd), v1 = ld32(Vs + vrd + 32 * VP), v2 = ld32(Vs + vrd + 64 * VP), v3 = ld32(Vs + vrd + 96 * VP);
  MF8(o[0], p8, v0); SBAR();
  float pmax = fmaxf(fmaxf(p0[0], p0[1]), p0[2]);
#pragma unroll
  for (int r = 3; r < 15; r += 2) pmax = fmaxf(fmaxf(pmax, p0[r]), p0[r + 1]);
  pmax = fmaxf(fmaxf(pmax, p0[15]), p1[0]);
#pragma unroll
  for (int r = 1; r < 7; r += 2) pmax = fmaxf(fmaxf(pmax, p1[r]), p1[r + 1]);
  SBAR();
  MF8(o[1], p8, v1); SBAR();
#pragma unroll
  for (int r = 7; r < 15; r += 2) pmax = fmaxf(fmaxf(pmax, p1[r]), p1[r + 1]);
  pmax = fmaxf(pmax, p1[15]);
  { auto rr = __builtin_amdgcn_permlane32_swap(__float_as_uint(pmax), __float_as_uint(pmax), false, false); pmax = fmaxf(__uint_as_float(rr[0]), __uint_as_float(rr[1])); }
  const bool keep = __all(pmax - m_reg <= THR / SCALE);
  const float mn = keep ? m_reg : fmaxf(m_reg, pmax);
  alpha = __builtin_amdgcn_exp2f((m_reg - mn) * C); m_reg = mn;
  const float mnC = PSH - mn * C;
  SBAR();
  MF8(o[2], p8, v2); SBAR();
#pragma unroll
  for (int r = 0; r < 14; ++r) p0[r] = fmaf(p0[r], C, mnC);
  SBAR();
  MF8(o[3], p8, v3); SBAR();
  p0[14] = fmaf(p0[14], C, mnC); p0[15] = fmaf(p0[15], C, mnC);
#pragma unroll
  for (int r = 0; r < 16; ++r) p1[r] = fmaf(p1[r], C, mnC);
#pragma unroll
  for (int r = 0; r < 16; ++r) p0[r] = __builtin_amdgcn_exp2f(p0[r]);
}

#define MF8C(ACC, A, B, C_) asm volatile("v_mfma_f32_32x32x64_f8f6f4 %0, %1, %2, %3" : "=&v"(ACC) : "v"(A), "v"(B), "v"(C_))
constexpr float THR2 = THR * 1.4426950408889634f;
__device__ __forceinline__ void qkt_fin_b(f32x16& n0, f32x16& n1, const char* Ks, int kb, const v8i (&qf8)[3], const f32x16& mb, f32x16& p0, f32x16& p1, float alpha, float& l_reg, v8i& p8,
                                          v8i& f0, v8i& f1, v8i& f2, const char* Vs, int vrd) {
#pragma unroll
  for (int r = 8; r < 16; ++r) p0[r] = __builtin_amdgcn_exp2f(p0[r]);
  float ps = 0.f, pt = 0.f;
  MF8C(n0, f0, qf8[0], mb); SBAR();
  f0 = ld32(Ks + kb + 64 + 32 * KP);
#pragma unroll
  for (int r = 0; r < 4; ++r) p1[r] = __builtin_amdgcn_exp2f(p1[r]);
  ps += p0[0]; pt += p0[1]; ps += p0[2]; pt += p0[3]; ps += p0[4]; pt += p0[5]; SBAR();
  MF8C(n1, f1, qf8[0], mb); SBAR();
  f1 = ld32(Ks + kb + 128);
#pragma unroll
  for (int r = 4; r < 8; ++r) p1[r] = __builtin_amdgcn_exp2f(p1[r]);
  ps += p0[6]; pt += p0[7]; ps += p0[8]; pt += p0[9]; ps += p0[10]; pt += p0[11]; SBAR();
  MF8(n0, f2, qf8[1]); SBAR();
  f2 = ld32(Ks + kb + 128 + 32 * KP);
#pragma unroll
  for (int r = 8; r < 12; ++r) p1[r] = __builtin_amdgcn_exp2f(p1[r]);
  ps += p0[12]; pt += p0[13]; ps += p0[14]; pt += p0[15]; ps += p1[0]; pt += p1[1]; SBAR();
  MF8(n1, f0, qf8[1]); SBAR();
#pragma unroll
  for (int r = 12; r < 16; ++r) p1[r] = __builtin_amdgcn_exp2f(p1[r]);
  ps += p1[2]; pt += p1[3]; ps += p1[4]; pt += p1[5]; ps += p1[6]; pt += p1[7]; SBAR();
  MF8(n0, f1, qf8[2]); SBAR();
  ps += p1[8]; pt += p1[9]; ps += p1[10]; pt += p1[11]; ps += p1[12]; pt += p1[13]; ps += p1[14]; pt += p1[15];
  p8[0] = (int)pk4f8o(p0[0], p0[1], p0[2], p0[3], p8[0]); p8[1] = (int)pk4f8o(p0[4], p0[5], p0[6], p0[7], p8[1]); p8[2] = (int)pk4f8o(p0[8], p0[9], p0[10], p0[11], p8[2]); SBAR();
  MF8(n1, f2, qf8[2]); SBAR();
  f0 = ld32(Vs + vrd); f1 = ld32(Vs + vrd + 32 * VP); f2 = ld32(Vs + vrd + 64 * VP);
  p8[3] = (int)pk4f8o(p0[12], p0[13], p0[14], p0[15], p8[3]);
#pragma unroll
  for (int w = 0; w < 4; ++w) p8[4 + w] = (int)pk4f8o(p1[4 * w], p1[4 * w + 1], p1[4 * w + 2], p1[4 * w + 3], p8[4 + w]);
  ps += pt;
  { auto rr = __builtin_amdgcn_permlane32_swap(__float_as_uint(ps), __float_as_uint(ps), false, false); ps = __uint_as_float(rr[0]) + __uint_as_float(rr[1]); }
  l_reg = l_reg * alpha + ps;
  asm volatile("s_nop 15\n\ts_nop 7" : "+v"(n0), "+v"(n1));
}
__device__ __forceinline__ void pv_part_b(f32x16* o, const char* Vs, int vrd, v8i p8, f32x16& p0, f32x16& p1, f32x16& mb, float& alpha, v8i v0, const v8i v1, const v8i v2) {
  asm volatile("s_nop 1" : "+v"(p8));
  MF8(o[0], p8, v0); SBAR();
  v0 = ld32(Vs + vrd + 96 * VP);
  float pmax = fmaxf(fmaxf(p0[0], p0[1]), p0[2]);
#pragma unroll
  for (int r = 3; r < 15; r += 2) pmax = fmaxf(fmaxf(pmax, p0[r]), p0[r + 1]);
  pmax = fmaxf(fmaxf(pmax, p0[15]), p1[0]);
#pragma unroll
  for (int r = 1; r < 7; r += 2) pmax = fmaxf(fmaxf(pmax, p1[r]), p1[r + 1]);
  SBAR();
  MF8(o[1], p8, v1); SBAR();
#pragma unroll
  for (int r = 7; r < 15; r += 2) pmax = fmaxf(fmaxf(pmax, p1[r]), p1[r + 1]);
  pmax = fmaxf(pmax, p1[15]);
  { auto rr = __builtin_amdgcn_permlane32_swap(__float_as_uint(pmax), __float_as_uint(pmax), false, false); pmax = fmaxf(__uint_as_float(rr[0]), __uint_as_float(rr[1])); }
  const bool keep = __all(pmax <= PSH + THR2);
  SBAR();
  MF8(o[2], p8, v2); SBAR();
  alpha = 1.f;
  if (__builtin_expect(!keep, 0)) {
    const float d = fmaxf(pmax - PSH, 0.f); alpha = __builtin_amdgcn_exp2f(-d);
#pragma unroll
    for (int r = 0; r < 16; ++r) { mb[r] -= d; p0[r] -= d; p1[r] -= d; } }
#pragma unroll
  for (int r = 0; r < 8; ++r) p0[r] = __builtin_amdgcn_exp2f(p0[r]);
  SBAR();
  MF8(o[3], p8, v0); SBAR();
}

constexpr float PLIM = 440.f;
__device__ __forceinline__ void qkt_fin_c(f32x16& n0, f32x16& n1, const char* Ks, int kb, const v8i (&qf8)[3], f32x16& mb, f32x16& p0, f32x16& p1, float& l_reg, v8i& p8,
                                          v8i& f0, v8i& f1, v8i& f2, const char* Vs, int vrd, float& alpha_out) {
  float ps = 0.f, pt = 0.f;
  MF8C(n0, f0, qf8[0], mb); SBAR();
  f0 = ld32(Ks + kb + 64 + 32 * KP);
#pragma unroll
  for (int r = 0; r < 4; ++r) p1[r] = __builtin_amdgcn_exp2f(p1[r]);
  ps += p0[0]; pt += p0[1]; ps += p0[2]; pt += p0[3]; ps += p0[4]; pt += p0[5]; SBAR();
  MF8C(n1, f1, qf8[0], mb); SBAR();
  f1 = ld32(Ks + kb + 128);
#pragma unroll
  for (int r = 4; r < 8; ++r) p1[r] = __builtin_amdgcn_exp2f(p1[r]);
  ps += p0[6]; pt += p0[7]; ps += p0[8]; pt += p0[9]; ps += p0[10]; pt += p0[11]; SBAR();
  MF8(n0, f2, qf8[1]); SBAR();
  f2 = ld32(Ks + kb + 128 + 32 * KP);
#pragma unroll
  for (int r = 8; r < 12; ++r) p1[r] = __builtin_amdgcn_exp2f(p1[r]);
  ps += p0[12]; pt += p0[13]; ps += p0[14]; pt += p0[15]; ps += p1[0]; pt += p1[1]; SBAR();
  MF8(n1, f0, qf8[1]); SBAR();
#pragma unroll
  for (int r = 12; r < 16; ++r) p1[r] = __builtin_amdgcn_exp2f(p1[r]);
  ps += p1[2]; pt += p1[3]; ps += p1[4]; pt += p1[5]; ps += p1[6]; pt += p1[7]; SBAR();
  MF8(n0, f1, qf8[2]); SBAR();
  ps += p1[8]; pt += p1[9]; ps += p1[10]; pt += p1[11]; ps += p1[12]; pt += p1[13]; ps += p1[14]; pt += p1[15];
  ps += pt;
  { auto rr = __builtin_amdgcn_permlane32_swap(__float_as_uint(ps), __float_as_uint(ps), false, false); ps = __uint_as_float(rr[0]) + __uint_as_float(rr[1]); }
  SBAR();
  MF8(n1, f2, qf8[2]); SBAR();
  f0 = ld32(Vs + vrd); f1 = ld32(Vs + vrd + 32 * VP); f2 = ld32(Vs + vrd + 64 * VP);
  alpha_out = 1.f;
  if (__builtin_expect(!__all(ps <= PLIM), 0)) {
    asm volatile("s_nop 15\n\ts_nop 7" : "+v"(n0), "+v"(n1));
    float pm = fmaxf(fmaxf(p0[0], p0[1]), p0[2]);
#pragma unroll
    for (int r = 3; r < 15; r += 2) pm = fmaxf(fmaxf(pm, p0[r]), p0[r + 1]);
    pm = fmaxf(fmaxf(pm, p0[15]), p1[0]);
#pragma unroll
    for (int r = 1; r < 15; r += 2) pm = fmaxf(fmaxf(pm, p1[r]), p1[r + 1]);
    pm = fmaxf(pm, p1[15]);
    { auto rr = __builtin_amdgcn_permlane32_swap(__float_as_uint(pm), __float_as_uint(pm), false, false); pm = fmaxf(__uint_as_float(rr[0]), __uint_as_float(rr[1])); }
    const float d = fmaxf(__log2f(pm) - PSH, 0.f), sc = __builtin_amdgcn_exp2f(-d);
    alpha_out = sc; ps *= sc;
#pragma unroll
    for (int r = 0; r < 16; ++r) { p0[r] *= sc; p1[r] *= sc; mb[r] -= d; n0[r] -= d; n1[r] -= d; } }
  l_reg = l_reg * alpha_out + ps;
#pragma unroll
  for (int w = 0; w < 4; ++w) { p8[w] = (int)pk4f8o(p0[4 * w], p0[4 * w + 1], p0[4 * w + 2], p0[4 * w + 3], p8[w]); p8[4 + w] = (int)pk4f8o(p1[4 * w], p1[4 * w + 1], p1[4 * w + 2], p1[4 * w + 3], p8[4 + w]); }
}
__device__ __forceinline__ void pv_part_c(f32x16* o, const char* Vs, int vrd, v8i p8, f32x16& p0, v8i v0, const v8i v1, const v8i v2) {
  asm volatile("s_nop 1" : "+v"(p8), "+v"(o[0]), "+v"(o[1]), "+v"(o[2]), "+v"(o[3]));
  MF8(o[0], p8, v0); SBAR();
  v0 = ld32(Vs + vrd + 96 * VP);
#pragma unroll
  for (int r = 0; r < 4; ++r) p0[r] = __builtin_amdgcn_exp2f(p0[r]);
  SBAR();
  MF8(o[1], p8, v1); SBAR();
#pragma unroll
  for (int r = 4; r < 8; ++r) p0[r] = __builtin_amdgcn_exp2f(p0[r]);
  SBAR();
  MF8(o[2], p8, v2); SBAR();
#pragma unroll
  for (int r = 8; r < 12; ++r) p0[r] = __builtin_amdgcn_exp2f(p0[r]);
  SBAR();
  MF8(o[3], p8, v0); SBAR();
#pragma unroll
  for (int r = 12; r < 16; ++r) p0[r] = __builtin_amdgcn_exp2f(p0[r]);
}

__device__ __forceinline__ void attn_unit(const bf16* __restrict__ Qb, const char* __restrict__ KVh,
                                          bf16* __restrict__ Ob, int seq, int rope_t0, const float* __restrict__ rope, char* lds, const int tid) {
  const int wid = tid >> 6, lane = tid & 63, r32 = lane & 31, hi = lane >> 5;
  char* V_lds = lds + OFF_V; char* K_lds = lds + OFF_K;
  const int kb = r32 * KP + hi * 32;
  float* wsf = (float*)(lds + OFF_W) + wid * 64; float* li_l = wsf; float* al_l = wsf + 32;
  float m_reg = -1e30f, l_reg = 0; f32x16 o[4] = {}; bf16x8 qr[12];
  int qoff = (wid * QBLK + r32) * 192 + hi * 8; asm volatile("" : "+v"(qoff));
  const bf16* Qw = Qb + qoff;
#pragma unroll
  for (int d0 = 0; d0 < 12; ++d0) qr[d0] = *reinterpret_cast<const bf16x8*>(Qw + d0 * 16);
  if (rope_t0 >= 0) {
    const int t = rope_t0 + wid * QBLK + r32; const float* ta = rope + (t >> 6) * 32 + hi * 8; const float* tb = rope + (t & 63) * 32 + hi * 8;
#pragma unroll
    for (int e = 0; e < 8; ++e) {
      { const float x1 = bf2f((unsigned short)qr[8][e]), x2 = bf2f((unsigned short)qr[10][e]), c = ta[e], s = ta[16 + e];
        qr[8][e] = (short)f2bf(x1 * c - x2 * s); qr[10][e] = (short)f2bf(x2 * c + x1 * s); }
      { const float x1 = bf2f((unsigned short)qr[9][e]), x2 = bf2f((unsigned short)qr[11][e]), c = tb[e], s = tb[16 + e];
        qr[9][e] = (short)f2bf(x1 * c - x2 * s); qr[11][e] = (short)f2bf(x2 * c + x1 * s); }
    }
  }
  v8i qf8[3];
#pragma unroll
  for (int s = 0; s < 3; ++s)
#pragma unroll
    for (int a = 0; a < 4; ++a) { const bf16x8 v = qr[4 * s + a]; constexpr float QC = SCALE * 1.4426950408889634f;
      qf8[s][2 * a] = (int)pk4f8(bf2f((unsigned short)v[0]) * QC, bf2f((unsigned short)v[1]) * QC, bf2f((unsigned short)v[2]) * QC, bf2f((unsigned short)v[3]) * QC);
      qf8[s][2 * a + 1] = (int)pk4f8(bf2f((unsigned short)v[4]) * QC, bf2f((unsigned short)v[5]) * QC, bf2f((unsigned short)v[6]) * QC, bf2f((unsigned short)v[7]) * QC); }
  int l16 = lane * 16; asm volatile("" : "+v"(l16));
  const int widu = __builtin_amdgcn_readfirstlane(wid);
  const int vrd = r32 * VP + hi * 32;
#define SDMA(k0, b) do { asm volatile("" : "+v"(l16));   const char* kt_ = KVh + (long)((k0) >> 6) * SLOT; \
    _Pragma("unroll") for (int i_ = 0; i_ < 3; ++i_) { const int c_ = widu + 8 * i_; \
      if (c_ < 23) __builtin_amdgcn_global_load_lds((const unsigned*)(kt_ + c_ * 1024 + l16), (LAS unsigned*)(lds + (b) * SLOT + c_ * 1024), 16, 0, 0); } } while (0)
#define RESC(a) do { if (__any((a) < 1.f)) { if (hi == 0) al_l[r32] = (a); asm volatile("s_waitcnt lgkmcnt(0)" ::: "memory"); \
    _Pragma("unroll") for (int d = 0; d < 4; ++d) _Pragma("unroll") for (int r = 0; r < 16; ++r) o[d][r] *= al_l[crow(r, hi)]; asm volatile("s_nop 1" : "+v"(o[0]), "+v"(o[1]), "+v"(o[2]), "+v"(o[3])); } } while (0)
  f32x16 pA0, pA1, pB0, pB1, mb; float alA, alB; v8i p8 = {}; const int NTL = seq / KVBLK;
#define KLOAD(Ks_) v8i f0 = ld32((Ks_) + kb), f1 = ld32((Ks_) + kb + 32 * KP), f2 = ld32((Ks_) + kb + 64)
  __syncthreads();
  SDMA(0, 0); SDMA(KVBLK, 1); asm volatile("s_waitcnt vmcnt(0)" ::: "memory"); __syncthreads();
  qkt(pA0, pA1, K_lds, kb, qf8);
  { float pmax = pA0[0];
#pragma unroll
    for (int r = 1; r < 16; ++r) pmax = fmaxf(pmax, pA0[r]);
#pragma unroll
    for (int r = 0; r < 16; ++r) pmax = fmaxf(pmax, pA1[r]);
    { auto rr = __builtin_amdgcn_permlane32_swap(__float_as_uint(pmax), __float_as_uint(pmax), false, false); pmax = fmaxf(__uint_as_float(rr[0]), __uint_as_float(rr[1])); }
    const float b0_ = PSH - pmax; alA = 1.f;
#pragma unroll
    for (int r = 0; r < 16; ++r) { mb[r] = b0_; pA0[r] = __builtin_amdgcn_exp2f(pA0[r] + b0_); pA1[r] += b0_; } }
  int bj = 1;
  if (wid >= 4) __builtin_amdgcn_s_setprio(1);
  for (int j = 1; j + 1 < NTL; j += 2) {
    const int b0 = bj == 0 ? 2 : bj - 1, b1 = bj, b2 = bj == 2 ? 0 : bj + 1;
    { KLOAD(K_lds + b1 * SLOT); SDMA((j + 1) * KVBLK, b2);
      SBAR(); qkt_fin_c(pB0, pB1, K_lds + b1 * SLOT, kb, qf8, mb, pA0, pA1, l_reg, p8, f0, f1, f2, V_lds + b0 * SLOT, vrd, alA); SBAR();
      RESC(alA);
      pv_part_c(o, V_lds + b0 * SLOT, vrd, p8, pB0, f0, f1, f2); SBAR(); }
    asm volatile("s_waitcnt vmcnt(0)" ::: "memory"); __syncthreads();
    { KLOAD(K_lds + b2 * SLOT); if (j + 2 < NTL) SDMA((j + 2) * KVBLK, b0);
      SBAR(); qkt_fin_c(pA0, pA1, K_lds + b2 * SLOT, kb, qf8, mb, pB0, pB1, l_reg, p8, f0, f1, f2, V_lds + b1 * SLOT, vrd, alB); SBAR();
      RESC(alB);
      pv_part_c(o, V_lds + b1 * SLOT, vrd, p8, pA0, f0, f1, f2); SBAR(); }
    asm volatile("s_waitcnt vmcnt(0)" ::: "memory"); __syncthreads();
    bj = bj == 0 ? 2 : bj - 1;
  }
  { const int b0 = bj == 0 ? 2 : bj - 1, b1 = bj;
    { KLOAD(K_lds + b1 * SLOT);
      SBAR(); qkt_fin_c(pB0, pB1, K_lds + b1 * SLOT, kb, qf8, mb, pA0, pA1, l_reg, p8, f0, f1, f2, V_lds + b0 * SLOT, vrd, alA); SBAR();
      asm volatile("s_nop 15\n\ts_nop 7" : "+v"(pB0), "+v"(pB1));
      RESC(alA);
      pv_part_b(o, V_lds + b0 * SLOT, vrd, p8, pB0, pB1, mb, alB, f0, f1, f2); SBAR(); }
    RESC(alB);
#pragma unroll
    for (int r = 8; r < 16; ++r) pB0[r] = __builtin_amdgcn_exp2f(pB0[r]);
    finishSM(pB0, pB1, alB, l_reg, p8); SBAR();
    pv_d0(o, V_lds + b1 * SLOT, vrd, p8); }
  asm volatile("s_nop 15\n\ts_nop 7" : "+v"(o[0]), "+v"(o[1]), "+v"(o[2]), "+v"(o[3]));
  __builtin_amdgcn_s_setprio(0);
  if (hi == 0) li_l[r32] = l_reg; asm volatile("s_waitcnt lgkmcnt(0)" ::: "memory");
  float rli[16];
#pragma unroll
  for (int r = 0; r < 16; ++r) rli[r] = __builtin_amdgcn_rcpf(li_l[crow(r, hi)]);
  bf16* Ow = Ob + (long)(wid * QBLK) * 1024;
#pragma unroll
  for (int r = 0; r < 16; ++r) { const int orow = crow(r, hi);
#pragma unroll
    for (int d0 = 0; d0 < 4; ++d0) Ow[(long)orow * 1024 + d0 * 32 + r32] = (bf16)f2bf(o[d0][r] * rli[r]); }
#undef SDMA
#undef KLOAD
#undef RESC
}
}

struct Args { const float* in[N_IN]; float* out; unsigned char* ws; int ph_lo, ph_hi; };
struct Frame {
    LAS unsigned char* lds; int tid, lane, wave, G, gw, NGW;
    const float* const* in; float* out; unsigned char* ws;
};
__device__ __forceinline__ void row_decode(int row, int& b, int& j) { b = row >= NT ? 1 : 0; j = row - b * NT; }
__device__ __forceinline__ bf16* res_row(const Frame& F, int row) { return (bf16*)(F.ws + WS_RES) + (size_t)row * DM; }
__device__ __forceinline__ float* out_row(const Frame& F, int row) { int b, j; row_decode(row, b, j); return F.out + (size_t)(b * SEQ + (j - CTXL)) * DM; }
__device__ __forceinline__ const float* in_row(const Frame& F, int row) { int b, j; row_decode(row, b, j);
    return j < CTXL ? F.in[I_CTX] + (size_t)(b * CTXL + j) * DM : F.in[I_X] + (size_t)(b * SEQ + (j - CTXL)) * DM; }
__device__ __forceinline__ const float* mod_vec(const Frame& F, int layer, int row, int chunk) { int b, j; row_decode(row, b, j);
    const int who = j < CTXL ? 2 : b; return (const float*)(F.ws + WS_MOD) + (size_t)(layer * 3 + who) * 6144 + chunk * 1024; }

template <class Src, class Dst>
__device__ __forceinline__ void transpose_items(const Frame& F, int Ktot, int Ntot, bf16* WT, Src src, Dst dstrow) {
    LAS float* scr = (LAS float*)(F.lds + F.wave * 16384);
    const int nblk = Ntot / 32, nitems = (Ktot / 64) * nblk, lane = F.lane;
    for (int it = F.gw; it < nitems; it += F.NGW) {
        const int kb = it / nblk, nb = it - kb * nblk, k0 = 64 * kb, n0 = 32 * nb;
        float tv[32];
#pragma unroll
        for (int i = 0; i < 32; ++i) tv[i] = src(k0 + 2 * i + (lane >> 5), n0 + (lane & 31));
#pragma unroll
        for (int i = 0; i < 32; ++i) { const int kk = 2 * i + (lane >> 5); scr[kk * 33 + (lane & 31)] = tv[i]; }
        LDS_WAIT(); asm volatile("" ::: "memory");
        const int c = lane & 7;
#pragma unroll
        for (int j = 0; j < 4; ++j) { const int n = (lane >> 3) + 8 * j; const LAS float* s = scr + (8 * c) * 33 + n;
            u32x4 o; o.x = pk2(s[0 * 33], s[1 * 33]); o.y = pk2(s[2 * 33], s[3 * 33]); o.z = pk2(s[4 * 33], s[5 * 33]); o.w = pk2(s[6 * 33], s[7 * 33]);
            *(u32x4*)(WT + (size_t)dstrow(n0 + n) * Ktot + k0 + 8 * c) = o; }
        LDS_WAIT(); asm volatile("" ::: "memory");
    }
}
__device__ __forceinline__ unsigned pk4_fp8(float a, float b, float c, float d) { int w = __builtin_amdgcn_cvt_pk_fp8_f32(a, b, 0, false); w = __builtin_amdgcn_cvt_pk_fp8_f32(c, d, w, true); return (unsigned)w; }
template <class Src, class Dst>
__device__ __forceinline__ void transpose_items_f8(const Frame& F, int Ktot, int Ntot, unsigned char* WT, Src src, Dst dstrow, float wscale) {
    LAS float* scr = (LAS float*)(F.lds + F.wave * 16384);
    const int nblk = Ntot / 32, nitems = (Ktot / 64) * nblk, lane = F.lane;
    for (int it = F.gw; it < nitems; it += F.NGW) {
        const int kb = it / nblk, nb = it - kb * nblk, k0 = 64 * kb, n0 = 32 * nb;
        float tv[32];
#pragma unroll
        for (int i = 0; i < 32; ++i) tv[i] = src(k0 + 2 * i + (lane >> 5), n0 + (lane & 31));
#pragma unroll
        for (int i = 0; i < 32; ++i) { const int kk = 2 * i + (lane >> 5); scr[kk * 33 + (lane & 31)] = tv[i] * wscale; }
        LDS_WAIT(); asm volatile("" ::: "memory");
        const int c = lane & 3;
#pragma unroll
        for (int j = 0; j < 2; ++j) { const int n = (lane >> 2) + 16 * j; const LAS float* s = scr + (16 * c) * 33 + n;
            u32x4 o; o.x = pk4_fp8(s[0 * 33], s[1 * 33], s[2 * 33], s[3 * 33]); o.y = pk4_fp8(s[4 * 33], s[5 * 33], s[6 * 33], s[7 * 33]);
            o.z = pk4_fp8(s[8 * 33], s[9 * 33], s[10 * 33], s[11 * 33]); o.w = pk4_fp8(s[12 * 33], s[13 * 33], s[14 * 33], s[15 * 33]);
            *(u32x4*)(WT + (size_t)dstrow(n0 + n) * Ktot + k0 + 16 * c) = o; }
        LDS_WAIT(); asm volatile("" ::: "memory");
    }
}
__device__ __forceinline__ unsigned pk4_i8(float a, float b, float c, float d) {
    const int q0 = __float2int_rn(a), q1 = __float2int_rn(b), q2 = __float2int_rn(c), q3 = __float2int_rn(d);
    return (unsigned)(q0 & 255) | ((unsigned)(q1 & 255) << 8) | ((unsigned)(q2 & 255) << 16) | ((unsigned)q3 << 24); }
template <class Src, class Dst>
__device__ __forceinline__ void transpose_items_i8(const Frame& F, int Ktot, int Ntot, unsigned char* WT, Src src, Dst dstrow, const float* cmaxp, float* colsc) {
    LAS float* scr = (LAS float*)(F.lds + F.wave * 16384);
    const int nblk = Ntot / 32, nitems = (Ktot / 64) * nblk, lane = F.lane;
    for (int it = F.gw; it < nitems; it += F.NGW) {
        const int kb = it / nblk, nb = it - kb * nblk, k0 = 64 * kb, n0 = 32 * nb;
        float tv[32];
#pragma unroll
        for (int i = 0; i < 32; ++i) tv[i] = src(k0 + 2 * i + (lane >> 5), n0 + (lane & 31));
        float am = 1e-30f;
#pragma unroll
        for (int c = 0; c < 16; ++c) am = fmaxf(am, cmaxp[c * 12800 + n0 + (lane & 31)]);
        const float qscale = 127.f / am;
        if (kb == 0 && lane < 32) colsc[dstrow(n0 + lane)] = am * (1.f / 127.f);
#pragma unroll
        for (int i = 0; i < 32; ++i) { const int kk = 2 * i + (lane >> 5); scr[kk * 33 + (lane & 31)] = tv[i] * qscale; }
        LDS_WAIT(); asm volatile("" ::: "memory");
        const int c = lane & 3;
#pragma unroll
        for (int j = 0; j < 2; ++j) { const int n = (lane >> 2) + 16 * j; const LAS float* s = scr + (16 * c) * 33 + n;
            u32x4 o; o.x = pk4_i8(s[0 * 33], s[1 * 33], s[2 * 33], s[3 * 33]); o.y = pk4_i8(s[4 * 33], s[5 * 33], s[6 * 33], s[7 * 33]);
            o.z = pk4_i8(s[8 * 33], s[9 * 33], s[10 * 33], s[11 * 33]); o.w = pk4_i8(s[12 * 33], s[13 * 33], s[14 * 33], s[15 * 33]);
            *(u32x4*)(WT + (size_t)dstrow(n0 + n) * Ktot + k0 + 16 * c) = o; }
        LDS_WAIT(); asm volatile("" ::: "memory");
    }
}
__device__ __forceinline__ float wave_max(float v) {
#pragma unroll
    for (int off = 32; off > 0; off >>= 1) v = fmaxf(v, __shfl_xor(v, off));
    return v; }
__device__ __forceinline__ void absmax_cols(const Frame& F, const float* W, int K, int N, float* cmaxp, int wave0) {
    const int nblk = (N + 255) / 256, nitems = nblk * (K / 64);
    for (int it = F.gw >= wave0 ? F.gw - wave0 : F.gw - wave0 + F.NGW; it < nitems; it += F.NGW) { const int nb = it % nblk, kc = it / nblk, n = nb * 256 + 4 * F.lane;
        if (n < N) { const float* p = W + (size_t)(kc * 64) * N + n; f32x4 m = {0.f, 0.f, 0.f, 0.f};
#pragma unroll 32
            for (int k = 0; k < 64; ++k) { const f32x4 v = *(const f32x4*)(p + (size_t)k * N); m.x = fmaxf(m.x, fabsf(v.x)); m.y = fmaxf(m.y, fabsf(v.y)); m.z = fmaxf(m.z, fabsf(v.z)); m.w = fmaxf(m.w, fabsf(v.w)); }
            *(f32x4*)(cmaxp + kc * 12800 + n) = m; } }
}
struct SrcPlain { const float* W; int N, Nvalid; __device__ __forceinline__ float operator()(int k, int n) const { return n < Nvalid ? W[(size_t)k * N + n] : 0.f; } };
struct SrcUp { const float* Wq; const float* Wkv;
    __device__ __forceinline__ float operator()(int k, int n) const { if (k < 256) return n < 768 ? Wq[(size_t)k * 768 + n] : 0.f; return n >= 768 ? Wkv[(size_t)(k - 256) * 1024 + (n - 768)] : 0.f; } };
struct DstPlain { __device__ __forceinline__ int operator()(int n) const { return n; } };
struct DstGU { __device__ __forceinline__ int operator()(int n) const { const int u = n >= DFF ? 1 : 0, m = n - u * DFF; return 8 * (m >> 2) + 4 * u + (m & 3); } };

__device__ __forceinline__ void p0_prologue(const Frame& F) {
    absmax_cols(F, F.in[I_WINAB], 1024, 2000, (float*)(F.ws + WS_CMAXP) + 10752, 1400);
    transpose_items(F, 384, 1792, (bf16*)(F.ws + WS_W_UP), SrcUp{F.in[I_WUQ], F.in[I_WUKV]}, DstPlain{});
    transpose_items(F, 1024, 1024, (bf16*)(F.ws + WS_W_OUTAB), SrcPlain{F.in[I_WOUTAB], 1024, 1024}, DstPlain{});
    absmax_cols(F, F.in[I_FFNGU], 1024, 2 * DFF, (float*)(F.ws + WS_CMAXP) + 0, 0);
    absmax_cols(F, F.in[I_WINC], 1024, 5120, (float*)(F.ws + WS_CMAXP) + 5632, 700);
    __syncthreads();
    LAS float* sil = (LAS float*)F.lds;
    LAS float* red = (LAS float*)(F.lds + 16384);
    for (int i = F.tid; i < 3 * 1024; i += NTHREADS) { const int who = i >> 10, k = i & 1023; const float c = who < 2 ? F.in[I_C][who * 1024 + k] : F.in[I_CCTX][k]; sil[i] = siluf(c); }
    __syncthreads();
    for (int it = blockIdx.x; it < 2 * 96; it += F.G) {
        const int l = it / 96, col = (it % 96) * 64 + F.lane; const float* W = F.in[I_WMOD] + (size_t)l * 1024 * 6144 + col;
        float a0 = 0.f, a1 = 0.f, a2 = 0.f; const int kb = F.wave * 128;
#pragma unroll 1
        for (int k0 = 0; k0 < 128; k0 += 32) { float wv[32];
#pragma unroll
            for (int k = 0; k < 32; ++k) wv[k] = W[(size_t)(kb + k0 + k) * 6144];
#pragma unroll
            for (int k = 0; k < 32; ++k) { a0 += sil[kb + k0 + k] * wv[k]; a1 += sil[1024 + kb + k0 + k] * wv[k]; a2 += sil[2048 + kb + k0 + k] * wv[k]; } }
        red[(F.wave * 3 + 0) * 64 + F.lane] = a0; red[(F.wave * 3 + 1) * 64 + F.lane] = a1; red[(F.wave * 3 + 2) * 64 + F.lane] = a2;
        __syncthreads();
        if (F.wave < 3) { float s = 0.f;
#pragma unroll
            for (int w = 0; w < 8; ++w) s += red[(w * 3 + F.wave) * 64 + F.lane];
            ((float*)(F.ws + WS_MOD))[(size_t)(l * 3 + F.wave) * 6144 + col] = s + F.in[I_BMOD][l * 6144 + col]; }
        __syncthreads();
    }
    if (blockIdx.x == F.G - 1) for (int i = F.tid; i < 1024; i += NTHREADS) { const float l0 = F.in[I_LBLOG][i], l1 = F.in[I_LBLOG][1024 + i]; ((float*)(F.ws + WS_LB))[i] = 1.f / (1.f + expf(l0 - l1)); }
    if (blockIdx.x == F.G - 2) for (int i = F.tid; i < 256 * 16; i += NTHREADS) { const int pos = i >> 4, f = i & 15; const float inv = powf(10000.f, -(float)f / 16.f), a = (float)pos * inv;
        ((float*)(F.ws + WS_ROPE))[pos * 32 + f] = cosf(a); ((float*)(F.ws + WS_ROPE))[pos * 32 + 16 + f] = sinf(a); }
}

__device__ __forceinline__ void load_row_f32(const float* p, int lane, f32x4 (&v)[4]) {
#pragma unroll
    for (int j = 0; j < 4; ++j) v[j] = *((const f32x4*)p + lane + 64 * j);
}
__device__ __forceinline__ void load_row_bf16(const bf16* p, int lane, f32x4 (&v)[4]) {
#pragma unroll
    for (int j = 0; j < 4; ++j) { const u32x2 w = *((const u32x2*)p + lane + 64 * j); v[j] = (f32x4){bf2f(w.x & 0xffffu), bf2f(w.x >> 16), bf2f(w.y & 0xffffu), bf2f(w.y >> 16)}; }
}
__device__ __forceinline__ void load_row_raw(const bf16* p, int lane, u32x2 (&w)[4]) {
#pragma unroll
    for (int j = 0; j < 4; ++j) w[j] = *((const u32x2*)p + lane + 64 * j);
}
__device__ __forceinline__ void cvt_row(const u32x2 (&w)[4], f32x4 (&v)[4]) {
#pragma unroll
    for (int j = 0; j < 4; ++j) v[j] = (f32x4){bf2f(w[j].x & 0xffffu), bf2f(w[j].x >> 16), bf2f(w[j].y & 0xffffu), bf2f(w[j].y >> 16)};
}
__device__ __forceinline__ void store_res(bf16* xr, int idx, const f32x4 v) { u32x2 w; w.x = pk2(v.x, v.y); w.y = pk2(v.z, v.w); *((u32x2*)xr + idx) = w; }
__device__ __forceinline__ float row_rstd(const f32x4 (&v)[4]) { float s = 0.f;
#pragma unroll
    for (int j = 0; j < 4; ++j) s += (v[j].x * v[j].x + v[j].y * v[j].y) + (v[j].z * v[j].z + v[j].w * v[j].w);
    return rsqrtf(wave_sum(s) * (1.f / DM) + RMS_EPS); }
__device__ __forceinline__ void norm_mod_store(const f32x4 (&v)[4], const float* gain, const float* sh, const float* sc, bf16* orow, int lane) {
    const float rstd = row_rstd(v);
#pragma unroll
    for (int j = 0; j < 4; ++j) { const int idx = lane + 64 * j; const f32x4 g = ((const f32x4*)gain)[idx], a = ((const f32x4*)sh)[idx], c = ((const f32x4*)sc)[idx];
        const f32x4 h = (v[j] * rstd * g) * (1.f + c) + a;
        u32x2 w; w.x = pk2(h.x, h.y); w.y = pk2(h.z, h.w); *((u32x2*)orow + idx) = w; }
}
__device__ __forceinline__ void load_vec(const float* p, int lane, f32x4 (&v)[4]) {
#pragma unroll
    for (int j = 0; j < 4; ++j) v[j] = ((const f32x4*)p)[lane + 64 * j];
}
__device__ __forceinline__ int row_who(int row) { int b, j; row_decode(row, b, j); return j < CTXL ? 2 : b; }
template <bool I8OUT = false>
__device__ __forceinline__ void norm_mod_store_r(const f32x4 (&v)[4], const f32x4 (&g)[4], const f32x4 (&sh)[4], const f32x4 (&sc)[4], bf16* orow, int lane, float* sa = nullptr) {
    const float rstd = row_rstd(v);
    if (I8OUT) {
        f32x4 h[4]; float am = 0.f;
#pragma unroll
        for (int j = 0; j < 4; ++j) { h[j] = (v[j] * rstd * g[j]) * (1.f + sc[j]) + sh[j]; am = fmaxf(fmaxf(am, fmaxf(fabsf(h[j].x), fabsf(h[j].y))), fmaxf(fabsf(h[j].z), fabsf(h[j].w))); }
        am = fmaxf(wave_max(am), 1e-20f); const float qs = 127.f / am;
#pragma unroll
        for (int j = 0; j < 4; ++j) *((unsigned*)orow + lane + 64 * j) = pk4_i8(h[j].x * qs, h[j].y * qs, h[j].z * qs, h[j].w * qs);
        if (lane == 0) *sa = am * (1.f / 127.f);
    } else {
#pragma unroll
    for (int j = 0; j < 4; ++j) { const f32x4 h = (v[j] * rstd * g[j]) * (1.f + sc[j]) + sh[j];
        u32x2 w; w.x = pk2(h.x, h.y); w.y = pk2(h.z, h.w); *((u32x2*)orow + lane + 64 * j) = w; }
    }
}
__device__ __forceinline__ void p1_norm0(const Frame& F) {
    const float* gain = F.in[I_GAINS] + 0;
    f32x4 v[4], vn[4], vg[4], vsh[4], vsc[4]; int cur = -1; load_vec(gain, F.lane, vg); int row = F.gw; if (row < NR) load_row_f32(in_row(F, row), F.lane, v);
    while (row < NR) { const int nrow = row + F.NGW; if (nrow < NR) load_row_f32(in_row(F, nrow), F.lane, vn);
        { const int who = row_who(row); if (who != cur) { cur = who; load_vec(mod_vec(F, 0, row, 0), F.lane, vsh); load_vec(mod_vec(F, 0, row, 1), F.lane, vsc); } }
        norm_mod_store_r<true>(v, vg, vsh, vsc, (bf16*)(F.ws + WS_H + (size_t)row * DM), F.lane, (float*)(F.ws + WS_SA) + row);
#pragma unroll
        for (int j = 0; j < 4; ++j) v[j] = vn[j];
        row = nrow; }
    __syncthreads(); transpose_items_i8(F, 1024, 2048, F.ws + WS_W_INAB, SrcPlain{F.in[I_WINAB], 2000, 2000}, DstPlain{}, (const float*)(F.ws + WS_CMAXP) + 10752, (float*)(F.ws + WS_CTL) + CW_COLSC + 10752); __syncthreads();
}
template <bool FIRST, bool I8OUT = false>
__device__ __forceinline__ void resnorm_rows(const Frame& F, const bf16* Y, int layer_a, int gate_chunk, const float* gain_a, int layer_b, int sh_chunk, const float* gain_b, bf16* H, int mode  , int gw, int ngw) {
    u32x2 yw[4], ywn[4], xw[4], xwn[4]; f32x4 x[4], xn[4], vga[4], vgb[4], vgt[4], vsh[4], vsc[4]; int cur = -1;
    load_vec(gain_a, F.lane, vga); load_vec(gain_b, F.lane, vgb);
    int row = gw;
#define RN_SKIP(r) do { if (mode) { while ((r) < NR) { int b_, j_; row_decode((r), b_, j_); if ((mode == 1) == (j_ >= CTXL)) break; (r) += ngw; } } } while (0)
    RN_SKIP(row);
    if (row < NR) { load_row_raw(Y + (size_t)row * DM, F.lane, yw); if (FIRST) load_row_f32(in_row(F, row), F.lane, x); else load_row_raw(res_row(F, row), F.lane, xw); }
    while (row < NR) {
        int nrow = row + ngw;
        RN_SKIP(nrow);
        if (nrow < NR) { load_row_raw(Y + (size_t)nrow * DM, F.lane, ywn); if (FIRST) load_row_f32(in_row(F, nrow), F.lane, xn); else load_row_raw(res_row(F, nrow), F.lane, xwn); }
        f32x4 y[4]; cvt_row(yw, y); if (!FIRST) cvt_row(xw, x); bf16* xr = res_row(F, row);
        { const int who = row_who(row); if (who != cur) { cur = who; load_vec(mod_vec(F, layer_a, row, gate_chunk), F.lane, vgt); load_vec(mod_vec(F, layer_b, row, sh_chunk), F.lane, vsh); load_vec(mod_vec(F, layer_b, row, sh_chunk + 1), F.lane, vsc); } }
        const float rstd = row_rstd(y);
#pragma unroll
        for (int q = 0; q < 4; ++q) { const int idx = F.lane + 64 * q; x[q] = x[q] + vgt[q] * (y[q] * rstd * vga[q]); store_res(xr, idx, x[q]); }
        norm_mod_store_r<I8OUT>(x, vgb, vsh, vsc, I8OUT ? (bf16*)((unsigned char*)H + (size_t)row * DM) : H + (size_t)row * DM, F.lane, (float*)(F.ws + WS_SA) + row);
#pragma unroll
        for (int q = 0; q < 4; ++q) { yw[q] = ywn[q]; if (FIRST) x[q] = xn[q]; else xw[q] = xwn[q]; }
        row = nrow;
    }
#undef RN_SKIP
}
__device__ __forceinline__ void p3_prep(const Frame& F) {
    const bf16* P = (const bf16*)(F.ws + WS_P); bf16* A2 = (bf16*)(F.ws + WS_A2); bf16* KR = (bf16*)(F.ws + WS_KR); bf16* QKP = (bf16*)(F.ws + WS_QKP); float* GT = (float*)(F.ws + WS_GATES);
    const float* rope = (const float*)(F.ws + WS_ROPE); const int lane = F.lane;
    for (int row = F.gw; row < NR; row += F.NGW) {
        int b, j; row_decode(row, b, j); const bf16* pr = P + (size_t)row * P_LD;
        {
            const u32x2 w = *((const u32x2*)pr + lane); const f32x4 v = (f32x4){bf2f(w.x & 0xffffu), bf2f(w.x >> 16), bf2f(w.y & 0xffffu), bf2f(w.y >> 16)};
            const float rstd = rsqrtf(wave_sum(v.x * v.x + v.y * v.y + v.z * v.z + v.w * v.w) * (1.f / 256.f) + RMS_EPS); const f32x4 g = ((const f32x4*)F.in[I_QGAIN])[lane]; const f32x4 h = v * rstd * g;
            u32x2 o; o.x = pk2(h.x, h.y); o.y = pk2(h.z, h.w); *((u32x2*)(A2 + (size_t)row * 384) + lane) = o; }
        {
            const unsigned w = *((const unsigned*)(pr + 256) + lane); const float v0 = bf2f(w & 0xffffu), v1 = bf2f(w >> 16);
            const float rstd = rsqrtf(wave_sum(v0 * v0 + v1 * v1) * (1.f / 128.f) + RMS_EPS); const float g0 = F.in[I_KVGAIN][2 * lane], g1 = F.in[I_KVGAIN][2 * lane + 1];
            *((unsigned*)(A2 + (size_t)row * 384 + 256) + lane) = pk2(v0 * rstd * g0, v1 * rstd * g1); }
        {
            if (lane < 32) { float x1 = bf2f(pr[384 + lane]), x2 = bf2f(pr[384 + 32 + lane]);
                if (j >= CTXL) { const int t = j - CTXL; const int pos = lane < 16 ? (t >> 6) : (t & 63), f = lane & 15; const float c = rope[pos * 32 + f], s = rope[pos * 32 + 16 + f];
                    const float o1 = x1 * c - x2 * s, o2 = x2 * c + x1 * s; x1 = o1; x2 = o2; }
                bf16* kr = KR + (size_t)row * 64; kr[lane] = (bf16)f2bf(x1); kr[32 + lane] = (bf16)f2bf(x2); } }
        {
            const bool hasp = (j != 0) && (j != CTXL), hasn = (j != CTXL - 1) && (j != NT - 1);
            const bf16x8 xc = *((const bf16x8*)(pr + 448) + lane); bf16x8 xp = {}, xn = {};
            if (hasp) xp = *((const bf16x8*)(pr - P_LD + 448) + lane);
            if (hasn) xn = *((const bf16x8*)(pr + P_LD + 448) + lane);
            const float* cw = F.in[I_CONVW]; const float* cb = F.in[I_CONVB]; const float ksc = lane >= 32 ? 0.125f : 1.f; unsigned o[4];
#pragma unroll
            for (int e = 0; e < 8; e += 2) { float r[2];
#pragma unroll
                for (int q = 0; q < 2; ++q) { const int ch = lane * 8 + e + q;
                    const float a = cw[ch] * bf2f((unsigned short)xp[e + q]) + cw[512 + ch] * bf2f((unsigned short)xc[e + q]) + cw[1024 + ch] * bf2f((unsigned short)xn[e + q]) + cb[ch];
                    r[q] = siluf(a) * ksc; }
                o[e >> 1] = pk2(r[0], r[1]); }
            *((u32x4*)(QKP + (size_t)row * 512) + lane) = (u32x4){o[0], o[1], o[2], o[3]}; }
        {
            if (lane < 16) { float g = GT[(size_t)row * 16 + lane] + F.in[I_GATEB][lane]; const int gi = lane >> 2; if (gi & 1) g = logsig(g); ((float*)(F.ws + WS_GL))[(size_t)row * 16 + lane] = g; } }
    }
}

namespace lin {
using att::crow; using att::cvtpk;
__device__ __forceinline__ float wave_prefix_add(float v, int lane) {
#pragma unroll
    for (int o = 1; o < 64; o <<= 1) { const float t = __shfl_up(v, o); if (lane >= o) v += t; }
    return v; }
__device__ __forceinline__ float wave_suffix_add(float v, int lane) {
#pragma unroll
    for (int o = 1; o < 64; o <<= 1) { const float t = __shfl_down(v, o); if (lane + o < 64) v += t; }
    return v; }
__device__ __forceinline__ float wave_prefix_max(float v, int lane) {
#pragma unroll
    for (int o = 1; o < 64; o <<= 1) { const float t = __shfl_up(v, o); if (lane >= o) v = fmaxf(v, t); }
    return v; }
__device__ __forceinline__ float wave_suffix_max(float v, int lane) {
#pragma unroll
    for (int o = 1; o < 64; o <<= 1) { const float t = __shfl_down(v, o); if (lane + o < 64) v = fmaxf(v, t); }
    return v; }
__device__ __forceinline__ float wave_max(float v) {
#pragma unroll
    for (int o = 1; o < 64; o <<= 1) v = fmaxf(v, __shfl_xor(v, o));
    return v; }
__device__ __forceinline__ unsigned voff(unsigned row, unsigned ch) { return 256u * row + 16u * (ch ^ (((row & 3u) << 2) | ((row >> 2) & 3u))); }
__device__ __forceinline__ unsigned v_tr_addr(unsigned lane, unsigned row0, unsigned c, unsigned t) {
    const unsigned h = lane >> 5, blk = (lane >> 4) & 1u, q = (lane & 15u) >> 2, p = lane & 3u;
    return voff(row0 + 8u * h + 4u * t + q, 4u * c + 2u * blk + (p >> 1)) + 8u * (p & 1u); }
__device__ __forceinline__ unsigned p_tr_addr(unsigned lane, unsigned pitchB, unsigned row0, unsigned c, unsigned t) {
    const unsigned h = lane >> 5, blk = (lane >> 4) & 1u, q = (lane & 15u) >> 2, p = lane & 3u;
    return (row0 + 8u * h + 4u * t + q) * pitchB + c * 64u + blk * 32u + p * 8u; }
__device__ __forceinline__ bf16x8 tr_frag(LAS unsigned char* base, unsigned a0, unsigned a1) {
    const s16x4 lo = __builtin_amdgcn_ds_read_tr16_b64_v4i16((LAS s16x4*)(base + a0)), hi = __builtin_amdgcn_ds_read_tr16_b64_v4i16((LAS s16x4*)(base + a1));
    return (bf16x8){lo[0], lo[1], lo[2], lo[3], hi[0], hi[1], hi[2], hi[3]}; }
#define LPK4(P, BASE, OUT) do { unsigned a0 = cvtpk(P[BASE + 0], P[BASE + 1]), a1 = cvtpk(P[BASE + 2], P[BASE + 3]);   \
    unsigned b0 = cvtpk(P[BASE + 4], P[BASE + 5]), b1 = cvtpk(P[BASE + 6], P[BASE + 7]);                              \
    auto r0 = __builtin_amdgcn_permlane32_swap(a0, b0, false, false); auto r1 = __builtin_amdgcn_permlane32_swap(a1, b1, false, false); \
    u32x4 w = {r0[0], r1[0], r0[1], r1[1]}; OUT = *reinterpret_cast<bf16x8*>(&w); } while (0)
__device__ __forceinline__ float half_sum32(float v) {
#pragma unroll
    for (int o = 1; o < 32; o <<= 1) v += __shfl_xor(v, o);
    return v; }
__device__ __forceinline__ float swap_add(float v) { auto rr = __builtin_amdgcn_permlane32_swap(__float_as_uint(v), __float_as_uint(v), false, false); return __uint_as_float(rr[0]) + __uint_as_float(rr[1]); }
}

namespace ml {
using att::cvtpk;
constexpr int ITEM_U = 8448;
constexpr int ITEM_S = 16896;
constexpr int L_V = 0, L_K = 65536, L_SC = 98304, L_WS = 98304 + 8192, L_CT = 98304 + 8192 + 1024;

__device__ __forceinline__ void load_gates(const float* GT, int row0, int h, int dir, int lane, float (&li)[4], float (&lf)[4]) {
#pragma unroll
    for (int i = 0; i < 4; ++i) { const float* g = GT + (size_t)(row0 + 4 * lane + i) * 16; li[i] = g[(2 * dir) * 4 + h]; lf[i] = g[(2 * dir + 1) * 4 + h]; }
}
__device__ __forceinline__ float cum_gates(const float (&lf)[4], int dir, int lane, float (&G)[4]) {
    float tot;
    if (dir == 0) { G[0] = lf[0]; G[1] = G[0] + lf[1]; G[2] = G[1] + lf[2]; G[3] = G[2] + lf[3]; const float inc = lin::wave_prefix_add(G[3], lane), ex = inc - G[3];
#pragma unroll
        for (int i = 0; i < 4; ++i) G[i] += ex;
        tot = __shfl(inc, 63); }
    else { G[3] = lf[3]; G[2] = G[3] + lf[2]; G[1] = G[2] + lf[1]; G[0] = G[1] + lf[0]; const float inc = lin::wave_suffix_add(G[0], lane), ex = inc - G[0];
#pragma unroll
        for (int i = 0; i < 4; ++i) G[i] += ex;
        tot = __shfl(inc, 0); }
    return tot;
}

__device__ __forceinline__ void pass_b(const Frame& F) {
    const bf16* P = (const bf16*)(F.ws + WS_P); const bf16* QKP = (const bf16*)(F.ws + WS_QKP); const float* GT = (const float*)(F.ws + WS_GL); float* MLU = (float*)(F.ws + WS_MLU);
    LAS unsigned char* Vl = F.lds + L_V; LAS unsigned char* Kl = F.lds + L_K; LAS float* wts = (LAS float*)(F.lds + L_SC); LAS float* part = (LAS float*)(F.lds + L_SC + 2048);
    const int tid = F.tid, lane = F.lane, wave = F.wave;
    for (int it = blockIdx.x; it < 16 * NGRP; it += F.G) {
        const int seq = it / NGRP, g = it - seq * NGRP, dir = seq & 1, h = (seq >> 1) & 3, b = seq >> 3, row0 = b * NT + g * 256;
        float* rec = MLU + (size_t)it * ITEM_U;
        __syncthreads();
        if (wave == 0) { float li[4], lf[4], G[4]; load_gates(GT, row0, h, dir, lane, li, lf); const float tot = cum_gates(lf, dir, lane, G);
            float e[4], mx = -3.0e38f;
#pragma unroll
            for (int i = 0; i < 4; ++i) { e[i] = li[i] + tot - G[i]; mx = fmaxf(mx, e[i]); }
            mx = lin::wave_max(mx);
#pragma unroll
            for (int i = 0; i < 4; ++i) wts[4 * lane + i] = __expf(e[i] - mx);
            if (lane == 0) { rec[8192 + 64] = mx; rec[8192 + 65] = tot; } }
        { const bf16* vb_ = P + (size_t)row0 * P_LD + 960 + h * 128;
#pragma unroll
            for (int c = 0; c < 8; ++c) { const int idx = c * 512 + tid, r = idx >> 4, ch = idx & 15; *(LAS bf16x8*)(Vl + (r >> 6) * 16384 + att::v_st(r & 63, ch * 8)) = *((const bf16x8*)(vb_ + (size_t)r * P_LD) + ch); } }
        __syncthreads();
        { const bf16* kb_ = QKP + (size_t)row0 * 512 + 256 + h * 64;
#pragma unroll
            for (int c = 0; c < 4; ++c) { const int idx = c * 512 + tid, r = idx >> 3, c0 = (idx & 7) * 8; const float w = wts[r]; const bf16x8 kv = *(const bf16x8*)(kb_ + (size_t)r * 512 + c0); u32x4 o;
                o.x = pk2(bf2f((unsigned short)kv[0]) * w, bf2f((unsigned short)kv[1]) * w); o.y = pk2(bf2f((unsigned short)kv[2]) * w, bf2f((unsigned short)kv[3]) * w);
                o.z = pk2(bf2f((unsigned short)kv[4]) * w, bf2f((unsigned short)kv[5]) * w); o.w = pk2(bf2f((unsigned short)kv[6]) * w, bf2f((unsigned short)kv[7]) * w);
                *(LAS u32x4*)(Kl + r * 128 + c0 * 2) = o; } }
        __syncthreads();
        { const int ei = wave >> 1, di = wave & 1; f32x16 acc = {}; const int vbase = att::v_rd_base(lane);
#pragma unroll
            for (int ks = 0; ks < 16; ++ks) {
                const bf16x8 a = lin::tr_frag(Vl + vbase + (ks >> 2) * 16384, ei * 512 + (ks & 3) * 4096, ei * 512 + (ks & 3) * 4096 + 2048);
                const bf16x8 bb = lin::tr_frag(Kl, lin::p_tr_addr(lane, 128, 16 * ks, di, 0), lin::p_tr_addr(lane, 128, 16 * ks, di, 1));
                acc = __builtin_amdgcn_mfma_f32_32x32x16_bf16(a, bb, acc, 0, 0, 0); }
            const int hi = lane >> 5;
#pragma unroll
            for (int r = 0; r < 16; ++r) rec[(32 * ei + lin::crow(r, hi)) * 64 + 32 * di + (lane & 31)] = acc[r]; }
        { const int d = tid & 63, sg = tid >> 6; float s = 0.f;
#pragma unroll 8
            for (int r = 0; r < 32; ++r) s += bf2f(*(LAS unsigned short*)(Kl + (sg * 32 + r) * 128 + d * 2));
            part[sg * 64 + d] = s; }
        __syncthreads();
        if (tid < 64) { float s = 0.f;
#pragma unroll
            for (int sg = 0; sg < 8; ++sg) s += part[sg * 64 + tid];
            rec[8192 + tid] = s; }
    }
}

__device__ __forceinline__ void pass_c(const Frame& F) {
    const float* __restrict__ MLU = (const float*)(F.ws + WS_MLU); unsigned char* __restrict__ MLS = F.ws + WS_MLS;
    for (int wgi = blockIdx.x; wgi < 16 * 16; wgi += F.G) {
        const int seq = wgi >> 4, part = wgi & 15, dir = seq & 1, el = part * 512 + F.tid;
        const bool do_n = (part == 0) && (F.tid < 64);
        float c = 0.f, n = 0.f, m = -1.0e30f;
#pragma unroll 1
        for (int blk = 0; blk < 5; ++blk) {
            float u[13], nu[13], mU[13], D[13];
#pragma unroll
            for (int i = 0; i < 13; ++i) { const int st = blk * 13 + i, g = dir == 0 ? st : (st == 0 ? 0 : NGRP - st); const float* rec = MLU + (size_t)(seq * NGRP + g) * ITEM_U;
                mU[i] = rec[8192 + 64]; D[i] = rec[8192 + 65]; u[i] = rec[el]; nu[i] = do_n ? rec[8192 + F.tid] : 0.f; }
#pragma unroll
            for (int i = 0; i < 13; ++i) { const int st = blk * 13 + i, g = dir == 0 ? st : (st == 0 ? 0 : NGRP - st); unsigned char* srec = MLS + (size_t)(seq * NGRP + g) * ITEM_S;
                ((bf16*)srec)[el] = (bf16)f2bf(c);
                if (do_n) ((float*)(srec + 16384))[F.tid] = n;
                if (part == 0 && F.tid == 0) *(float*)(srec + 16384 + 256) = m;
                const float mn = fmaxf(m + D[i], mU[i]), f1 = __expf(m + D[i] - mn), f2 = __expf(mU[i] - mn);
                c = f1 * c + f2 * u[i]; n = f1 * n + f2 * nu[i]; m = mn; }
        }
    }
}

__device__ __forceinline__ void pass_d(const Frame& F) {
    const bf16* P = (const bf16*)(F.ws + WS_P); const bf16* QKP = (const bf16*)(F.ws + WS_QKP); const float* GT = (const float*)(F.ws + WS_GL);
    const unsigned char* MLS = F.ws + WS_MLS; bf16* CAT = (bf16*)(F.ws + WS_CAT);
    LAS unsigned char* Vl = F.lds + L_V; LAS unsigned char* Kl = F.lds + L_K; LAS float* sc = (LAS float*)(F.lds + L_SC);
    const int tid = F.tid, lane = F.lane, wave = F.wave, t32 = lane & 31, hi = lane >> 5;
    LAS float* wsc = (LAS float*)(F.lds + L_WS) + wave * 32;
    for (int it = blockIdx.x; it < 8 * NGRP; it += F.G) {
        const int bh = it / NGRP, g = it - bh * NGRP, b = bh >> 2, h = bh & 3, row0 = b * NT + g * 256;
        __syncthreads();
        if (wave < 2) { const int dir = wave; const unsigned char* srec = MLS + (size_t)((bh * 2 + dir) * NGRP + g) * ITEM_S; const float mg = *(const float*)(srec + 16384 + 256);
            float li[4], lf[4], G[4]; load_gates(GT, row0, h, dir, lane, li, lf); (void)cum_gates(lf, dir, lane, G);
            float a[4], M[4];
#pragma unroll
            for (int i = 0; i < 4; ++i) a[i] = li[i] - G[i];
            if (dir == 0) { M[0] = a[0]; M[1] = fmaxf(M[0], a[1]); M[2] = fmaxf(M[1], a[2]); M[3] = fmaxf(M[2], a[3]);
                const float inc = lin::wave_prefix_max(M[3], lane); float ex = __shfl_up(inc, 1); if (lane == 0) ex = -3.0e38f; ex = fmaxf(ex, mg);
#pragma unroll
                for (int i = 0; i < 4; ++i) M[i] = fmaxf(M[i], ex); }
            else { M[3] = a[3]; M[2] = fmaxf(M[3], a[2]); M[1] = fmaxf(M[2], a[1]); M[0] = fmaxf(M[1], a[0]);
                const float inc = lin::wave_suffix_max(M[0], lane); float ex = __shfl_down(inc, 1); if (lane == 63) ex = -3.0e38f; ex = fmaxf(ex, mg);
#pragma unroll
                for (int i = 0; i < 4; ++i) M[i] = fmaxf(M[i], ex); }
            LAS float* s = sc + dir * 1024;
#pragma unroll
            for (int i = 0; i < 4; ++i) { const int r = 4 * lane + i; s[r] = a[i]; s[256 + r] = M[i]; s[512 + r] = __expf(-G[i] - M[i]); s[768 + r] = __expf(mg - M[i]); } }
        {
#pragma unroll 1
            for (int dd = 0; dd < 2; ++dd) { const bf16x8* src = (const bf16x8*)(MLS + (size_t)((bh * 2 + dd) * NGRP + g) * ITEM_S);
#pragma unroll
                for (int c = 0; c < 2; ++c) *(LAS bf16x8*)(F.lds + L_CT + dd * 16384 + tid * 32 + c * 16) = src[tid * 2 + c]; } }
        __builtin_amdgcn_sched_barrier(0);
        { const int r = tid >> 1, c0 = (tid & 1) * 8; const bf16* vp = P + (size_t)(row0 + r) * P_LD + 960 + h * 128 + c0 * 8;
#pragma unroll
            for (int c = 0; c < 8; ++c) *(LAS bf16x8*)(Vl + (r >> 6) * 16384 + att::v_st(r & 63, (c0 + c) * 8)) = *((const bf16x8*)vp + c);
            const int k0 = (tid & 1) * 4; const bf16* kp = QKP + (size_t)(row0 + r) * 512 + 256 + h * 64 + k0 * 8;
#pragma unroll
            for (int c = 0; c < 4; ++c) *(LAS bf16x8*)(Kl + r * 128 + (((k0 + c) ^ (r & 7)) << 4)) = *((const bf16x8*)kp + c); }
        __syncthreads();
        const int I = wave < 4 ? wave : 11 - wave, trow = 32 * I + t32, vbase = att::v_rd_base(lane);
        bf16x8 qr[4];
        { const bf16* qp = QKP + (size_t)(row0 + trow) * 512 + h * 64 + hi * 8;
#pragma unroll
            for (int kk = 0; kk < 4; ++kk) qr[kk] = *(const bf16x8*)(qp + kk * 16); }
        u32x2 hpk[4][4];
        f32x16 o[4];
#pragma unroll 1
        for (int dir = 0; dir < 2; ++dir) {
            const LAS float* s = sc + dir * 1024; const float Mt = s[256 + trow];
#pragma unroll
            for (int c = 0; c < 4; ++c) o[c] = f32x16{};
            float den = 0.f;
            const int Jlo = dir == 0 ? 0 : I, Jhi = dir == 0 ? I : 7;
#pragma unroll 1
            for (int J = Jlo; J <= Jhi; ++J) {
                f32x16 p = {};
#pragma unroll
                for (int kk = 0; kk < 4; ++kk) { const int kr = 32 * J + t32; const bf16x8 kf = *(LAS bf16x8*)(Kl + kr * 128 + (((2 * kk + hi) ^ (kr & 7)) << 4));
                    p = __builtin_amdgcn_mfma_f32_32x32x16_bf16(kf, qr[kk], p, 0, 0, 0); }
                const bool diag = (J == I);
#pragma unroll
                for (int r = 0; r < 16; ++r) { const int sl = lin::crow(r, hi); const float w = __expf(s[32 * J + sl] - Mt);
                    const bool keep = !diag || (dir == 0 ? (sl <= t32) : (sl >= t32)); p[r] = keep ? p[r] * w : 0.f; den += p[r]; }
                bf16x8 pa0, pa1; LPK4(p, 0, pa0); LPK4(p, 8, pa1);
                LAS unsigned char* vj = Vl + vbase + (J >> 1) * 16384 + (J & 1) * 8192;
#pragma unroll
                for (int c = 0; c < 4; ++c) {
                    const bf16x8 v0 = lin::tr_frag(vj, c * 512, c * 512 + 2048);
                    const bf16x8 v1 = lin::tr_frag(vj, c * 512 + 4096, c * 512 + 4096 + 2048);
                    o[c] = __builtin_amdgcn_mfma_f32_32x32x16_bf16(pa0, v0, o[c], 0, 0, 0);
                    o[c] = __builtin_amdgcn_mfma_f32_32x32x16_bf16(pa1, v1, o[c], 0, 0, 0); }
            }
            { const unsigned char* srec = MLS + (size_t)((bh * 2 + dir) * NGRP + g) * ITEM_S; const float* nv = (const float*)(srec + 16384);
                const float wi = s[768 + trow]; float dn = 0.f;
#pragma unroll
                for (int kk = 0; kk < 4; ++kk) { float qf[8];
#pragma unroll
                    for (int e = 0; e < 8; ++e) { qf[e] = bf2f((unsigned short)qr[kk][e]); dn += qf[e] * nv[kk * 16 + hi * 8 + e]; qf[e] *= wi; }
                    u32x4 w = {cvtpk(qf[0], qf[1]), cvtpk(qf[2], qf[3]), cvtpk(qf[4], qf[5]), cvtpk(qf[6], qf[7])}; const bf16x8 aq = *reinterpret_cast<bf16x8*>(&w);
#pragma unroll
                    for (int c = 0; c < 4; ++c) { const int e_ = 32 * c + t32; const bf16x8 cf = *(LAS bf16x8*)(F.lds + L_CT + dir * 16384 + e_ * 128 + (2 * kk + hi) * 16);
                        o[c] = __builtin_amdgcn_mfma_f32_32x32x16_bf16(aq, cf, o[c], 0, 0, 0); } }
                den += wi * dn; }
            den = lin::swap_add(den);
            const float inv = 1.f / fmaxf(fabsf(den), s[512 + trow]);
            if (hi == 0) wsc[t32] = inv;
            LDS_WAIT(); asm volatile("" ::: "memory");
            if (dir == 0) {
#pragma unroll
                for (int r = 0; r < 16; r += 4) { const float i0 = wsc[lin::crow(r, hi)], i1 = wsc[lin::crow(r + 1, hi)], i2 = wsc[lin::crow(r + 2, hi)], i3 = wsc[lin::crow(r + 3, hi)];
#pragma unroll
                    for (int c = 0; c < 4; ++c) { hpk[c][r >> 2].x = cvtpk(o[c][r] * i0, o[c][r + 1] * i1); hpk[c][r >> 2].y = cvtpk(o[c][r + 2] * i2, o[c][r + 3] * i3); } }
            } else {
#pragma unroll
                for (int r = 0; r < 16; r += 4) { const float i0 = wsc[lin::crow(r, hi)], i1 = wsc[lin::crow(r + 1, hi)], i2 = wsc[lin::crow(r + 2, hi)], i3 = wsc[lin::crow(r + 3, hi)];
#pragma unroll
                    for (int c = 0; c < 4; ++c) { const u32x2 hp = hpk[c][r >> 2];
                        o[c][r] = o[c][r] * i0 + bf2f(hp.x & 0xffffu); o[c][r + 1] = o[c][r + 1] * i1 + bf2f(hp.x >> 16);
                        o[c][r + 2] = o[c][r + 2] * i2 + bf2f(hp.y & 0xffffu); o[c][r + 3] = o[c][r + 3] * i3 + bf2f(hp.y >> 16); } }
            }
            LDS_WAIT(); asm volatile("" ::: "memory");
        }
        const float* hg = F.in[I_MLGAIN] + h * 128;
        int lane_r = F.lane; asm volatile("" : "+v"(lane_r)); const int t32r = lane_r & 31, hir = lane_r >> 5;
#pragma unroll
        for (int r = 0; r < 16; ++r) { float ss = 0.f;
#pragma unroll
            for (int c = 0; c < 4; ++c) ss += o[c][r] * o[c][r];
            ss = lin::half_sum32(ss); const float rstd = rsqrtf(ss * (1.f / 128.f) + RMS_EPS); const int row = row0 + 32 * I + lin::crow(r, hir);
            const bf16* op = P + (size_t)row * P_LD + 1472 + h * 128; bf16* cp = CAT + (size_t)row * DM + 512 + h * 128;
#pragma unroll
            for (int c = 0; c < 4; ++c) { const int e = 32 * c + t32r; cp[e] = (bf16)f2bf(o[c][r] * rstd * hg[e] * sigm(bf2f(op[e]))); }
            __builtin_amdgcn_sched_barrier(0); }
    }
}
}

namespace hg {
using att::cvtpk;
constexpr size_t WS_HGD = 3 * MiB;
constexpr size_t WS_QT = WS_D;
constexpr int L_V = 0, L_K = 65536, L_ET = 131072, L_WS = 131072 + 4096;
#define K256(row, colB) ((row) * 256 + ((colB) ^ (((row) & 7) << 4)))

struct Cols { const bf16* pc; const float* lb; int h, dir; };
__device__ __forceinline__ void fk(float z, float lb, float& logf, float& k) { const float sg = __builtin_amdgcn_rcpf(1.f + __expf(-z)); logf = __logf(lb + (1.f - lb) * sg); k = (1.f - lb) * (1.f - sg); }
__device__ __forceinline__ void ffk(float z, float lb, float& f, float& k) { const float sg = __builtin_amdgcn_rcpf(1.f + __expf(-z)); f = lb + (1.f - lb) * sg; k = (1.f - lb) * (1.f - sg); }

__device__ __forceinline__ int vimg(int row, int c) { return (row >> 6) * 16384 + att::v_st(row & 63, c); }
__device__ __forceinline__ void pass_b(const Frame& F) {
    const bf16* PC = (const bf16*)(F.ws + WS1_PC); const float* LB = (const float*)(F.ws + WS_LB); bf16* U = (bf16*)(F.ws + WS1_U); float* HGD = (float*)(F.ws + WS_HGD);
    LAS unsigned char* Vl = F.lds + L_V; LAS unsigned char* Kl = F.lds + L_K; LAS float* tot = (LAS float*)(F.lds + L_ET);
    const int wave = F.wave;
    bf16x8 vv[8], zz[8];
#define HGB_FETCH(item) do { const int seq_ = (item) / NGRP, g_ = (item) - seq_ * NGRP, dir_ = seq_ & 1, h_ = (seq_ >> 1) & 7, b_ = seq_ >> 4, row0_ = b_ * NT + g_ * 256; \
        const bf16* vb_ = PC + (size_t)row0_ * 5120 + 3072 + h_ * 128; const bf16* zb_ = PC + (size_t)row0_ * 5120 + 1024 * (1 + dir_) + h_ * 128; \
        _Pragma("unroll") for (int c = 0; c < 8; ++c) { const unsigned off = (unsigned)(F.tid >> 4) * 10240u + (unsigned)(F.tid & 15) * 16u + (unsigned)c * 327680u; vv[c] = *(const bf16x8*)((const char*)vb_ + off); zz[c] = *(const bf16x8*)((const char*)zb_ + off); } } while (0)
    if ((int)blockIdx.x < 32 * NGRP) HGB_FETCH((int)blockIdx.x);
    for (int it = blockIdx.x; it < 32 * NGRP; it += F.G) {
        const int seq = it / NGRP, g = it - seq * NGRP, dir = seq & 1, h = (seq >> 1) & 7;
        int tid = F.tid, lane = F.lane; asm volatile("" : "+v"(tid), "+v"(lane));
        __syncthreads();
#pragma unroll
        for (int c = 0; c < 8; ++c) { const int idx = c * 512 + tid, r = idx >> 4, ch = idx & 15; const int o = vimg(r, ch * 8); *(LAS bf16x8*)(Vl + o) = vv[c]; *(LAS bf16x8*)(Kl + o) = zz[c]; }
        if (it + F.G < 32 * NGRP) HGB_FETCH(it + F.G);
        __syncthreads();
        const int d = tid & 127, sg = tid >> 7; const float lb = LB[h * 128 + d];
        { float acc = 1.f;
#pragma unroll 4
            for (int i = 0; i < 64; ++i) { const int row = sg * 64 + (dir == 0 ? 63 - i : i); LAS unsigned short* p = (LAS unsigned short*)(Kl + vimg(row, d));
                const float k = bf2f(*p); *p = (unsigned short)f2bf(k * acc); acc *= (1.f - k); }
            tot[sg * 128 + d] = acc; }
        __syncthreads();
        if (sg == 0) HGD[(size_t)it * 128 + d] = (tot[d] * tot[128 + d]) * (tot[256 + d] * tot[384 + d]);
        { const int ei = wave >> 1, dj = 2 * (wave & 1), vb = att::v_rd_base(lane), hi = lane >> 5, d0 = 32 * dj + (lane & 31), d1 = d0 + 32; f32x16 a0 = {}, a1 = {};
#pragma unroll
            for (int sgm = 0; sgm < 4; ++sgm) { f32x16 s0 = {}, s1 = {};
#pragma unroll
                for (int k4 = 0; k4 < 4; ++k4) { const int to = sgm * 16384 + k4 * 4096;
                    const bf16x8 a = lin::tr_frag(Vl + vb + to, ei * 512, ei * 512 + 2048);
                    const bf16x8 b0 = lin::tr_frag(Kl + vb + to, dj * 512, dj * 512 + 2048), b1 = lin::tr_frag(Kl + vb + to, (dj + 1) * 512, (dj + 1) * 512 + 2048);
                    s0 = __builtin_amdgcn_mfma_f32_32x32x16_bf16(a, b0, s0, 0, 0, 0); s1 = __builtin_amdgcn_mfma_f32_32x32x16_bf16(a, b1, s1, 0, 0, 0); }
                float f0 = 1.f, f1 = 1.f;
                if (dir == 0) { for (int s2 = sgm + 1; s2 < 4; ++s2) { f0 *= tot[s2 * 128 + d0]; f1 *= tot[s2 * 128 + d1]; } } else { for (int s2 = 0; s2 < sgm; ++s2) { f0 *= tot[s2 * 128 + d0]; f1 *= tot[s2 * 128 + d1]; } }
#pragma unroll
                for (int r = 0; r < 16; ++r) { a0[r] += s0[r] * f0; a1[r] += s1[r] * f1; } }
            bf16* rec = U + (size_t)it * 16384;
#pragma unroll
            for (int r = 0; r < 16; ++r) { bf16* p = rec + (32 * ei + lin::crow(r, hi)) * 128 + 32 * dj + (lane & 31); p[0] = (bf16)f2bf(a0[r]); p[32] = (bf16)f2bf(a1[r]); } }
    }
}

#undef HGB_FETCH
__device__ __forceinline__ void pass_c(const Frame& F) {
    const unsigned* __restrict__ U2 = (const unsigned*)(F.ws + WS1_U); const float* __restrict__ HGD = (const float*)(F.ws + WS_HGD); unsigned* __restrict__ S2 = (unsigned*)(F.ws + WS1_S);
    for (int wgi = blockIdx.x; wgi < 32 * 16; wgi += F.G) {
        const int seq = wgi >> 4, part = wgi & 15, dir = seq & 1, pr = part * 512 + F.tid, d = (2 * pr) & 127;
        float c0 = 0.f, c1 = 0.f;
#pragma unroll 1
        for (int blk = 0; blk < 5; ++blk) {
            unsigned u[13]; float dg0[13], dg1[13];
#pragma unroll
            for (int i = 0; i < 13; ++i) { const int st = blk * 13 + i, g = dir == 0 ? st : (st == 0 ? 0 : NGRP - st); const size_t ix = (size_t)(seq * NGRP + g);
                u[i] = U2[ix * 8192 + pr]; const float* hp = HGD + ix * 128 + d; dg0[i] = hp[0]; dg1[i] = hp[1]; }
#pragma unroll
            for (int i = 0; i < 13; ++i) { const int st = blk * 13 + i, g = dir == 0 ? st : (st == 0 ? 0 : NGRP - st); const size_t ix = (size_t)(seq * NGRP + g);
                S2[ix * 8192 + pr] = pk2(c0, c1); c0 = dg0[i] * c0 + bf2f(u[i] & 0xffffu); c1 = dg1[i] * c1 + bf2f(u[i] >> 16); }
        }
    }
}

__device__ __forceinline__ void pass_d(const Frame& F) {
    const bf16* PC = (const bf16*)(F.ws + WS1_PC); const float* LB = (const float*)(F.ws + WS_LB); const bf16* S = (const bf16*)(F.ws + WS1_S); bf16* CAT = (bf16*)(F.ws + WS1_CAT);
    bf16* QT = (bf16*)(F.ws + WS_QT) + (size_t)blockIdx.x * 32768;
    LAS unsigned char* Vl = F.lds + L_V; LAS unsigned char* Kl = F.lds + L_K; LAS float* ET = (LAS float*)(F.lds + L_ET);
    const int tid = F.tid, lane = F.lane, wave = F.wave, t32 = lane & 31, hi = lane >> 5, vb = att::v_rd_base(lane);
    for (int it = blockIdx.x; it < 16 * 64; it += F.G) {
        const int bh = it >> 6, g = (it & 63) + 1, b = bh >> 3, h = bh & 7, row0 = b * NT + g * 256;
        const int I = wave < 4 ? wave : 11 - wave, trow = 32 * I + t32;
        f32x16 o[4] = {};
#pragma unroll 1
        for (int dir = 0; dir < 2; ++dir) {
            __syncthreads();
            {
                const bf16* zb_ = PC + (size_t)row0 * 5120 + 1024 * (1 + dir) + h * 128; const bf16* qb_ = PC + (size_t)row0 * 5120 + h * 128;
#pragma unroll 1
                for (int c0 = 0; c0 < 8; c0 += 4) {
                    bf16x8 zz[4], qq[4];
#pragma unroll
                    for (int c = 0; c < 4; ++c) { const unsigned off = (unsigned)(tid >> 4) * 10240u + (unsigned)(tid & 15) * 16u + (unsigned)(c0 + c) * 327680u;
                        zz[c] = *(const bf16x8*)((const char*)zb_ + off); qq[c] = *(const bf16x8*)((const char*)qb_ + off); }
#pragma unroll
                    for (int c = 0; c < 4; ++c) { const int idx = (c0 + c) * 512 + tid, r = idx >> 4, ch = idx & 15; *(LAS bf16x8*)(Kl + K256(r, ch * 16)) = zz[c]; *(LAS bf16x8*)(Vl + r * 256 + ch * 16) = qq[c]; } } }
            __syncthreads();
            {
                const int d = tid & 127; const float lb = LB[h * 128 + d];
#pragma unroll 1
                for (int q2 = 0; q2 < 2; ++q2) { const int B = (tid >> 7) + 4 * q2; float x = 1.f;
#pragma unroll 4
                    for (int i = 0; i < 32; ++i) { const int row = 32 * B + (dir == 0 ? i : 31 - i);
                        LAS unsigned short* zp = (LAS unsigned short*)(Kl + K256(row, d * 2)); LAS unsigned short* qp = (LAS unsigned short*)(Vl + row * 256 + d * 2);
                        const float k = bf2f(*zp); x *= (1.f - k);
                        *zp = (unsigned short)f2bf(k * __builtin_amdgcn_rcpf(fmaxf(x, 1.0e-30f))); *qp = (unsigned short)f2bf(bf2f(*qp) * x); }
                    ET[B * 128 + d] = x; } }
            __syncthreads();
            float qf[8][8];
            { const LAS unsigned char* qp = Vl + trow * 256 + hi * 16;
#pragma unroll
                for (int kk = 0; kk < 8; ++kk) { const bf16x8 v = *(const LAS bf16x8*)(qp + kk * 32);
#pragma unroll
                    for (int e = 0; e < 8; ++e) qf[kk][e] = bf2f((unsigned short)v[e]); } }
            __syncthreads();
            { const bf16* vb_ = PC + (size_t)row0 * 5120 + 3072 + h * 128; bf16x8 vv[8];
#pragma unroll
                for (int c = 0; c < 8; ++c) { const unsigned off = (unsigned)(tid >> 4) * 10240u + (unsigned)(tid & 15) * 16u + (unsigned)c * 327680u; vv[c] = *(const bf16x8*)((const char*)vb_ + off); }
#pragma unroll
                for (int c = 0; c < 8; ++c) { const int idx = c * 512 + tid, r = idx >> 4, ch = idx & 15; *(LAS bf16x8*)(Vl + vimg(r, ch * 8)) = vv[c]; } }
            __syncthreads();
            const bf16* ST = S + (size_t)((bh * 2 + dir) * NGRP + g) * 16384; bf16x8 sreg[4];
#pragma unroll
            for (int c = 0; c < 4; ++c) sreg[c] = *((const bf16x8*)ST + c * 512 + tid);
            const int nst = dir == 0 ? I + 1 : 8 - I;
#pragma unroll 1
            for (int st = 0; st < nst; ++st) {
                const int J = dir == 0 ? I - st : I + st;
                if (st != 0) {
#pragma unroll
                    for (int kk = 0; kk < 8; ++kk) { const f32x4 e0 = *(LAS f32x4*)(ET + J * 128 + kk * 16 + hi * 8), e1 = *(LAS f32x4*)(ET + J * 128 + kk * 16 + hi * 8 + 4);
                        qf[kk][0] *= e0[0]; qf[kk][1] *= e0[1]; qf[kk][2] *= e0[2]; qf[kk][3] *= e0[3]; qf[kk][4] *= e1[0]; qf[kk][5] *= e1[1]; qf[kk][6] *= e1[2]; qf[kk][7] *= e1[3]; } }
                f32x16 p = {};
#pragma unroll
                for (int kk = 0; kk < 8; ++kk) { const int kr = 32 * J + t32; const bf16x8 kf = *(LAS bf16x8*)(Kl + K256(kr, (2 * kk + hi) * 16));
                    u32x4 w = {cvtpk(qf[kk][0], qf[kk][1]), cvtpk(qf[kk][2], qf[kk][3]), cvtpk(qf[kk][4], qf[kk][5]), cvtpk(qf[kk][6], qf[kk][7])};
                    p = __builtin_amdgcn_mfma_f32_32x32x16_bf16(kf, *reinterpret_cast<bf16x8*>(&w), p, 0, 0, 0); }
                if (st == 0) {
#pragma unroll
                    for (int r = 0; r < 16; ++r) { const int sl = lin::crow(r, hi); const bool keep = dir == 0 ? (sl <= t32) : (sl >= t32); p[r] = keep ? p[r] : 0.f; } }
                asm volatile("s_nop 15\n\ts_nop 7" : "+v"(p));
                bf16x8 pa0, pa1; LPK4(p, 0, pa0); LPK4(p, 8, pa1);
                LAS unsigned char* vj = Vl + vb + (J >> 1) * 16384 + (J & 1) * 8192;
#pragma unroll
                for (int c = 0; c < 4; ++c) {
                    const bf16x8 v0 = lin::tr_frag(vj, c * 512, c * 512 + 2048);
                    const bf16x8 v1 = lin::tr_frag(vj, c * 512 + 4096, c * 512 + 4096 + 2048);
                    o[c] = __builtin_amdgcn_mfma_f32_32x32x16_bf16(pa0, v0, o[c], 0, 0, 0);
                    o[c] = __builtin_amdgcn_mfma_f32_32x32x16_bf16(pa1, v1, o[c], 0, 0, 0); }
            }
            __syncthreads();
#pragma unroll
            for (int c = 0; c < 4; ++c) { const int ch = c * 512 + tid, e = ch >> 4, cc = ch & 15; *(LAS bf16x8*)(Kl + K256(e, cc * 16)) = sreg[c]; }
            __syncthreads();
#pragma unroll
            for (int kk = 0; kk < 8; ++kk) { u32x4 w = {cvtpk(qf[kk][0], qf[kk][1]), cvtpk(qf[kk][2], qf[kk][3]), cvtpk(qf[kk][4], qf[kk][5]), cvtpk(qf[kk][6], qf[kk][7])};
                const bf16x8 aq = *reinterpret_cast<bf16x8*>(&w);
#pragma unroll
                for (int c = 0; c < 4; ++c) { const bf16x8 sf = *(LAS bf16x8*)(Kl + K256(32 * c + t32, (2 * kk + hi) * 16));
                    o[c] = __builtin_amdgcn_mfma_f32_32x32x16_bf16(aq, sf, o[c], 0, 0, 0); } }
        }
        __syncthreads();
        { const bf16* gb_ = PC + (size_t)row0 * 5120 + 4096 + h * 128;
#pragma unroll
            for (int c = 0; c < 8; ++c) { const unsigned off = (unsigned)(tid >> 4) * 10240u + (unsigned)(tid & 15) * 16u + (unsigned)c * 327680u;
                __builtin_amdgcn_global_load_lds((const unsigned*)((const char*)gb_ + off), (LAS unsigned*)(Kl + c * 8192 + wave * 1024), 16, 0, 0); }
            VM_WAIT(); }
        __syncthreads();
        const float* gn = F.in[I_HGGAIN] + h * 128; LAS unsigned char* gbase = Kl + (32 * I + 4 * hi) * 256 + t32 * 2;
#pragma unroll
        for (int r = 0; r < 16; ++r) { float ss = 0.f;
#pragma unroll
            for (int c = 0; c < 4; ++c) ss += o[c][r] * o[c][r];
            ss = lin::half_sum32(ss); const float rstd = rsqrtf(ss * (1.f / 128.f) + RMS_EPS); const int row = row0 + 32 * I + lin::crow(r, hi);
            const LAS unsigned short* gp = (const LAS unsigned short*)(gbase + ((r & 3) + 8 * (r >> 2)) * 256); bf16* cp = CAT + (size_t)row * DM + h * 128;
#pragma unroll
            for (int c = 0; c < 4; ++c) { const int e = 32 * c + t32; cp[e] = (bf16)f2bf(o[c][r] * rstd * gn[e] * siluf(bf2f(gp[32 * c]))); }
            __builtin_amdgcn_sched_barrier(0); }
    }
}
}


namespace moe {
constexpr size_t WS_TILEE = WS_WGBASE + 65536;
constexpr size_t GU_SLAB = (size_t)2 * DFF * 1024, DN_SLAB = (size_t)1024 * DFF;
constexpr float GU_WSCALE = 32.f, DN_WSCALE = 64.f;
constexpr size_t MWGU_OFF = 0, MWDN_OFF = 8 * GU_SLAB;
static_assert(MWDN_OFF + 8 * DN_SLAB <= (size_t)2 * SEQ * DM * 4, "MoE weights");
struct TokRec { int e0, e1, p0, p1; float g0, g1; int s0, s1; };

__device__ __forceinline__ void convert_expert_weights(const Frame& F) {
    __syncthreads();
    transpose_items_i8(F, 1024, 2 * DFF, F.ws + WS_W_GU, SrcPlain{F.in[I_FFNGU], 2 * DFF, 2 * DFF}, DstGU{}, (const float*)(F.ws + WS_CMAXP) + 0, (float*)(F.ws + WS_CTL) + CW_COLSC + 0);
    transpose_items_f8(F, DFF, 1024, F.ws + WS_W_DN, SrcPlain{F.in[I_FFNDN], 1024, 1024}, DstPlain{}, DN_WSCALE);
    transpose_items_i8(F, 1024, 5120, F.ws + WS_W_INC, SrcPlain{F.in[I_WINC], 5120, 5120}, DstPlain{}, (const float*)(F.ws + WS_CMAXP) + 5632, (float*)(F.ws + WS_CTL) + CW_COLSC + 5632);
    transpose_items(F, 1024, 1024, (bf16*)(F.ws + WS_W_OUTC), SrcPlain{F.in[I_WOUTC], 1024, 1024}, DstPlain{});
    for (int e = 0; e < NEXP; ++e) {
        transpose_items_f8(F, 1024, 2 * DFF, (unsigned char*)F.out + MWGU_OFF + e * GU_SLAB, SrcPlain{F.in[I_MOEGU] + (size_t)e * 1024 * 2 * DFF, 2 * DFF, 2 * DFF}, DstGU{}, GU_WSCALE);
        transpose_items_f8(F, DFF, 1024, (unsigned char*)F.out + MWDN_OFF + e * DN_SLAB, SrcPlain{F.in[I_MOEDN] + (size_t)e * DFF * 1024, 1024, 1024}, DstPlain{}, DN_WSCALE);
    }
    __syncthreads();
}
__device__ __forceinline__ void p19_route(const Frame& F) {
    LAS float* wr = (LAS float*)F.lds;
    LAS int* cntl = (LAS int*)(F.lds + 32768);
    for (int i = F.tid; i < 8192; i += NTHREADS) wr[i] = F.in[I_ROUTER][i];
    if (F.tid < 8) cntl[F.tid] = 0;
    __syncthreads();
    const bf16* Y = (const bf16*)(F.ws + WS1_Y); unsigned char* H2 = F.ws + WS1_H2; TokRec* TR = (TokRec*)(F.ws + WS_TOKREC);
    const float* gain_a = F.in[I_GAINS] + 5 * 1024; const float* gain_b = F.in[I_GAINS] + 6 * 1024; const int lane = F.lane;
    u32x2 yw[4], ywn[4], xw[4], xwn[4]; f32x4 x[4], vga[4], vgb[4], vgt[4], vsh[4], vsc[4]; int cur = -1; load_vec(gain_a, lane, vga); load_vec(gain_b, lane, vgb);
    int row = F.gw; { while (row < NR) { int b, j; row_decode(row, b, j); if (j >= CTXL) break; row += F.NGW; } }
    if (row < NR) { load_row_raw(Y + (size_t)row * DM, lane, yw); load_row_raw(res_row(F, row), lane, xw); }
    while (row < NR) {
        int nrow = row + F.NGW; { while (nrow < NR) { int b, j; row_decode(nrow, b, j); if (j >= CTXL) break; nrow += F.NGW; } }
        if (nrow < NR) { load_row_raw(Y + (size_t)nrow * DM, lane, ywn); load_row_raw(res_row(F, nrow), lane, xwn); }
        int b, j; row_decode(row, b, j);
        f32x4 y[4]; cvt_row(yw, y); cvt_row(xw, x); bf16* xr = res_row(F, row);
        if (b != cur) { cur = b; load_vec(mod_vec(F, 1, row, 2), lane, vgt); load_vec(mod_vec(F, 1, row, 3), lane, vsh); load_vec(mod_vec(F, 1, row, 4), lane, vsc); }
        const float rstd = row_rstd(y);
#pragma unroll
        for (int q = 0; q < 4; ++q) { const int idx = lane + 64 * q; x[q] = x[q] + vgt[q] * (y[q] * rstd * vga[q]); store_res(xr, idx, x[q]); }
        const float rs2 = row_rstd(x);
        float lg[8] = {0.f, 0.f, 0.f, 0.f, 0.f, 0.f, 0.f, 0.f};
#pragma unroll
        for (int q = 0; q < 4; ++q) { const int idx = lane + 64 * q;
            const f32x4 hv = (x[q] * rs2 * vgb[q]) * (1.f + vsc[q]) + vsh[q];
            *((unsigned*)(H2 + (size_t)row * DM) + idx) = pk4_fp8(hv.x, hv.y, hv.z, hv.w);
#pragma unroll
            for (int i = 0; i < 4; ++i) { const f32x4 w0 = *(LAS f32x4*)(wr + (4 * idx + i) * 8), w1 = *(LAS f32x4*)(wr + (4 * idx + i) * 8 + 4); const float hh = hv[i];
                lg[0] += hh * w0[0]; lg[1] += hh * w0[1]; lg[2] += hh * w0[2]; lg[3] += hh * w0[3]; lg[4] += hh * w1[0]; lg[5] += hh * w1[1]; lg[6] += hh * w1[2]; lg[7] += hh * w1[3]; } }
#pragma unroll
        for (int e = 0; e < 8; ++e) lg[e] = wave_sum(lg[e]);
        int e0 = 0; float v0 = lg[0];
#pragma unroll
        for (int e = 1; e < 8; ++e) if (lg[e] > v0) { v0 = lg[e]; e0 = e; }
        int e1 = -1; float v1 = -3.0e38f;
#pragma unroll
        for (int e = 0; e < 8; ++e) if (e != e0 && lg[e] > v1) { v1 = lg[e]; e1 = e; }
        if (lane == 0) { const float ga = 1.f / (1.f + __expf(v1 - v0)); const int p0 = atomicAdd((int*)&cntl[e0], 1), p1 = atomicAdd((int*)&cntl[e1], 1);
            TokRec t; t.e0 = e0; t.e1 = e1; t.p0 = p0; t.p1 = p1; t.g0 = ga; t.g1 = 1.f - ga; t.s0 = 0; t.s1 = 0; TR[b * SEQ + (j - CTXL)] = t; }
#pragma unroll
        for (int q = 0; q < 4; ++q) { yw[q] = ywn[q]; xw[q] = xwn[q]; }
        row = nrow;
    }
    __syncthreads();
    if (F.tid < 8) { unsigned* cnt = (unsigned*)(F.ws + WS_CTL) + CW_MOECNT + 64 * F.tid;
        ((unsigned*)(F.ws + WS_WGBASE))[blockIdx.x * 64 + F.tid] = __hip_atomic_fetch_add(cnt, (unsigned)cntl[F.tid], __ATOMIC_RELAXED, __HIP_MEMORY_SCOPE_AGENT); }
}
__device__ __forceinline__ int slot_layout(const Frame& F, int (&base)[8], int (&cnt)[8]) {
    int acc = 0;
#pragma unroll
    for (int e = 0; e < 8; ++e) { cnt[e] = (int)__hip_atomic_load((unsigned*)(F.ws + WS_CTL) + CW_MOECNT + 64 * e, __ATOMIC_RELAXED, __HIP_MEMORY_SCOPE_AGENT); base[e] = acc; acc += (cnt[e] + 255) & ~255; }
    return acc >> 8;
}
__device__ __forceinline__ void p20_gather(const Frame& F) {
    int base[8], cnt[8]; const int ntiles = slot_layout(F, base, cnt);
    if (blockIdx.x == 0) { int* te = (int*)(F.ws + WS_TILEE);
        for (int t = F.tid; t < 264; t += NTHREADS) { int e = 0;
#pragma unroll
            for (int q = 1; q < 8; ++q) if (t * 256 >= base[q]) e = q;
            te[t] = e; }
        if (F.tid == 0) te[264] = ntiles; }
    const unsigned char* H2 = F.ws + WS1_H2; unsigned char* XS = F.ws + WS1_XS; TokRec* TR = (TokRec*)(F.ws + WS_TOKREC);
    const unsigned* wgb = (const unsigned*)(F.ws + WS_WGBASE) + blockIdx.x * 64; const int lane = F.lane;
    for (int row = F.gw; row < NR; row += F.NGW) {
        int b, j; row_decode(row, b, j); if (j < CTXL) continue;
        TokRec* tr = TR + (b * SEQ + (j - CTXL)); const int e0 = tr->e0, e1 = tr->e1;
        int s0 = 0, s1 = 0;
#pragma unroll
        for (int e = 0; e < 8; ++e) { if (e == e0) s0 = base[e] + (int)wgb[e] + tr->p0; if (e == e1) s1 = base[e] + (int)wgb[e] + tr->p1; }
        const u32x4 a = ((const u32x4*)(H2 + (size_t)row * DM))[lane];
        ((u32x4*)(XS + (size_t)s0 * DM))[lane] = a; ((u32x4*)(XS + (size_t)s1 * DM))[lane] = a;
        if (lane == 0) { tr->s0 = s0; tr->s1 = s1; }
    }
    if (blockIdx.x < 8) { const int e = blockIdx.x, lo = base[e] + cnt[e], hi = base[e] + ((cnt[e] + 255) & ~255);
        for (int s = lo + F.wave; s < hi; s += NWAVES) { ((u32x4*)(XS + (size_t)s * DM))[lane] = (u32x4){0u, 0u, 0u, 0u}; } }
}
__device__ __forceinline__ void p23_combine(const Frame& F) {
    const bf16* YS = (const bf16*)(F.ws + WS1_YS); const TokRec* TR = (const TokRec*)(F.ws + WS_TOKREC); const float* gain = F.in[I_GAINS] + 7 * 1024; const int lane = F.lane;
    u32x2 w0[4], w1[4], w0n[4], w1n[4], xw[4], xwn[4]; f32x4 x[4], vg[4], vgt[4]; int cur = -1; load_vec(gain, lane, vg); float g0 = 0.f, g1 = 0.f, g0n = 0.f, g1n = 0.f;
    int row = F.gw; { while (row < NR) { int b, j; row_decode(row, b, j); if (j >= CTXL) break; row += F.NGW; } }
    if (row < NR) { int b, j; row_decode(row, b, j); const TokRec tr = TR[b * SEQ + (j - CTXL)]; g0 = tr.g0; g1 = tr.g1;
        load_row_raw(YS + (size_t)tr.s0 * DM, lane, w0); load_row_raw(YS + (size_t)tr.s1 * DM, lane, w1); load_row_raw(res_row(F, row), lane, xw); }
    while (row < NR) {
        int nrow = row + F.NGW; { while (nrow < NR) { int b, j; row_decode(nrow, b, j); if (j >= CTXL) break; nrow += F.NGW; } }
        if (nrow < NR) { int b, j; row_decode(nrow, b, j); const TokRec tr = TR[b * SEQ + (j - CTXL)]; g0n = tr.g0; g1n = tr.g1;
            load_row_raw(YS + (size_t)tr.s0 * DM, lane, w0n); load_row_raw(YS + (size_t)tr.s1 * DM, lane, w1n); load_row_raw(res_row(F, nrow), lane, xwn); }
        f32x4 y0[4], y1[4]; cvt_row(w0, y0); cvt_row(w1, y1); cvt_row(xw, x); float* xr = out_row(F, row);
#pragma unroll
        for (int q = 0; q < 4; ++q) y0[q] = y0[q] * g0 + y1[q] * g1;
        { const int who = row_who(row); if (who != cur) { cur = who; load_vec(mod_vec(F, 1, row, 5), lane, vgt); } }
        const float rstd = row_rstd(y0);
#pragma unroll
        for (int q = 0; q < 4; ++q) { const int idx = lane + 64 * q; *((f32x4*)xr + idx) = x[q] + vgt[q] * (y0[q] * rstd * vg[q]); }
#pragma unroll
        for (int q = 0; q < 4; ++q) { w0[q] = w0n[q]; w1[q] = w1n[q]; xw[q] = xwn[q]; }
        g0 = g0n; g1 = g1n; row = nrow;
    }
}
}

__device__ __forceinline__ int opaque(int v) { asm volatile("" : "+s"(v)); return v; }
__device__ __forceinline__ void convert_v(const Frame& F) {
    const bf16* V = (const bf16*)(F.ws + WS_V); char* VT = (char*)(F.ws + WS_KV8) + 64 * 208;
    for (int item = F.gw; item < 8 * (NT / 64); item += F.NGW) {
        const unsigned* src = (const unsigned*)(V + (size_t)item * 64 * 128) + F.lane;
        unsigned v[64];
#pragma unroll
        for (int k = 0; k < 64; ++k) v[k] = src[k * 64];
        u32x4 lo[4], hi4[4];
#pragma unroll
        for (int w = 0; w < 16; ++w) { const int k0 = 32 * ((w >> 2) & 1) + 8 * (w & 3) + 4 * (w >> 3);
            const unsigned a = att::pk4f8(__uint_as_float(v[k0] << 16), __uint_as_float(v[k0 + 1] << 16), __uint_as_float(v[k0 + 2] << 16), __uint_as_float(v[k0 + 3] << 16));
            const unsigned b = att::pk4f8(__uint_as_float(v[k0] & 0xffff0000u), __uint_as_float(v[k0 + 1] & 0xffff0000u), __uint_as_float(v[k0 + 2] & 0xffff0000u), __uint_as_float(v[k0 + 3] & 0xffff0000u));
            if ((w & 3) == 0) { lo[w >> 2].x = a; hi4[w >> 2].x = b; } else if ((w & 3) == 1) { lo[w >> 2].y = a; hi4[w >> 2].y = b; } else if ((w & 3) == 2) { lo[w >> 2].z = a; hi4[w >> 2].z = b; } else { lo[w >> 2].w = a; hi4[w >> 2].w = b; } }
        u32x4* dst = (u32x4*)(VT + (size_t)item * 23552 + F.lane * 160);
#pragma unroll
        for (int q = 0; q < 4; ++q) { dst[q] = lo[q]; dst[5 + q] = hi4[q]; }
    }
}
__device__ __forceinline__ void convert_k(const Frame& F) {
    const bf16* KN = (const bf16*)(F.ws + WS_KN); const bf16* KR = (const bf16*)(F.ws + WS_KR); char* K8 = (char*)(F.ws + WS_KV8);
    for (int item = F.gw; item < 8 * (NT / 64); item += F.NGW) {
        const int bh = item / (NT / 64), key = (item - bh * (NT / 64)) * 64 + F.lane;
        const bf16x8* sn = (const bf16x8*)(KN + ((size_t)bh * NT + key) * 128); const bf16x8* sr = (const bf16x8*)(KR + ((size_t)(bh >> 2) * NT + key) * 64);
        bf16x8 c[24];
#pragma unroll
        for (int i = 0; i < 16; ++i) c[i] = sn[i];
#pragma unroll
        for (int i = 0; i < 8; ++i) c[16 + i] = sr[i];
        u32x4* dst = (u32x4*)(K8 + (size_t)item * 23552 + F.lane * 208);
#pragma unroll
        for (int g = 0; g < 3; ++g)
#pragma unroll
            for (int u = 0; u < 4; ++u) {
                const int u0 = 2 * u, u1 = 2 * u + 1; const u32x2 x = att::bf8_to_f8(c[8 * g + 2 * (u0 & 3) + (u0 >> 2)]), y = att::bf8_to_f8(c[8 * g + 2 * (u1 & 3) + (u1 >> 2)]);
                dst[4 * g + u] = (u32x4){x.x, x.y, y.x, y.y}; }
    }
}
__global__ void __launch_bounds__(NTHREADS, 2) fwd_kernel(Args args) {
    extern __shared__ __attribute__((aligned(16))) unsigned char lds_raw[];
    Frame F;
    F.lds = (LAS unsigned char*)lds_raw; F.tid = threadIdx.x; asm volatile("" : "+v"(F.tid));     F.lane = F.tid & 63; F.wave = __builtin_amdgcn_readfirstlane(F.tid >> 6);
    F.G = gridDim.x; F.gw = blockIdx.x * NWAVES + F.wave; F.NGW = F.G * NWAVES; F.in = args.in; F.out = args.out; F.ws = args.ws;
    volatile LAS unsigned* MISC = (volatile LAS unsigned*)(F.lds + MISC_OFF);
    for (int u = F.tid; u < (LDS_BYTES - RING_BYTES) / 4; u += NTHREADS) ((LAS unsigned*)(F.lds + RING_BYTES))[u] = 0u;
    __syncthreads();
    unsigned* ctl = (unsigned*)(F.ws + WS_CTL);
    XcdBarrier bar = xcd_barrier_post(ctl + CW_BAR, MISC + 8, F.tid);
    const int lo = args.ph_lo, hi = args.ph_hi;
#define IN(k) (lo <= (k) && (k) < hi)
#ifndef DUP_MASK
#define DUP_MASK 0u
#endif
#define REP(k) (1 + (int)(((unsigned)(DUP_MASK) >> (k)) & 1u))
#define LAUNDER() do { asm volatile("" : "+v"(F.tid), "+v"(F.lane)); } while (0)
#define SEAM(k) do { if (IN(k) && IN((k) + 1)) xcd_barrier(bar, F.tid); } while (0)

#if BAR_PROBE
    for (int i_ = 0; i_ < BAR_PROBE; ++i_) xcd_barrier(bar, F.tid);
#endif
    if (IN(0)) for (int rep_ = 0; rep_ < REP(0); ++rep_) { LAUNDER(); p0_prologue(F); } SEAM(0);
    if (IN(1)) for (int rep_ = 0; rep_ < REP(1); ++rep_) { LAUNDER(); p1_norm0(F); } SEAM(1);
    if (IN(2)) for (int rep_ = 0; rep_ < REP(2); ++rep_) { LAUNDER();
        pg8::Gemm g{(const bf16*)(F.ws + WS_H), (const bf16*)(F.ws + WS_W_INAB), opaque(1024 / 2), 0, (const float*)(F.ws + WS_SA), (const float*)(F.ws + WS_CTL) + CW_COLSC + 10752}; pg8::StaticOrder S; S.init(NR / 256, 2048 / 256, F.G, (int)blockIdx.x, 0);
        epi::InAB E{(bf16*)(F.ws + WS_P), (float*)(F.ws + WS_GATES)};
        pg8::gemm_phase<epi::InAB, pg8::StaticOrder, true, true, 2>(F.lds, g, S, E, F.tid);
    } SEAM(2);
    if (IN(3)) for (int rep_ = 0; rep_ < REP(3); ++rep_) { LAUNDER(); p3_prep(F); } SEAM(3);
    if (IN(4)) for (int rep_ = 0; rep_ < REP(4); ++rep_) { LAUNDER();
        pg8::Gemm g{(const bf16*)(F.ws + WS_A2), (const bf16*)(F.ws + WS_W_UP), opaque(384), 0}; pg8::StaticOrder S; S.init(NR / 256, 1792 / 256, F.G, (int)blockIdx.x, 0);
        epi::UpProj E{F.ws};
        pg8::gemm_phase<epi::UpProj, pg8::StaticOrder, true, true>(F.lds, g, S, E, F.tid);
    } if (IN(4)) xcd_barrier(bar, F.tid);
    if (IN(4)) { LAUNDER(); convert_v(F); LAUNDER(); convert_k(F); } SEAM(4);
    if (IN(5)) for (int rep_ = 0; rep_ < REP(5); ++rep_) { LAUNDER();
        const bf16* Q = (const bf16*)(F.ws + WS_Q); const bf16* KN = (const bf16*)(F.ws + WS_KN); const bf16* KR = (const bf16*)(F.ws + WS_KR); const char* KV = (const char*)(F.ws + WS_KV8);
        bf16* CAT = (bf16*)(F.ws + WS_CAT); const float* rope = (const float*)(F.ws + WS_ROPE);
#if !MLSTM_STUB
        ml::pass_b(F);
#endif
        const int c = blockIdx.x, bh = c & 7, b = bh >> 2, h = bh & 3;
        const int cslot = (c >> 3) & 1;
        if (cslot == 0) moe::convert_expert_weights(F);
        for (int i = 0; i < 3; ++i) {
            int j0, seq, rt0;
            if (i < 2) { const int qb = (c >> 3) + 32 * i; if (qb >= 64) continue; j0 = CTXL + qb * 256; seq = NT; rt0 = qb * 256; }
            else { if ((c >> 3) != 0) continue; j0 = 0; seq = CTXL; rt0 = -1; }
            att::attn_unit(Q + ((size_t)bh * NT + j0) * 192, KV + (size_t)bh * (NT / 64) * 23552  ,
                           CAT + ((size_t)b * NT + j0) * DM + h * 128, seq, rt0, rope, (char*)lds_raw, F.tid);
        }
        if (cslot == 1) moe::convert_expert_weights(F);
        __syncthreads();
#if MLSTM_STUB
        for (int row = F.gw; row < NR; row += F.NGW) { *((u32x4*)((bf16*)CAT + (size_t)row * DM + 512) + F.lane) = (u32x4){0u, 0u, 0u, 0u}; }
#endif
    } SEAM(5);
#if !MLSTM_STUB
    if (IN(7)) for (int rep_ = 0; rep_ < REP(7); ++rep_) { LAUNDER(); ml::pass_c(F); } SEAM(7);
    if (IN(8)) for (int rep_ = 0; rep_ < REP(8); ++rep_) { LAUNDER(); ml::pass_d(F); } SEAM(8);
#endif
    if (IN(9)) for (int rep_ = 0; rep_ < REP(9); ++rep_) { LAUNDER();
        pg8::Gemm g{(const bf16*)(F.ws + WS_CAT), (const bf16*)(F.ws + WS_W_OUTAB), opaque(1024), 0}; pg8::StaticOrder S; S.init(128, 4, F.G, (int)blockIdx.x, 1);
        epi::Bf16 E{(bf16*)(F.ws + WS_Y), DM};
        pg8::gemm_phase<epi::Bf16, pg8::StaticOrder, true, true>(F.lds, g, S, E, F.tid);
    } SEAM(9);
    if (IN(10)) for (int rep_ = 0; rep_ < REP(10); ++rep_) { LAUNDER();
        if (blockIdx.x < 8) { pg8::Gemm g{(const bf16*)(F.ws + WS_CAT), (const bf16*)(F.ws + WS_W_OUTAB), opaque(1024), 0}; pg8::CtxOrder S{(int)blockIdx.x}; epi::Bf16 E{(bf16*)(F.ws + WS_Y), DM};
            pg8::gemm_phase<epi::Bf16, pg8::CtxOrder, true, true>(F.lds, g, S, E, F.tid); }
        else resnorm_rows<true, true>(F, (const bf16*)(F.ws + WS_Y), 0, 2, F.in[I_GAINS] + 1 * 1024, 0, 3, F.in[I_GAINS] + 2 * 1024, (bf16*)(F.ws + WS_H), 1, F.gw - 8 * NWAVES, F.NGW - 8 * NWAVES);
    } if (IN(10)) xcd_barrier(bar, F.tid);
    if (IN(10)) { LAUNDER(); resnorm_rows<true, true>(F, (const bf16*)(F.ws + WS_Y), 0, 2, F.in[I_GAINS] + 1 * 1024, 0, 3, F.in[I_GAINS] + 2 * 1024, (bf16*)(F.ws + WS_H), 2, F.gw, F.NGW); } SEAM(10);
    if (IN(11)) for (int rep_ = 0; rep_ < REP(11); ++rep_) { LAUNDER();
        pg8::Gemm g{(const bf16*)(F.ws + WS_H), (const bf16*)(F.ws + WS_W_GU), opaque(1024 / 2), 0, (const float*)(F.ws + WS_SA), (const float*)(F.ws + WS_CTL) + CW_COLSC + 0}; pg8::StaticOrder S; S.init(NR / 256, 2 * DFF / 256, F.G, (int)blockIdx.x, 0);
        epi::SwiGLUf8 E{F.ws + WS_HID, DFF, 1.f};
        pg8::gemm_phase<epi::SwiGLUf8, pg8::StaticOrder, true, true, 2>(F.lds, g, S, E, F.tid);
    } SEAM(11);
    if (IN(12)) for (int rep_ = 0; rep_ < REP(12); ++rep_) { LAUNDER();
        pg8::Gemm g{(const bf16*)(F.ws + WS_HID), (const bf16*)(F.ws + WS_W_DN), opaque(DFF / 2), 0}; pg8::StaticOrder S; S.init(128, 4, F.G, (int)blockIdx.x, 1);
        epi::Bf16 E{(bf16*)(F.ws + WS_Y), DM, 1.f / moe::DN_WSCALE};
        pg8::gemm_phase<epi::Bf16, pg8::StaticOrder, true, true, 1>(F.lds, g, S, E, F.tid);
    } SEAM(12);
    if (IN(13)) { LAUNDER();
        if (blockIdx.x < 8) { pg8::Gemm g{(const bf16*)(F.ws + WS_HID), (const bf16*)(F.ws + WS_W_DN), opaque(DFF / 2), 0}; pg8::CtxOrder S{(int)blockIdx.x}; epi::Bf16 E{(bf16*)(F.ws + WS_Y), DM, 1.f / moe::DN_WSCALE};
            pg8::gemm_phase<epi::Bf16, pg8::CtxOrder, true, true, 1>(F.lds, g, S, E, F.tid); }
        else resnorm_rows<false, true>(F, (const bf16*)(F.ws + WS_Y), 0, 5, F.in[I_GAINS] + 3 * 1024, 1, 0, F.in[I_GAINS] + 4 * 1024, (bf16*)(F.ws + WS1_H1), 1, F.gw - 8 * NWAVES, F.NGW - 8 * NWAVES);
    } if (IN(13)) xcd_barrier(bar, F.tid);
    if (IN(13)) { LAUNDER(); resnorm_rows<false, true>(F, (const bf16*)(F.ws + WS_Y), 0, 5, F.in[I_GAINS] + 3 * 1024, 1, 0, F.in[I_GAINS] + 4 * 1024, (bf16*)(F.ws + WS1_H1), 2, F.gw, F.NGW); } SEAM(13);
    if (IN(14)) for (int rep_ = 0; rep_ < REP(14); ++rep_) { LAUNDER();
        pg8::Gemm g{(const bf16*)(F.ws + WS1_H1), (const bf16*)(F.ws + WS_W_INC), opaque(1024 / 2), 0, (const float*)(F.ws + WS_SA), (const float*)(F.ws + WS_CTL) + CW_COLSC + 5632}; pg8::StaticOrder S; S.init(NR / 256, 5120 / 256, F.G, (int)blockIdx.x, 0);
        epi::InC E{(bf16*)(F.ws + WS1_PC), (const float*)(F.ws + WS_LB)};
        pg8::gemm_phase<epi::InC, pg8::StaticOrder, true, true, 2>(F.lds, g, S, E, F.tid);
    } SEAM(14);
    if (IN(15)) for (int rep_ = 0; rep_ < REP(15); ++rep_) { LAUNDER(); hg::pass_b(F); } SEAM(15);
    if (IN(16)) for (int rep_ = 0; rep_ < REP(16); ++rep_) { LAUNDER(); hg::pass_c(F); } SEAM(16);
    if (IN(17)) for (int rep_ = 0; rep_ < REP(17); ++rep_) { LAUNDER(); hg::pass_d(F); } SEAM(17);
    if (IN(18)) for (int rep_ = 0; rep_ < REP(18); ++rep_) { LAUNDER();
        pg8::Gemm g{(const bf16*)(F.ws + WS1_CAT), (const bf16*)(F.ws + WS_W_OUTC), opaque(1024), 0}; pg8::StaticOrder S; S.init(128, 4, F.G, (int)blockIdx.x, 1);
        epi::Bf16 E{(bf16*)(F.ws + WS1_Y), DM};
        pg8::gemm_phase<epi::Bf16, pg8::StaticOrder, true, true>(F.lds, g, S, E, F.tid);
    } SEAM(18);
    if (IN(19)) for (int rep_ = 0; rep_ < REP(19); ++rep_) { LAUNDER(); moe::p19_route(F); } SEAM(19);
    if (IN(20)) for (int rep_ = 0; rep_ < REP(20); ++rep_) { LAUNDER(); moe::p20_gather(F); } SEAM(20);
    if (IN(21)) for (int rep_ = 0; rep_ < REP(21); ++rep_) { LAUNDER();
        const int* te = (const int*)(F.ws + moe::WS_TILEE); const int ntiles = te[264];
        pg8::Gemm g{(const bf16*)(F.ws + WS1_XS), (const bf16*)((const unsigned char*)F.out + moe::MWGU_OFF), opaque(1024 / 2), moe::GU_SLAB}; pg8::GroupedOrder S; S.init(ntiles, 2 * DFF / 256, F.G, (int)blockIdx.x, te);
        epi::SwiGLUf8 E{F.ws + WS1_MHID, DFF, 1.f / moe::GU_WSCALE};
        pg8::gemm_phase<epi::SwiGLUf8, pg8::GroupedOrder, true, true, true>(F.lds, g, S, E, F.tid);
    } SEAM(21);
    if (IN(22)) for (int rep_ = 0; rep_ < REP(22); ++rep_) { LAUNDER();
        const int* te = (const int*)(F.ws + moe::WS_TILEE); const int ntiles = te[264];
        pg8::Gemm g{(const bf16*)(F.ws + WS1_MHID), (const bf16*)((const unsigned char*)F.out + moe::MWDN_OFF), opaque(DFF / 2), moe::DN_SLAB}; pg8::GroupedOrder S; S.init(ntiles, 4, F.G, (int)blockIdx.x, te);
        epi::Bf16 E{(bf16*)(F.ws + WS1_YS), DM, 1.f / moe::DN_WSCALE};
        pg8::gemm_phase<epi::Bf16, pg8::GroupedOrder, true, true, true>(F.lds, g, S, E, F.tid);
    } SEAM(22);
    if (IN(23)) for (int rep_ = 0; rep_ < REP(23); ++rep_) { LAUNDER(); moe::p23_combine(F); }
#undef IN
#undef SEAM
}

extern "C" void kernel_launch(void* const* d_in, const int* in_sizes, int n_in, void* d_out, int out_size, void* d_ws, size_t ws_size, hipStream_t stream) {
    static int grid = 0;
    if (grid == 0) {
        if (n_in != N_IN || out_size != NB * SEQ * DM || ws_size < WS_END) { fprintf(stderr, "kernel_launch: unexpected shapes: n_in %d out %d ws %zu (need %zu)\n", n_in, out_size, ws_size, (size_t)WS_END); grid = -1; return; }
        int dev = 0, cus = 0, per_cu = 0;
        if (hipGetDevice(&dev) != hipSuccess || hipDeviceGetAttribute(&cus, hipDeviceAttributeMultiprocessorCount, dev) != hipSuccess) { grid = -1; return; }
        if (hipFuncSetAttribute((const void*)fwd_kernel, hipFuncAttributeMaxDynamicSharedMemorySize, LDS_BYTES) != hipSuccess) { fprintf(stderr, "kernel_launch: hipFuncSetAttribute failed\n"); grid = -1; return; }
        if (hipOccupancyMaxActiveBlocksPerMultiprocessor(&per_cu, (const void*)fwd_kernel, NTHREADS, LDS_BYTES) != hipSuccess || per_cu < 1) { fprintf(stderr, "kernel_launch: occupancy query reports %d\n", per_cu); }
        (void)hipGetLastError();
        grid = cus;
    }
    if (grid < 0) return;
    if (hipMemsetAsync((char*)d_ws + WS_CTL, 0, CTL_ZERO_BYTES, stream) != hipSuccess) return;
    Args a{};
    for (int i = 0; i < N_IN; ++i) a.in[i] = (const float*)d_in[i];
    a.out = (float*)d_out; a.ws = (unsigned char*)d_ws;
#if N_LAUNCHES == 1
    a.ph_lo = 0; a.ph_hi = 64;
    hipLaunchKernelGGL(fwd_kernel, dim3(grid), dim3(NTHREADS), LDS_BYTES, stream, a);
#else
    for (int p = 0; p < 64; ++p) { a.ph_lo = p; a.ph_hi = p + 1; hipLaunchKernelGGL(fwd_kernel, dim3(grid), dim3(NTHREADS), LDS_BYTES, stream, a); }
#endif
}
```
